# Optimizing an MI355X kernel written in HIP

```python
import jax, jax.numpy as jnp
from jax import lax
import numpy as np

D_MODEL = 2048
BATCH = 32
SEQ = 256
DEPTH = 4
DEC_BATCH = 2
DEC_SEQ = 2048
PAST_LEN = 256

GRID_W = 64
HEAD_DIM = 128
N_Q_HEADS = 12
N_KV_HEADS = 4
Q_PER_KV = N_Q_HEADS // N_KV_HEADS
ATTN_WIDTH = N_Q_HEADS * HEAD_DIM
KV_WIDTH = N_KV_HEADS * HEAD_DIM
WINDOW = 128
BLOCK = 128
ROPE_THETA = 10000.0
FOURIER_GROUPS = 4
FOURIER_WIDTH = D_MODEL // 4
FOURIER_GROUP_DIM = FOURIER_WIDTH // FOURIER_GROUPS
POOL_WINDOWS = (2, 4, 8, 16)
POOL_WIDTH = D_MODEL // 2
POOL_GROUP_DIM = POOL_WIDTH // len(POOL_WINDOWS)
SGU_HEADS = 4
SGU_WIDTH = D_MODEL // 2
SGU_GROUP_DIM = SGU_WIDTH // SGU_HEADS
SGU_CHUNK = 128
MIX_WIDTH = ATTN_WIDTH + FOURIER_WIDTH
IN_WIDTH = 2 * ATTN_WIDTH + 2 * KV_WIDTH + 2 * FOURIER_WIDTH
EVEN_SPLITS = (ATTN_WIDTH, ATTN_WIDTH + KV_WIDTH, ATTN_WIDTH + 2 * KV_WIDTH,
               2 * ATTN_WIDTH + 2 * KV_WIDTH, 2 * ATTN_WIDTH + 2 * KV_WIDTH + FOURIER_WIDTH)
ODD_SPLITS = (POOL_WIDTH, 2 * POOL_WIDTH, 2 * POOL_WIDTH + SGU_WIDTH, 2 * POOL_WIDTH + 2 * SGU_WIDTH)
N_ATTN_LAYERS = (DEPTH + 1) // 2
N_POOL_LAYERS = DEPTH // 2
EPS = 1e-6
NEG_INF = -1e30

kernel_name = "hybrid_diffusion_prefix_step"


def rmsnorm(x, g):
    x32 = x.astype(jnp.float32)
    y = x32 * lax.rsqrt(jnp.mean(x32 * x32, axis=-1, keepdims=True) + EPS)
    return (y * g.astype(jnp.float32)).astype(x.dtype)


def axial_rope_tables(t_len):
    rows = t_len // GRID_W
    row = jnp.repeat(jnp.arange(rows), GRID_W).astype(jnp.float32)
    col = jnp.tile(jnp.arange(GRID_W), rows).astype(jnp.float32)
    n_freq = HEAD_DIM // 4
    inv = ROPE_THETA ** (-jnp.arange(n_freq, dtype=jnp.float32) / n_freq)
    ang = jnp.stack([row[:, None] * inv, col[:, None] * inv], axis=1)
    return jnp.cos(ang), jnp.sin(ang)


def apply_axial_rope(x, cos, sin):
    shp = x.shape
    xr = x.reshape(shp[:-1] + (2, 2, HEAD_DIM // 4)).astype(jnp.float32)
    c = cos[None, :, None]
    s = sin[None, :, None]
    x1 = xr[..., 0, :]
    x2 = xr[..., 1, :]
    out = jnp.stack([x1 * c - x2 * s, x2 * c + x1 * s], axis=-2)
    return out.reshape(shp).astype(x.dtype)


def context_attention(q, k, v, sink):
    B, L = q.shape[:2]
    s = jnp.einsum('blhgd,bmhd->bhglm', q, k, preferred_element_type=jnp.float32) * (HEAD_DIM ** -0.5)
    sink_l = jnp.broadcast_to(sink.astype(jnp.float32)[None, :, :, None, None], s.shape[:-1] + (1,))
    p = jax.nn.softmax(jnp.concatenate([s, sink_l], axis=-1), axis=-1)[..., :-1]
    o = jnp.einsum('bhglm,bmhd->blhgd', p.astype(v.dtype), v)
    return o.reshape(B, L, ATTN_WIDTH)


def latent_window_attention(q, k, v, k_ctx, v_ctx, sink):
    B, T = q.shape[:2]
    nb = T // BLOCK
    qb = q.reshape(B, nb, BLOCK, N_KV_HEADS, Q_PER_KV, HEAD_DIM)
    pad = ((0, 0), (BLOCK, BLOCK), (0, 0), (0, 0))
    kb = jnp.pad(k, pad).reshape(B, nb + 2, BLOCK, N_KV_HEADS, HEAD_DIM)
    vb = jnp.pad(v, pad).reshape(B, nb + 2, BLOCK, N_KV_HEADS, HEAD_DIM)
    kw = jnp.concatenate([kb[:, :-2], kb[:, 1:-1], kb[:, 2:]], axis=2)
    vw = jnp.concatenate([vb[:, :-2], vb[:, 1:-1], vb[:, 2:]], axis=2)
    scale = HEAD_DIM ** -0.5
    s_loc = jnp.einsum('bnqhgd,bnkhd->bnhgqk', qb, kw, preferred_element_type=jnp.float32) * scale
    blk = jnp.arange(nb)[:, None]
    qpos = blk * BLOCK + jnp.arange(BLOCK)[None, :]
    kpos = (blk - 1) * BLOCK + jnp.arange(3 * BLOCK)[None, :]
    valid = ((jnp.abs(qpos[:, :, None] - kpos[:, None, :]) <= WINDOW)
             & (kpos >= 0)[:, None, :] & (kpos < T)[:, None, :])
    s_loc = jnp.where(valid[None, :, None, None], s_loc, NEG_INF)
    s_ctx = jnp.einsum('bnqhgd,blhd->bnhgql', qb, k_ctx, preferred_element_type=jnp.float32) * scale
    sink_l = jnp.broadcast_to(sink.astype(jnp.float32)[None, None, :, :, None, None], s_loc.shape[:-1] + (1,))
    p = jax.nn.softmax(jnp.concatenate([s_loc, s_ctx, sink_l], axis=-1), axis=-1)
    p_loc = p[..., :3 * BLOCK].astype(v.dtype)
    p_ctx = p[..., 3 * BLOCK:-1].astype(v.dtype)
    o = (jnp.einsum('bnhgqk,bnkhd->bnqhgd', p_loc, vw)
         + jnp.einsum('bnhgql,blhd->bnqhgd', p_ctx, v_ctx))
    return o.reshape(B, T, ATTN_WIDTH)


def fourier_mix(u):
    B, T, _ = u.shape
    ug = u.reshape(B, T, FOURIER_GROUPS, FOURIER_GROUP_DIM).astype(jnp.float32)
    f = jnp.fft.fft2(ug, axes=(1, 3), norm="ortho").real
    return f.reshape(B, T, FOURIER_WIDTH).astype(u.dtype)


def multiscale_pool(u, pool_w, pool_scale):
    B, T, _ = u.shape
    ug = u.reshape(B, T, len(POOL_WINDOWS), POOL_GROUP_DIM).astype(jnp.float32)
    csum = jnp.pad(jnp.cumsum(ug, axis=1), ((0, 0), (1, 0), (0, 0), (0, 0)))
    pos = jnp.arange(T)
    outs = []
    for g, w in enumerate(POOL_WINDOWS):
        lo = jnp.clip(pos - w // 2, 0, T)
        hi = jnp.clip(pos + w // 2, 0, T)
        cg = csum[:, :, g]
        cnt = (hi - lo).astype(jnp.float32)[None, :, None]
        outs.append((cg[:, hi] - cg[:, lo]) / cnt - ug[:, :, g])
    pooled = jnp.stack(outs, axis=2)
    mixed = jnp.einsum('btgc,gcd->btgd', pooled, pool_w.astype(jnp.float32))
    return (mixed.reshape(B, T, POOL_WIDTH) * pool_scale.astype(jnp.float32)).astype(u.dtype)


def spatial_gating(u, v, sgu_norm, sgu_w, sgu_b):
    B, T, _ = u.shape
    nc = T // SGU_CHUNK
    v32 = v.reshape(B, T, SGU_HEADS, SGU_GROUP_DIM).astype(jnp.float32)
    mu = jnp.mean(v32, axis=-1, keepdims=True)
    var = jnp.mean(jnp.square(v32 - mu), axis=-1, keepdims=True)
    vn = ((v32 - mu) * lax.rsqrt(var + EPS) * sgu_norm.astype(jnp.float32).reshape(SGU_HEADS, SGU_GROUP_DIM)).astype(v.dtype)
    vc = vn.reshape(B, nc, SGU_CHUNK, SGU_HEADS, SGU_GROUP_DIM)
    mixed = jnp.einsum('hpq,bnqhc->bnphc', sgu_w, vc) + sgu_b.T[None, None, :, :, None]
    return u * mixed.reshape(B, T, SGU_WIDTH)


def trunk_layer(l, x, cond, w_ada, b_ada, norm_pre, norm_post, w_in, w_out,
                attn_sink, pool_w, pool_scale, sgu_norm, sgu_w, sgu_b,
                rope, ctx_k, ctx_v):
    B, T, _ = x.shape
    j = l // 2
    mod = jax.nn.silu(cond) @ w_ada[l] + b_ada[l]
    shift, scale, gate = jnp.split(mod[:, None, :], 3, axis=-1)
    h = rmsnorm(x, norm_pre[l]) * (1 + scale) + shift
    proj = h @ w_in[l]
    k = v = None
    if l % 2 == 0:
        q, k, v, g_a, u_b, g_b = jnp.split(proj, EVEN_SPLITS, axis=-1)
        q = q.reshape(B, T, N_Q_HEADS, HEAD_DIM)
        k = k.reshape(B, T, N_KV_HEADS, HEAD_DIM)
        v = v.reshape(B, T, N_KV_HEADS, HEAD_DIM)
        sink = attn_sink[j].reshape(N_KV_HEADS, Q_PER_KV)
        if ctx_k is None:
            o_a = context_attention(q.reshape(B, T, N_KV_HEADS, Q_PER_KV, HEAD_DIM), k, v, sink)
        else:
            cos, sin = rope
            qr = apply_axial_rope(q, cos, sin).reshape(B, T, N_KV_HEADS, Q_PER_KV, HEAD_DIM)
            kr = apply_axial_rope(k, cos, sin)
            o_a = latent_window_attention(qr, kr, v, ctx_k, ctx_v, sink)
        o = jnp.concatenate([jax.nn.silu(g_a) * o_a, jax.nn.silu(g_b) * fourier_mix(u_b)], axis=-1)
    else:
        u_c, g_c, u_d, v_d, g_d = jnp.split(proj, ODD_SPLITS, axis=-1)
        o = jnp.concatenate([
            jax.nn.silu(g_c) * multiscale_pool(u_c, pool_w[j], pool_scale[j]),
            jax.nn.silu(g_d) * spatial_gating(u_d, v_d, sgu_norm[j], sgu_w[j], sgu_b[j])], axis=-1)
    x = x + gate * rmsnorm(o @ w_out[l], norm_post[l])
    return x, k, v


def setup_inputs(seed: int = 0) -> dict:
    key = jax.random.key(seed)
    ks = jax.random.split(key, 18)
    f32 = jnp.float32
    nrm = lambda k, shp: jax.random.normal(k, shp, f32)
    d_inv = D_MODEL ** -0.5
    return {
        "x_prompt": nrm(ks[0], (BATCH, SEQ, D_MODEL)),
        "x_sample": nrm(ks[1], (DEC_BATCH, DEC_SEQ, D_MODEL)),
        "cache_k": nrm(ks[2], (DEC_BATCH, N_ATTN_LAYERS, PAST_LEN, N_KV_HEADS, HEAD_DIM)),
        "cache_v": nrm(ks[3], (DEC_BATCH, N_ATTN_LAYERS, PAST_LEN, N_KV_HEADS, HEAD_DIM)),
        "c": nrm(ks[4], (DEC_BATCH, D_MODEL)),
        "c_ctx": nrm(ks[5], (D_MODEL,)),
        "w_ada": nrm(ks[6], (DEPTH, D_MODEL, 3 * D_MODEL)) * (0.5 * d_inv),
        "b_ada": nrm(ks[7], (DEPTH, 3 * D_MODEL)) * 0.02,
        "norm_pre": 1.0 + 0.02 * nrm(ks[8], (DEPTH, D_MODEL)),
        "norm_post": 1.0 + 0.02 * nrm(ks[9], (DEPTH, D_MODEL)),
        "w_in": nrm(ks[10], (DEPTH, D_MODEL, IN_WIDTH)) * d_inv,
        "w_out": nrm(ks[11], (DEPTH, MIX_WIDTH, D_MODEL)) * (MIX_WIDTH ** -0.5),
        "attn_sink": 0.5 * nrm(ks[12], (N_ATTN_LAYERS, N_Q_HEADS)),
        "pool_w": nrm(ks[13], (N_POOL_LAYERS, len(POOL_WINDOWS), POOL_GROUP_DIM, POOL_GROUP_DIM)) * (POOL_GROUP_DIM ** -0.5),
        "pool_scale": 1.0 + 0.02 * nrm(ks[14], (N_POOL_LAYERS, POOL_WIDTH)),
        "sgu_norm": 1.0 + 0.02 * nrm(ks[15], (N_POOL_LAYERS, SGU_WIDTH)),
        "sgu_w": nrm(ks[16], (N_POOL_LAYERS, SGU_HEADS, SGU_CHUNK, SGU_CHUNK)) * (SGU_CHUNK ** -0.5),
        "sgu_b": 1.0 + 0.02 * nrm(ks[17], (N_POOL_LAYERS, SGU_HEADS, SGU_CHUNK)),
    }


def reference(x_prompt, x_sample, cache_k, cache_v, c, c_ctx, w_ada, b_ada, norm_pre, norm_post,
              w_in, w_out, attn_sink, pool_w, pool_scale, sgu_norm, sgu_w, sgu_b):
    rope = axial_rope_tables(x_sample.shape[1])
    cond_ctx = c_ctx[None, :]
    xp = x_prompt
    xs = x_sample
    new_k = []
    new_v = []
    for l in range(DEPTH):
        j = l // 2
        xp, kp, vp = trunk_layer(l, xp, cond_ctx, w_ada, b_ada, norm_pre, norm_post, w_in, w_out,
                                 attn_sink, pool_w, pool_scale, sgu_norm, sgu_w, sgu_b,
                                 None, None, None)
        if l % 2 == 0:
            new_k.append(kp)
            new_v.append(vp)
            ck, cv = cache_k[:, j], cache_v[:, j]
        else:
            ck, cv = None, None
        xs, _, _ = trunk_layer(l, xs, c, w_ada, b_ada, norm_pre, norm_post, w_in, w_out,
                               attn_sink, pool_w, pool_scale, sgu_norm, sgu_w, sgu_b,
                               rope, ck, cv)
    new_cache_k = jnp.stack(new_k, axis=1)
    new_cache_v = jnp.stack(new_v, axis=1)
    return (xp, xs, new_cache_k, new_cache_v)
```

```cpp
#include <hip/hip_runtime.h>
#include <hip/hip_cooperative_groups.h>
#include <cstdio>
namespace cg = cooperative_groups;
namespace pg8 {
#define PG8_LAS __attribute__((address_space(3)))
typedef unsigned short bf16_t;
typedef short bf16x8 __attribute__((ext_vector_type(8)));
typedef float f32x4 __attribute__((ext_vector_type(4)));
typedef unsigned u32x4 __attribute__((ext_vector_type(4)));
constexpr int BM = 256, BK = 64, HALF = 128, HTB = HALF * BK * 2  , STAGE_BYTES = 8 * HTB, NXCD = 8, WGM = 8;

__host__ __device__ __forceinline__ int lds_byte(int r, int c) { const int st = (r >> 4) * 2 + (c >> 5), rr = r & 15, cc = c & 31, ob = rr * 64 + cc * 2; return st * 1024 + (ob ^ (((ob >> 9) & 1) << 5)); }
__host__ __device__ __forceinline__ void stage_rc(int b, int& R, int& C) { const int st = b / 1024, sb = b % 1024, swz = sb ^ (((sb >> 9) & 1) << 5); R = (st >> 1) * 16 + swz / 64; C = (st & 1) * 32 + (swz % 64) / 2; }
__host__ __device__ __forceinline__ int perm32(int rho) { const int n = rho >> 4, i = rho & 15; return 8 * (i >> 2) + 4 * n + (i & 3); }

struct Unit { int pm, pn; };
struct Gemm { const bf16_t* A; const bf16_t* Bt; int M, N, K; };

struct StaticOrder {
    int nM, nN, nwg, G, c;
    __host__ __device__ void init(int M, int N, int G_, int c_) { nM = M / BM; nN = N / BM; nwg = nM * nN; G = G_; c = c_; }
    __host__ __device__ bool next(int i, Unit& u) const {
        const long L = (long)i * G + c; if (L >= nwg) return false;
        int wgid = (int)L; { const int q = nwg / NXCD, r = nwg % NXCD, xcd = wgid % NXCD, off = wgid / NXCD; wgid = (xcd < r ? xcd * (q + 1) : r * (q + 1) + (xcd - r) * q) + off; }
        const int nig = WGM * nN, gid = wgid / nig, fm = gid * WGM, gsz = (nM - fm) < WGM ? (nM - fm) : WGM;
        u.pm = fm + ((wgid % nig) % gsz); u.pn = (wgid % nig) / gsz; return true;
    }
    __device__ __forceinline__ void a_ready(const Unit&) const {}
    __device__ __forceinline__ void done(const Unit&) const {}
};
__device__ __forceinline__ unsigned cvt_pk_bf16(float lo, float hi) { unsigned r; asm volatile("v_cvt_pk_bf16_f32 %0, %1, %2" : "=v"(r) : "v"(lo), "v"(hi)); return r; }
template <class Epi, class Sched, bool STAMP = false>
__device__ __forceinline__ void gemm_phase(PG8_LAS unsigned char* lds, const Gemm g, const Sched& S, const Epi& E, unsigned long long* stamps) {
    int tid_ = threadIdx.x; asm volatile("" : "+v"(tid_));
    const int tid = tid_, wid = __builtin_amdgcn_readfirstlane(tid >> 6), lane = tid & 63, wr = wid >> 2, wc = wid & 3, fr = lane & 15, fq = lane >> 4;
    const int K = g.K, nt = K / BK;
    int ts_lo = 0, ts_hi = 0, nts = 0; const unsigned long long rt_entry = STAMP ? (unsigned long long)wall_clock64() : 0ull;
#define PG8_STAMP() do { if (STAMP && wid == 0 && nts < 64) { const unsigned long long _c = (unsigned long long)clock64(); \
        ts_lo = (lane == nts) ? (int)(unsigned)_c : ts_lo; ts_hi = (lane == nts) ? (int)(unsigned)(_c >> 32) : ts_hi; ++nts; } } while (0)
    PG8_STAMP();
    unsigned voffA[2], voffB[2];
#pragma unroll
    for (int i = 0; i < 2; ++i) { int R, C; stage_rc(tid * 16 + i * 8192, R, C); const int Rb = Epi::PERM ? ((R & ~31) + perm32(R & 31)) : R;
        voffA[i] = (unsigned)(R * K + C) * 2u; voffB[i] = (unsigned)(Rb * K + C) * 2u; }
    const size_t kstep = (size_t)(BK * 2);
    const size_t hstep = (size_t)HALF * K * 2;
    const size_t tstep = 2 * hstep;
    const unsigned ldsw = (unsigned)wid * 1024u;
    const int aoff = lds_byte(wr * 64 + fr, fq * 8), boff = lds_byte(wc * 32 + fr, fq * 8);
#define PG8_SA(b, h) (((b) * 2 + (h)) * HTB)
#define PG8_SB(b, h) ((4 + (b) * 2 + (h)) * HTB)
#define PG8_STAGE(bufoff, gbase, voff) do { _Pragma("unroll") for (int _i = 0; _i < 2; ++_i) \
        __builtin_amdgcn_global_load_lds((const unsigned*)((const char*)(gbase) + (voff)[_i]), (PG8_LAS unsigned*)(lds + (bufoff) + ldsw + _i * 8192), 16, 0, 0); } while (0)
#define PG8_LDA(dst, b, h) do { _Pragma("unroll") for (int m = 0; m < 4; ++m) _Pragma("unroll") for (int k = 0; k < 2; ++k) dst[m][k] = *(const PG8_LAS bf16x8*)(lds + PG8_SA(b, h) + aoff + m * 2048 + k * 1024); } while (0)
#define PG8_LDB(dst, b, h) do { _Pragma("unroll") for (int n = 0; n < 2; ++n) _Pragma("unroll") for (int k = 0; k < 2; ++k) dst[n][k] = *(const PG8_LAS bf16x8*)(lds + PG8_SB(b, h) + boff + n * 2048 + k * 1024); } while (0)
#define PG8_MMA(ai, bj, At, Bt) do { __builtin_amdgcn_s_setprio(1); _Pragma("unroll") for (int m = 0; m < 4; ++m) _Pragma("unroll") for (int n = 0; n < 2; ++n) _Pragma("unroll") for (int k = 0; k < 2; ++k) \
        acc[ai][bj][m][n] = __builtin_amdgcn_mfma_f32_16x16x32_bf16(Bt[n][k], At[m][k], acc[ai][bj][m][n], 0, 0, 0); __builtin_amdgcn_s_setprio(0); } while (0)
#define PG8_WAIT_V(n) asm volatile("s_waitcnt vmcnt(" #n ")" ::: "memory")
#define PG8_WAIT_L(n) asm volatile("s_waitcnt lgkmcnt(" #n ")" ::: "memory")
#define PG8_BAR __builtin_amdgcn_s_barrier()
#define PG8_SCHED __builtin_amdgcn_sched_barrier(0)
    Unit cur, nxt; int ui = 0;
    if (!S.next(0, cur)) return;
    f32x4 acc[2][2][4][2];
#pragma unroll
    for (int a = 0; a < 2; ++a)
#pragma unroll
        for (int b = 0; b < 2; ++b)
#pragma unroll
            for (int m = 0; m < 4; ++m)
#pragma unroll
                for (int n = 0; n < 2; ++n) acc[a][b][m][n] = (f32x4){0.f, 0.f, 0.f, 0.f};
    bf16x8 At[4][2], B0[2][2], B1[2][2];
    const char* cA = (const char*)g.A + (size_t)cur.pm * tstep; const char* cB = (const char*)g.Bt + (size_t)cur.pn * tstep;
    S.a_ready(cur);
    PG8_STAGE(PG8_SB(0, 0), cB, voffB); PG8_STAGE(PG8_SA(0, 0), cA, voffA); PG8_STAGE(PG8_SB(0, 1), cB + hstep, voffB); PG8_STAGE(PG8_SA(0, 1), cA + hstep, voffA);
    if (wr == 1) PG8_BAR;
    PG8_WAIT_V(4); PG8_BAR;
    PG8_STAGE(PG8_SB(1, 0), cB + kstep, voffB); PG8_STAGE(PG8_SA(1, 0), cA + kstep, voffA); PG8_STAGE(PG8_SB(1, 1), cB + hstep + kstep, voffB);
    PG8_WAIT_V(6); PG8_BAR;
    PG8_STAMP();
    for (;;) {
        const bool has_next = S.next(ui + 1, nxt);
        const char* nA = has_next ? (const char*)g.A + (size_t)nxt.pm * tstep : cA; const char* nB = has_next ? (const char*)g.Bt + (size_t)nxt.pn * tstep : cB;
        for (int t = 0; t < nt; t += 2) {
            const bool last = (t == nt - 2);
            const char* a1 = cA + (size_t)(t + 1) * kstep;
            const char* a2 = last ? nA : cA + (size_t)(t + 2) * kstep; const char* b2 = last ? nB : cB + (size_t)(t + 2) * kstep;
            const char* a3 = a2 + kstep; const char* b3 = b2 + kstep;
            if (last && has_next) S.a_ready(nxt);
            PG8_LDB(B0, 0, 0); PG8_SCHED; PG8_LDA(At, 0, 0); PG8_STAGE(PG8_SA(1, 1), a1 + hstep, voffA);
            PG8_WAIT_L(8); PG8_BAR; PG8_WAIT_L(0); PG8_MMA(0, 0, At, B0); PG8_BAR; PG8_SCHED;
            PG8_LDB(B1, 0, 1); PG8_STAGE(PG8_SB(0, 0), b2, voffB);
            PG8_BAR; PG8_WAIT_L(0); PG8_MMA(0, 1, At, B1); PG8_BAR;
            PG8_LDA(At, 0, 1); PG8_STAGE(PG8_SA(0, 0), a2, voffA);
            PG8_BAR; PG8_WAIT_L(0); PG8_MMA(1, 0, At, B0); PG8_BAR; PG8_SCHED;
            PG8_STAGE(PG8_SB(0, 1), b2 + hstep, voffB);
            PG8_WAIT_V(6); PG8_BAR; PG8_MMA(1, 1, At, B1); PG8_BAR;
            PG8_LDB(B0, 1, 0); PG8_SCHED; PG8_LDA(At, 1, 0); PG8_STAGE(PG8_SA(0, 1), a2 + hstep, voffA);
            PG8_WAIT_L(8); PG8_BAR; PG8_WAIT_L(0); PG8_MMA(0, 0, At, B0); PG8_BAR; PG8_SCHED;
            PG8_LDB(B1, 1, 1); PG8_STAGE(PG8_SB(1, 0), b3, voffB);
            PG8_BAR; PG8_WAIT_L(0); PG8_MMA(0, 1, At, B1); PG8_BAR;
            PG8_LDA(At, 1, 1); PG8_STAGE(PG8_SA(1, 0), a3, voffA);
            PG8_BAR; PG8_WAIT_L(0); PG8_MMA(1, 0, At, B0); PG8_BAR; PG8_SCHED;
            PG8_STAGE(PG8_SB(1, 1), b3 + hstep, voffB);
            PG8_WAIT_V(6); PG8_BAR; PG8_MMA(1, 1, At, B1); PG8_BAR;
        }
        PG8_STAMP();
        if constexpr (!Epi::AFTER_DRAIN) { E(acc, cur, wr, wc, fr, fq); S.done(cur); }
        PG8_STAMP();
        if (!has_next) break;
#pragma unroll
        for (int a = 0; a < 2; ++a)
#pragma unroll
            for (int b = 0; b < 2; ++b)
#pragma unroll
                for (int m = 0; m < 4; ++m)
#pragma unroll
                    for (int n = 0; n < 2; ++n) acc[a][b][m][n] = (f32x4){0.f, 0.f, 0.f, 0.f};
        cur = nxt; cA = nA; cB = nB; ++ui;
    }
    PG8_WAIT_V(0);
    if (wr == 0) PG8_BAR;
    PG8_BAR;
    if constexpr (Epi::AFTER_DRAIN) { E.fused(acc, cur, wr, wc, fr, fq, lds, wid, lane); S.done(cur); }
    PG8_STAMP();
    if (STAMP && wid == 0) { stamps[lane] = lane < nts ? (((unsigned long long)(unsigned)ts_hi << 32) | (unsigned)ts_lo) : 0ull;
        if (lane == 62) stamps[62] = rt_entry; if (lane == 63) stamps[63] = (unsigned long long)wall_clock64(); }
#undef PG8_STAMP
#undef PG8_SA
#undef PG8_SB
#undef PG8_STAGE
#undef PG8_LDA
#undef PG8_LDB
#undef PG8_MMA
#undef PG8_WAIT_V
#undef PG8_WAIT_L
#undef PG8_BAR
#undef PG8_SCHED
}
}


using pg8::bf16_t; using pg8::bf16x8; using pg8::f32x4; using pg8::u32x4; using pg8::cvt_pk_bf16;
typedef float f32x16 __attribute__((ext_vector_type(16)));
typedef short bf16x4 __attribute__((ext_vector_type(4)));
typedef unsigned u32x2 __attribute__((ext_vector_type(2)));
#define LAS __attribute__((address_space(3)))

constexpr int DM = 2048, MROWS = 12288, NPROMPT = 8192, INW = 5120;
constexpr float LOG2E = 1.4426950408889634f;

constexpr size_t OFF_WTIN  = 0;
constexpr size_t OFF_WTOUT = OFF_WTIN  + (size_t)4 * 5120 * 2048 * 2;
constexpr size_t OFF_MOD   = OFF_WTOUT + (size_t)4 * 2048 * 2048 * 2;
constexpr size_t OFF_H     = OFF_MOD   + (size_t)4 * 3 * 6144 * 4;
constexpr size_t OFF_PROJ  = OFF_H     + (size_t)MROWS * 2048 * 2;
constexpr size_t OFF_O     = OFF_PROJ  + (size_t)MROWS * 5120 * 2;
constexpr size_t OFF_Y     = OFF_O     + (size_t)MROWS * 2048 * 2;
constexpr size_t OFF_VT    = OFF_Y     + (size_t)MROWS * 2048 * 4;
constexpr size_t OFF_CTXK  = OFF_VT    + (size_t)MROWS * 512 * 2;
constexpr size_t OFF_CTXVT = OFF_CTXK  + (size_t)2 * 2 * 256 * 512 * 2;
constexpr size_t OFF_YTP   = OFF_CTXVT + (size_t)2 * 2 * 256 * 512 * 2;
constexpr size_t OFF_YTS   = OFF_YTP   + (size_t)32 * 512 * 512 * 2;
constexpr size_t OFF_TW256 = OFF_YTS   + (size_t)2 * 512 * 4096 * 2;
constexpr size_t OFF_TW2K  = OFF_TW256 + (size_t)256 * 512 * 2;
constexpr size_t OFF_CCS   = OFF_TW2K  + (size_t)2048 * 4096 * 2;
constexpr size_t OFF_POOLW = OFF_CCS   + (size_t)256 * 128 * 2;
constexpr size_t OFF_SGUW  = OFF_POOLW + (size_t)2 * 4 * 256 * 256 * 2;
constexpr size_t WS_NEED   = OFF_SGUW  + (size_t)2 * 4 * 128 * 128 * 2;

struct Params { const float* in[18]; float* out; unsigned char* ws; };
enum { I_XP = 0, I_XS, I_CK, I_CV, I_C, I_CCTX, I_WADA, I_BADA, I_NPRE, I_NPOST, I_WIN, I_WOUT, I_SINK, I_POOLW, I_POOLS, I_SGUN, I_SGUW, I_SGUB };

__device__ __forceinline__ int my_tid() { int t = threadIdx.x; asm volatile("" : "+v"(t)); return t; }
__device__ __forceinline__ float bflo(unsigned w) { return __uint_as_float(w << 16); }
__device__ __forceinline__ float bfhi(unsigned w) { return __uint_as_float(w & 0xffff0000u); }
__device__ __forceinline__ float bf1(bf16_t b) { return __uint_as_float(((unsigned)b) << 16); }
__device__ __forceinline__ float silu(float x) { return x * __builtin_amdgcn_rcpf(1.f + __builtin_amdgcn_exp2f(-1.4426950408889634f * x)); }
__device__ __forceinline__ bf16_t f2bf(float f) { return (bf16_t)(cvt_pk_bf16(f, 0.f) & 0xffffu); }
__device__ __forceinline__ float wave_sum(float v) {
#pragma unroll
    for (int o = 32; o >= 1; o >>= 1) v += __shfl_xor(v, o);
    return v;
}
__device__ __forceinline__ bf16x8 ld16(const bf16_t* p) { return *(const bf16x8*)p; }
__device__ __forceinline__ bf16x8 ld8x2(const bf16_t* p0, const bf16_t* p1) {
    const bf16x4 a = *(const bf16x4*)p0, b = *(const bf16x4*)p1;
    return __builtin_shufflevector(a, b, 0, 1, 2, 3, 4, 5, 6, 7);
}
__device__ __forceinline__ f32x16 mfma32(bf16x8 a, bf16x8 b, f32x16 c) { return __builtin_amdgcn_mfma_f32_32x32x16_bf16(a, b, c, 0, 0, 0); }

__device__ void phase0(const Params& p, unsigned char* smem) {
    float* sc = (float*)smem;
    float* tile = sc + 3 * 2048;
    float* red = tile + 64 * 65;
    const int tid = my_tid(), wave = tid >> 6, lane = tid & 63;
    for (int i = tid; i < 3 * 2048; i += 512) {
        const int ci = i >> 11, k = i & 2047;
        const float v = ci == 0 ? p.in[I_CCTX][k] : p.in[I_C][(ci - 1) * 2048 + k];
        sc[i] = silu(v);
    }
    __syncthreads();
    constexpr int NG = 384, NTI = 10240, NTO = 4096;
    bf16_t* wtin = (bf16_t*)(p.ws + OFF_WTIN); bf16_t* wtout = (bf16_t*)(p.ws + OFF_WTOUT);
    float* mod = (float*)(p.ws + OFF_MOD);
    for (int item = blockIdx.x; item < NG + NTI + NTO; item += gridDim.x) {
        if (item < NG) {
            const int l = item / 96, n0 = (item % 96) * 64;
            const float* wp = p.in[I_WADA] + ((size_t)l * 2048 + wave * 256) * 6144 + n0 + lane;
            const float* s0 = sc + wave * 256;
            float a0 = 0.f, a1 = 0.f, a2 = 0.f;
#pragma unroll 16
            for (int kk = 0; kk < 256; ++kk) {
                const float wv = wp[(size_t)kk * 6144];
                a0 += s0[kk] * wv; a1 += s0[2048 + kk] * wv; a2 += s0[4096 + kk] * wv;
            }
            red[(wave * 3 + 0) * 64 + lane] = a0; red[(wave * 3 + 1) * 64 + lane] = a1; red[(wave * 3 + 2) * 64 + lane] = a2;
            __syncthreads();
            if (tid < 192) {
                const int ci = tid >> 6, col = tid & 63;
                float s = p.in[I_BADA][l * 6144 + n0 + col];
#pragma unroll
                for (int w = 0; w < 8; ++w) s += red[(w * 3 + ci) * 64 + col];
                mod[(l * 3 + ci) * 6144 + n0 + col] = s;
            }
            __syncthreads();
        } else {
            int it = item - NG; const float* src; bf16_t* dst; int N, kt, nt;
            if (it < NTI) { const int l = it / 2560, r = it % 2560; kt = r / 80; nt = r % 80; N = 5120; src = p.in[I_WIN] + (size_t)l * 2048 * 5120; dst = wtin + (size_t)l * 5120 * 2048; }
            else { it -= NTI; const int l = it >> 10, r = it & 1023; kt = r >> 5; nt = r & 31; N = 2048; src = p.in[I_WOUT] + (size_t)l * 2048 * 2048; dst = wtout + (size_t)l * 2048 * 2048; }
            const int k0 = kt * 64, n0 = nt * 64;
            {
                const int rr = tid >> 4, c4 = (tid & 15) * 4;
#pragma unroll
                for (int i = 0; i < 2; ++i) {
                    const int row = rr + 32 * i;
                    const f32x4 v = *(const f32x4*)(src + (size_t)(k0 + row) * N + n0 + c4);
                    tile[row * 65 + c4 + 0] = v[0]; tile[row * 65 + c4 + 1] = v[1]; tile[row * 65 + c4 + 2] = v[2]; tile[row * 65 + c4 + 3] = v[3];
                }
            }
            __syncthreads();
            {
                const int n = tid >> 3, kq = tid & 7;
                float v[8];
#pragma unroll
                for (int j = 0; j < 8; ++j) v[j] = tile[(kq * 8 + j) * 65 + n];
                u32x4 w; w.x = cvt_pk_bf16(v[0], v[1]); w.y = cvt_pk_bf16(v[2], v[3]); w.z = cvt_pk_bf16(v[4], v[5]); w.w = cvt_pk_bf16(v[6], v[7]);
                *(u32x4*)(dst + (size_t)(n0 + n) * 2048 + k0 + kq * 8) = w;
            }
            __syncthreads();
        }
    }
    const int gt = blockIdx.x * 512 + tid, NT = gridDim.x * 512;
    {
        bf16_t* o = (bf16_t*)(p.ws + OFF_POOLW);
        for (int idx = gt; idx < 2 * 4 * 256 * 256; idx += NT) { const int lg = idx >> 16, d = (idx >> 8) & 255, c = idx & 255; o[idx] = f2bf(p.in[I_POOLW][(lg * 256 + c) * 256 + d]); }
    }
    {
        bf16_t* o = (bf16_t*)(p.ws + OFF_SGUW);
        for (int idx = gt; idx < 2 * 4 * 128 * 128; idx += NT) o[idx] = f2bf(p.in[I_SGUW][idx]);
    }
    {
        bf16_t* o = (bf16_t*)(p.ws + OFF_CCS);
        for (int idx = gt; idx < 256 * 128; idx += NT) {
            const int R = idx >> 7, c = idx & 127, cs = R >> 7, cp = R & 127; const float x = (float)((c * cp) & 127) * (1.f / 128.f);
            const float v = cs ? __builtin_amdgcn_sinf(x) : __builtin_amdgcn_cosf(x);
            o[idx] = f2bf(v * 0.08838834764831845f);
        }
    }
    {
        bf16_t* o = (bf16_t*)(p.ws + OFF_TW256);
        for (int idx = gt; idx < 256 * 512; idx += NT) {
            const int tp = idx >> 9, k = idx & 511, t = k & 255, isS = k >> 8; const float x = (float)((t * tp) & 255) * (1.f / 256.f);
            const float v = isS ? -__builtin_amdgcn_sinf(x) : __builtin_amdgcn_cosf(x);
            o[idx] = f2bf(v * 0.0625f);
        }
    }
    {
        unsigned* o = (unsigned*)(p.ws + OFF_TW2K);
        for (int idx = gt; idx < 2048 * 2048; idx += NT) {
            const int tp = idx >> 11, k = (idx & 2047) * 2, t = k & 2047, isS = k >> 11;
            const float x0 = (float)((t * tp) & 2047) * (1.f / 2048.f), x1 = (float)(((t + 1) * tp) & 2047) * (1.f / 2048.f);
            const float v0 = isS ? -__builtin_amdgcn_sinf(x0) : __builtin_amdgcn_cosf(x0);
            const float v1 = isS ? -__builtin_amdgcn_sinf(x1) : __builtin_amdgcn_cosf(x1);
            o[idx] = cvt_pk_bf16(v0 * 0.022097086912079608f, v1 * 0.022097086912079608f);
        }
    }
    {
        bf16_t* ok = (bf16_t*)(p.ws + OFF_CTXK); bf16_t* ov = (bf16_t*)(p.ws + OFF_CTXVT);
        for (int idx = gt; idx < 2 * 2 * 256 * 512; idx += NT) {
            ok[idx] = f2bf(p.in[I_CK][idx]);
            const int t = idx & 255, dim = (idx >> 8) & 127, kvh = (idx >> 15) & 3, bj = idx >> 17;
            ov[idx] = f2bf(p.in[I_CV][((bj * 256 + t) * 4 + kvh) * 128 + dim]);
        }
    }
}

__device__ void phase_rows(const Params& p, const int l) {
    const int tid = my_tid(), wave = tid >> 6, lane = tid & 63;
    const float* mod = (const float*)(p.ws + OFF_MOD);
    const float* ybuf = (const float*)(p.ws + OFF_Y);
    bf16_t* hbuf = (bf16_t*)(p.ws + OFF_H);
    for (int row = blockIdx.x * 8 + wave; row < MROWS; row += gridDim.x * 8) {
        const int ci = row < NPROMPT ? 0 : 1 + ((row - NPROMPT) >> 11);
        const float* xs = (l <= 0) ? (row < NPROMPT ? p.in[I_XP] + (size_t)row * DM : p.in[I_XS] + (size_t)(row - NPROMPT) * DM) : p.out + (size_t)row * DM;
        f32x4 x[8];
#pragma unroll
        for (int i = 0; i < 8; ++i) x[i] = *(const f32x4*)(xs + i * 256 + lane * 4);
        if (l >= 0) {
            f32x4 y[8]; float ss = 0.f;
#pragma unroll
            for (int i = 0; i < 8; ++i) { y[i] = *(const f32x4*)(ybuf + (size_t)row * DM + i * 256 + lane * 4); ss += y[i][0] * y[i][0] + y[i][1] * y[i][1] + y[i][2] * y[i][2] + y[i][3] * y[i][3]; }
            ss = wave_sum(ss);
            const float r = rsqrtf(ss * (1.f / 2048.f) + 1e-6f);
            const float* gate = mod + (l * 3 + ci) * 6144 + 4096; const float* np = p.in[I_NPOST] + l * 2048;
#pragma unroll
            for (int i = 0; i < 8; ++i) {
                const f32x4 g = *(const f32x4*)(gate + i * 256 + lane * 4), w = *(const f32x4*)(np + i * 256 + lane * 4);
#pragma unroll
                for (int e = 0; e < 4; ++e) x[i][e] += g[e] * (y[i][e] * r * w[e]);
                *(f32x4*)(p.out + (size_t)row * DM + i * 256 + lane * 4) = x[i];
            }
        }
        if (l < 3) {
            const int l1 = l + 1;
            float ss = 0.f;
#pragma unroll
            for (int i = 0; i < 8; ++i) ss += x[i][0] * x[i][0] + x[i][1] * x[i][1] + x[i][2] * x[i][2] + x[i][3] * x[i][3];
            ss = wave_sum(ss);
            const float r = rsqrtf(ss * (1.f / 2048.f) + 1e-6f);
            const float* shift = mod + (l1 * 3 + ci) * 6144; const float* scale = shift + 2048; const float* np = p.in[I_NPRE] + l1 * 2048;
#pragma unroll
            for (int i = 0; i < 8; ++i) {
                const f32x4 sh = *(const f32x4*)(shift + i * 256 + lane * 4), sl = *(const f32x4*)(scale + i * 256 + lane * 4), w = *(const f32x4*)(np + i * 256 + lane * 4);
                float hv[4];
#pragma unroll
                for (int e = 0; e < 4; ++e) hv[e] = (x[i][e] * r * w[e]) * (1.f + sl[e]) + sh[e];
                u32x2 o; o.x = cvt_pk_bf16(hv[0], hv[1]); o.y = cvt_pk_bf16(hv[2], hv[3]);
                *(u32x2*)(hbuf + (size_t)row * DM + i * 256 + lane * 4) = o;
            }
        }
    }
}

struct EpiProj {
    static constexpr bool PERM = true, AFTER_DRAIN = false;
    bf16_t* O; float* outk; float* outv; int even, j;
    __device__ __forceinline__ void operator()(const f32x4 (&acc)[2][2][4][2], const pg8::Unit& u, int wr, int wc, int fr, int fq) const {
        asm volatile("" : "+v"(fr), "+v"(fq));
        const int rloc0 = wr * 64 + fr, col0 = u.pn * 256 + wc * 32 + 8 * fq;
        const bool kv = even && u.pm < 32 && u.pn >= 6 && u.pn < 10;
        float* cbase = nullptr;
        if (kv) cbase = (u.pn < 8 ? outk : outv) + ((size_t)(u.pm * 2 + j) * 256) * 512 + ((u.pn & 1) * 256 + wc * 32 + 8 * fq);
#pragma unroll
        for (int ai = 0; ai < 2; ++ai)
#pragma unroll
            for (int m = 0; m < 4; ++m) {
                const int rloc = rloc0 + ai * 128 + m * 16;
                bf16_t* rowp = O + (size_t)(u.pm * 256 + rloc) * INW + col0;
#pragma unroll
                for (int bj = 0; bj < 2; ++bj) {
                    const f32x4 v0 = acc[ai][bj][m][0], v1 = acc[ai][bj][m][1];
                    u32x4 w; w.x = cvt_pk_bf16(v0[0], v0[1]); w.y = cvt_pk_bf16(v0[2], v0[3]); w.z = cvt_pk_bf16(v1[0], v1[1]); w.w = cvt_pk_bf16(v1[2], v1[3]);
                    *(u32x4*)(rowp + bj * 128) = w;
                    if (kv) { float* cp = cbase + (size_t)rloc * 512 + bj * 128; *(f32x4*)cp = v0; *(f32x4*)(cp + 4) = v1; }
                    __builtin_amdgcn_sched_barrier(0);
                }
            }
    }
};
struct EpiY {
    static constexpr bool PERM = false, AFTER_DRAIN = false;
    float* C;
    __device__ __forceinline__ void operator()(const f32x4 (&acc)[2][2][4][2], const pg8::Unit& u, int wr, int wc, int fr, int fq) const {
        asm volatile("" : "+v"(fr), "+v"(fq));
        const int row0 = u.pm * 256 + wr * 64 + fr, col0 = u.pn * 256 + wc * 32 + 4 * fq;
#pragma unroll
        for (int ai = 0; ai < 2; ++ai)
#pragma unroll
            for (int m = 0; m < 4; ++m) {
                float* rowp = C + (size_t)(row0 + ai * 128 + m * 16) * DM + col0;
#pragma unroll
                for (int bj = 0; bj < 2; ++bj)
#pragma unroll
                    for (int n = 0; n < 2; ++n) *(f32x4*)(rowp + bj * 128 + n * 16) = acc[ai][bj][m][n];
            }
    }
};
struct EpiFnet {
    static constexpr bool PERM = true, AFTER_DRAIN = false;
    const bf16_t* proj; bf16_t* O; int rowbase0, T;
    __device__ __forceinline__ void operator()(const f32x4 (&acc)[2][2][4][2], const pg8::Unit& u, int wr, int wc, int fr, int fq) const {
        asm volatile("" : "+v"(fr), "+v"(fq));
        const int row0 = rowbase0 + (u.pn >> 1) * T + u.pm * 256 + wr * 64 + fr, col0 = (u.pn & 1) * 256 + wc * 32 + 8 * fq;
#pragma unroll
        for (int ai = 0; ai < 2; ++ai)
#pragma unroll
            for (int m = 0; m < 4; ++m) {
                const size_t row = (size_t)(row0 + ai * 128 + m * 16);
#pragma unroll
                for (int bj = 0; bj < 2; ++bj) {
                    const u32x4 g = *(const u32x4*)(proj + row * INW + 4608 + col0 + bj * 128);
                    const f32x4 v0 = acc[ai][bj][m][0], v1 = acc[ai][bj][m][1];
                    u32x4 w;
                    w.x = cvt_pk_bf16(v0[0] * silu(bflo(g.x)), v0[1] * silu(bfhi(g.x))); w.y = cvt_pk_bf16(v0[2] * silu(bflo(g.y)), v0[3] * silu(bfhi(g.y)));
                    w.z = cvt_pk_bf16(v1[0] * silu(bflo(g.z)), v1[1] * silu(bfhi(g.z))); w.w = cvt_pk_bf16(v1[2] * silu(bflo(g.w)), v1[3] * silu(bfhi(g.w)));
                    *(u32x4*)(O + row * DM + 1536 + col0 + bj * 128) = w;
                    __builtin_amdgcn_sched_barrier(0);
                }
            }
    }
};

__device__ void phase_even_prep(const Params& p) {
    const int tid = my_tid(), wave = tid >> 6, lane = tid & 63, l32 = lane & 31, h = lane >> 5;
    bf16_t* proj = (bf16_t*)(p.ws + OFF_PROJ);
    const bf16_t* ccs = (const bf16_t*)(p.ws + OFF_CCS);
    for (int task = blockIdx.x * 8 + wave; task < 384 * 4; task += gridDim.x * 8) {
        const int rb = task >> 2, g = task & 3, row0 = rb * 32;
        bf16x8 af[8];
        const bf16_t* ap = proj + (size_t)(row0 + l32) * INW + 4096 + g * 128 + 8 * h;
#pragma unroll
        for (int s = 0; s < 8; ++s) af[s] = ld16(ap + 16 * s);
        bf16_t* yt; int T, tl0;
        if (row0 < NPROMPT) { T = 256; tl0 = row0 & 255; yt = (bf16_t*)(p.ws + OFF_YTP) + (size_t)(row0 >> 8) * 512 * 512; }
        else { T = 2048; tl0 = (row0 - NPROMPT) & 2047; yt = (bf16_t*)(p.ws + OFF_YTS) + (size_t)((row0 - NPROMPT) >> 11) * 512 * 4096; }
#pragma unroll 1
        for (int nt = 0; nt < 8; ++nt) {
            const int R = nt * 32 + l32;
            const bf16_t* bp = ccs + R * 128 + 8 * h;
            f32x16 acc;
#pragma unroll
            for (int r = 0; r < 16; ++r) acc[r] = 0.f;
#pragma unroll
            for (int s = 0; s < 8; ++s) acc = mfma32(af[s], ld16(bp + 16 * s), acc);
            const int cs = R >> 7, cp = R & 127;
            bf16_t* dst = yt + (size_t)(g * 128 + cp) * (2 * T) + cs * T + tl0 + 4 * h;
#pragma unroll
            for (int q = 0; q < 4; ++q) {
                u32x2 w; w.x = cvt_pk_bf16(acc[4 * q], acc[4 * q + 1]); w.y = cvt_pk_bf16(acc[4 * q + 2], acc[4 * q + 3]);
                *(u32x2*)(dst + 8 * q) = w;
            }
        }
    }
    const int gt = blockIdx.x * 512 + tid, NT = gridDim.x * 512;
    for (int idx = gt; idx < 4096 * 16 * 2 * 4; idx += NT) {
        const int ib = idx & 3, a = (idx >> 2) & 1, head = (idx >> 3) & 15, rs = idx >> 7;
        const int t = rs & 2047; const float pos = (float)(a == 0 ? (t >> 6) : (t & 63));
        bf16_t* x1p = proj + (size_t)(NPROMPT + rs) * INW + head * 128 + a * 64 + ib * 8;
        const u32x4 x1 = *(const u32x4*)x1p, x2 = *(const u32x4*)(x1p + 32);
        u32x4 o1, o2;
#pragma unroll
        for (int e = 0; e < 4; ++e) {
            const unsigned w1 = e == 0 ? x1.x : e == 1 ? x1.y : e == 2 ? x1.z : x1.w, w2 = e == 0 ? x2.x : e == 1 ? x2.y : e == 2 ? x2.z : x2.w;
            float r1[2], r2[2];
#pragma unroll
            for (int q = 0; q < 2; ++q) {
                const int i = ib * 8 + e * 2 + q;
                const float inv = __builtin_amdgcn_exp2f(-(float)i * (13.287712379549449f / 32.f));
                const float rev = pos * inv * 0.15915494309189535f;
                const float cc = __builtin_amdgcn_cosf(rev), sn = __builtin_amdgcn_sinf(rev);
                const float a1 = q ? bfhi(w1) : bflo(w1), a2 = q ? bfhi(w2) : bflo(w2);
                r1[q] = a1 * cc - a2 * sn; r2[q] = a2 * cc + a1 * sn;
            }
            const unsigned p1 = cvt_pk_bf16(r1[0], r1[1]), p2 = cvt_pk_bf16(r2[0], r2[1]);
            if (e == 0) { o1.x = p1; o2.x = p2; } else if (e == 1) { o1.y = p1; o2.y = p2; } else if (e == 2) { o1.z = p1; o2.z = p2; } else { o1.w = p1; o2.w = p2; }
        }
        *(u32x4*)x1p = o1; *(u32x4*)(x1p + 32) = o2;
    }
    bf16_t* vt = (bf16_t*)(p.ws + OFF_VT);
    for (int idx = gt; idx < 1536 * 512; idx += NT) {
        const int cd = idx & 511, r8 = idx >> 9, row0 = r8 * 8;
        int rowbase, T;
        if (row0 < NPROMPT) { rowbase = row0 & ~255; T = 256; } else { rowbase = NPROMPT + ((row0 - NPROMPT) & ~2047); T = 2048; }
        const bf16_t* src = proj + (size_t)row0 * INW + 2048 + cd;
        unsigned short v[8];
#pragma unroll
        for (int j = 0; j < 8; ++j) v[j] = src[(size_t)j * INW];
        u32x4 w; w.x = v[0] | ((unsigned)v[1] << 16); w.y = v[2] | ((unsigned)v[3] << 16); w.z = v[4] | ((unsigned)v[5] << 16); w.w = v[6] | ((unsigned)v[7] << 16);
        *(u32x4*)(vt + (size_t)rowbase * 512 + (size_t)cd * T + (row0 - rowbase)) = w;
    }
}

template <bool MASK>
__device__ __forceinline__ void attn_tile(const bf16x8 (&qf)[8], f32x16 (&oacc)[4], float& m, float& lsum,
                                          const bf16_t* kptr, const bf16_t* vptr, const size_t vstride, const int dqk  ) {
    f32x16 s;
#pragma unroll
    for (int r = 0; r < 16; ++r) s[r] = 0.f;
#pragma unroll
    for (int ks = 0; ks < 8; ++ks) s = mfma32(ld16(kptr + 16 * ks), qf[ks], s);
    constexpr float sc = 0.08838834764831845f * LOG2E;
    float tmax = -3.0e38f;
#pragma unroll
    for (int r = 0; r < 16; ++r) {
        float v = s[r] * sc;
        if (MASK) { const int d = dqk - (8 * (r >> 2) + (r & 3)); if (d > 128 || d < -128) v = -1.0e30f; }
        s[r] = v; tmax = fmaxf(tmax, v);
    }
    tmax = fmaxf(tmax, __shfl_xor(tmax, 32));
    const float mn = fmaxf(m, tmax), alpha = __builtin_amdgcn_exp2f(m - mn);
    m = mn;
    float ps = 0.f;
#pragma unroll
    for (int r = 0; r < 16; ++r) { s[r] = __builtin_amdgcn_exp2f(s[r] - mn); ps += s[r]; }
    lsum = lsum * alpha + ps;
#pragma unroll
    for (int dt = 0; dt < 4; ++dt)
#pragma unroll
        for (int r = 0; r < 16; ++r) oacc[dt][r] *= alpha;
    bf16x8 pb[2];
#pragma unroll
    for (int c = 0; c < 2; ++c) {
        u32x4 w; w.x = cvt_pk_bf16(s[8 * c + 0], s[8 * c + 1]); w.y = cvt_pk_bf16(s[8 * c + 2], s[8 * c + 3]); w.z = cvt_pk_bf16(s[8 * c + 4], s[8 * c + 5]); w.w = cvt_pk_bf16(s[8 * c + 6], s[8 * c + 7]);
        pb[c] = __builtin_bit_cast(bf16x8, w);
    }
#pragma unroll
    for (int dt = 0; dt < 4; ++dt)
#pragma unroll
        for (int c = 0; c < 2; ++c) {
            const bf16_t* vp = vptr + (size_t)(32 * dt) * vstride + 16 * c;
            oacc[dt] = mfma32(ld8x2(vp, vp + 8), pb[c], oacc[dt]);
        }
}

__device__ void attn_task(const Params& p, const int task, const int j) {
    const int lane = my_tid() & 63, l32 = lane & 31, h = lane >> 5;
    int rowbase, T, qb, qh, bs = -1;
    if (task < 1536) { bs = task / 768; const int rem = task % 768; qh = rem >> 6; qb = rem & 63; rowbase = NPROMPT + bs * 2048; T = 2048; }
    else { const int t2 = task - 1536; const int seq = t2 / 96, rem = t2 % 96; qh = rem >> 3; qb = rem & 7; rowbase = seq * 256; T = 256; }
    const int kvh = qh / 3, q0 = qb * 32;
    const bf16_t* proj = (const bf16_t*)(p.ws + OFF_PROJ);
    const bf16_t* vt = (const bf16_t*)(p.ws + OFF_VT);
    bf16x8 qf[8];
    {
        const bf16_t* qp = proj + (size_t)(rowbase + q0 + l32) * INW + qh * 128 + 8 * h;
#pragma unroll
        for (int s = 0; s < 8; ++s) qf[s] = ld16(qp + 16 * s);
    }
    float m = p.in[I_SINK][j * 12 + qh] * LOG2E, lsum = (h == 0) ? 1.f : 0.f;
    f32x16 oacc[4];
#pragma unroll
    for (int dt = 0; dt < 4; ++dt)
#pragma unroll
        for (int r = 0; r < 16; ++r) oacc[dt][r] = 0.f;
    const bf16_t* kbase = proj + (size_t)rowbase * INW + 1536 + kvh * 128 + 8 * h;
    const bf16_t* vbase = vt + (size_t)rowbase * 512 + (size_t)(kvh * 128 + l32) * T + 4 * h;
    if (bs < 0) {
#pragma unroll 1
        for (int kt = 0; kt < 256; kt += 32)
            attn_tile<false>(qf, oacc, m, lsum, kbase + (size_t)(kt + l32) * INW, vbase + kt, (size_t)T, 0);
    } else {
#pragma unroll 1
        for (int n = 0; n < 9; ++n) {
            const int kt = q0 - 128 + 32 * n;
            if (kt < 0 || kt >= T) continue;
            const int dqk = (q0 + l32) - kt - 4 * h;
            if (n == 0 || n == 8) attn_tile<true>(qf, oacc, m, lsum, kbase + (size_t)(kt + l32) * INW, vbase + kt, (size_t)T, dqk);
            else attn_tile<false>(qf, oacc, m, lsum, kbase + (size_t)(kt + l32) * INW, vbase + kt, (size_t)T, dqk);
        }
        const bf16_t* ck = (const bf16_t*)(p.ws + OFF_CTXK) + (size_t)((bs * 2 + j) * 256 + l32) * 512 + kvh * 128 + 8 * h;
        const bf16_t* cv = (const bf16_t*)(p.ws + OFF_CTXVT) + (size_t)(((bs * 2 + j) * 4 + kvh) * 128 + l32) * 256 + 4 * h;
#pragma unroll 1
        for (int kt = 0; kt < 256; kt += 32)
            attn_tile<false>(qf, oacc, m, lsum, ck + (size_t)kt * 512, cv + kt, (size_t)256, 0);
    }
    const float lt = lsum + __shfl_xor(lsum, 32), inv = 1.f / lt;
    const size_t row = (size_t)(rowbase + q0 + l32);
    const bf16_t* gp = proj + row * INW + 2560 + qh * 128 + 4 * h;
    bf16_t* op = (bf16_t*)(p.ws + OFF_O) + row * DM + qh * 128 + 4 * h;
#pragma unroll
    for (int dt = 0; dt < 4; ++dt)
#pragma unroll
        for (int g4 = 0; g4 < 4; ++g4) {
            const u32x2 g = *(const u32x2*)(gp + 32 * dt + 8 * g4);
            u32x2 w;
            w.x = cvt_pk_bf16(oacc[dt][4 * g4 + 0] * inv * silu(bflo(g.x)), oacc[dt][4 * g4 + 1] * inv * silu(bfhi(g.x)));
            w.y = cvt_pk_bf16(oacc[dt][4 * g4 + 2] * inv * silu(bflo(g.y)), oacc[dt][4 * g4 + 3] * inv * silu(bfhi(g.y)));
            *(u32x2*)(op + 32 * dt + 8 * g4) = w;
        }
}

__device__ void pool_task(const Params& p, const int task, const int lj) {
    const int lane = my_tid() & 63, l32 = lane & 31, h = lane >> 5;
    const int rb = task >> 2, g = task & 3;
    const int row = rb * 32 + l32;
    int rowbase, T;
    if (row < NPROMPT) { rowbase = row & ~255; T = 256; } else { rowbase = NPROMPT + ((row - NPROMPT) & ~2047); T = 2048; }
    const int tl = row - rowbase, hw = 1 << g  ;
    const int lo = max(tl - hw, 0), hi = min(tl + hw, T);
    const float rc = 1.f / (float)(hi - lo);
    const bf16_t* proj = (const bf16_t*)(p.ws + OFF_PROJ);
    const bf16_t* ub = proj + (size_t)rowbase * INW + g * 256 + 8 * h;
    bf16x8 bfr[16];
#pragma unroll
    for (int s = 0; s < 16; ++s) {
        float sum[8];
#pragma unroll
        for (int e = 0; e < 8; ++e) sum[e] = 0.f;
#pragma unroll 1
        for (int d = -hw; d < hw; ++d) {
            const int tt = tl + d; const bool ok = tt >= 0 && tt < T; const int tc = min(max(tt, 0), T - 1);
            const u32x4 v = *(const u32x4*)(ub + (size_t)tc * INW + 16 * s);
            const float wgt = ok ? 1.f : 0.f;
            sum[0] += wgt * bflo(v.x); sum[1] += wgt * bfhi(v.x); sum[2] += wgt * bflo(v.y); sum[3] += wgt * bfhi(v.y);
            sum[4] += wgt * bflo(v.z); sum[5] += wgt * bfhi(v.z); sum[6] += wgt * bflo(v.w); sum[7] += wgt * bfhi(v.w);
        }
        const u32x4 sv = *(const u32x4*)(ub + (size_t)tl * INW + 16 * s);
        u32x4 w;
        w.x = cvt_pk_bf16(sum[0] * rc - bflo(sv.x), sum[1] * rc - bfhi(sv.x)); w.y = cvt_pk_bf16(sum[2] * rc - bflo(sv.y), sum[3] * rc - bfhi(sv.y));
        w.z = cvt_pk_bf16(sum[4] * rc - bflo(sv.z), sum[5] * rc - bfhi(sv.z)); w.w = cvt_pk_bf16(sum[6] * rc - bflo(sv.w), sum[7] * rc - bfhi(sv.w));
        bfr[s] = __builtin_bit_cast(bf16x8, w);
    }
    const bf16_t* wt = (const bf16_t*)(p.ws + OFF_POOLW) + (size_t)(lj * 4 + g) * 65536 + (size_t)l32 * 256 + 8 * h;
    const float* psc = p.in[I_POOLS] + lj * 1024 + g * 256 + 4 * h;
    const bf16_t* gp = proj + (size_t)row * INW + 1024 + g * 256 + 4 * h;
    bf16_t* op = (bf16_t*)(p.ws + OFF_O) + (size_t)row * DM + g * 256 + 4 * h;
#pragma unroll 1
    for (int mt = 0; mt < 8; ++mt) {
        f32x16 acc;
#pragma unroll
        for (int r = 0; r < 16; ++r) acc[r] = 0.f;
        const bf16_t* ap = wt + (size_t)mt * 32 * 256;
#pragma unroll
        for (int s = 0; s < 16; ++s) acc = mfma32(ld16(ap + 16 * s), bfr[s], acc);
#pragma unroll
        for (int g4 = 0; g4 < 4; ++g4) {
            const int c0 = mt * 32 + 8 * g4;
            const u32x2 gg = *(const u32x2*)(gp + c0);
            const f32x4 ps = *(const f32x4*)(psc + c0);
            u32x2 w;
            w.x = cvt_pk_bf16(acc[4 * g4 + 0] * ps[0] * silu(bflo(gg.x)), acc[4 * g4 + 1] * ps[1] * silu(bfhi(gg.x)));
            w.y = cvt_pk_bf16(acc[4 * g4 + 2] * ps[2] * silu(bflo(gg.y)), acc[4 * g4 + 3] * ps[3] * silu(bfhi(gg.y)));
            *(u32x2*)(op + c0) = w;
        }
    }
}

constexpr int SGU_PITCH = 260;
__device__ void sgu_item(const Params& p, const int item, const int lj, LAS unsigned char* lds) {
    const int tid = my_tid(), wave = tid >> 6, lane = tid & 63, l32 = lane & 31, h = lane >> 5;
    const int ch = item >> 2, hd = item & 3, R0 = ch * 128;
    const bf16_t* proj = (const bf16_t*)(p.ws + OFF_PROJ);
    LAS bf16_t* vn = (LAS bf16_t*)lds;
    {
        const f32x4 gn = *(const f32x4*)(p.in[I_SGUN] + lj * 1024 + hd * 256 + lane * 4);
#pragma unroll 4
        for (int rr = 0; rr < 16; ++rr) {
            const int q = wave * 16 + rr;
            const u32x2 v = *(const u32x2*)(proj + (size_t)(R0 + q) * INW + 3072 + hd * 256 + lane * 4);
            const float a0 = bflo(v.x), a1 = bfhi(v.x), a2 = bflo(v.y), a3 = bfhi(v.y);
            const float mu = wave_sum(a0 + a1 + a2 + a3) * (1.f / 256.f);
            const float d0 = a0 - mu, d1 = a1 - mu, d2 = a2 - mu, d3 = a3 - mu;
            const float var = wave_sum(d0 * d0 + d1 * d1 + d2 * d2 + d3 * d3) * (1.f / 256.f);
            const float rs = rsqrtf(var + 1e-6f);
            u32x2 w; w.x = cvt_pk_bf16(d0 * rs * gn[0], d1 * rs * gn[1]); w.y = cvt_pk_bf16(d2 * rs * gn[2], d3 * rs * gn[3]);
            *(LAS u32x2*)(vn + q * SGU_PITCH + lane * 4) = w;
        }
    }
    __syncthreads();
    bf16x8 af[8];
    {
        const int c = wave * 32 + l32;
#pragma unroll
        for (int s = 0; s < 8; ++s) {
            unsigned short e[8];
#pragma unroll
            for (int jj = 0; jj < 8; ++jj) e[jj] = vn[(16 * s + 8 * h + jj) * SGU_PITCH + c];
            u32x4 w; w.x = e[0] | ((unsigned)e[1] << 16); w.y = e[2] | ((unsigned)e[3] << 16); w.z = e[4] | ((unsigned)e[5] << 16); w.w = e[6] | ((unsigned)e[7] << 16);
            af[s] = __builtin_bit_cast(bf16x8, w);
        }
    }
    const bf16_t* wb = (const bf16_t*)(p.ws + OFF_SGUW) + (size_t)(lj * 4 + hd) * 16384 + 8 * h;
#pragma unroll 1
    for (int nt = 0; nt < 4; ++nt) {
        const int pp = nt * 32 + l32;
        f32x16 acc;
#pragma unroll
        for (int r = 0; r < 16; ++r) acc[r] = 0.f;
#pragma unroll
        for (int s = 0; s < 8; ++s) acc = mfma32(af[s], ld16(wb + (size_t)pp * 128 + 16 * s), acc);
        const float bias = p.in[I_SGUB][(lj * 4 + hd) * 128 + pp];
        const size_t row = (size_t)(R0 + pp);
        const int cb = hd * 256 + wave * 32 + 4 * h;
        const bf16_t* up = proj + row * INW + 2048 + cb; const bf16_t* gp = proj + row * INW + 4096 + cb;
        bf16_t* op = (bf16_t*)(p.ws + OFF_O) + row * DM + 1024 + cb;
#pragma unroll
        for (int g4 = 0; g4 < 4; ++g4) {
            const u32x2 uu = *(const u32x2*)(up + 8 * g4), gg = *(const u32x2*)(gp + 8 * g4);
            u32x2 w;
            w.x = cvt_pk_bf16(bflo(uu.x) * (acc[4 * g4 + 0] + bias) * silu(bflo(gg.x)), bfhi(uu.x) * (acc[4 * g4 + 1] + bias) * silu(bfhi(gg.x)));
            w.y = cvt_pk_bf16(bflo(uu.y) * (acc[4 * g4 + 2] + bias) * silu(bflo(gg.y)), bfhi(uu.y) * (acc[4 * g4 + 3] + bias) * silu(bfhi(gg.y)));
            *(u32x2*)(op + 8 * g4) = w;
        }
    }
    __syncthreads();
}

#ifndef MK_SPLIT
#define MK_SPLIT 0
#endif

#ifndef MK_ENABLE
#define MK_ENABLE 0x1ff
#endif
#define EN(x) (((MK_ENABLE) >> (x)) & 1)
__global__ __launch_bounds__(512, 2) void fwd_megakernel(const Params p, const int ph_lo, const int ph_hi, const int use_sync) {
    extern __shared__ __attribute__((aligned(16))) unsigned char shm[];
    cg::grid_group grid = cg::this_grid();
    LAS unsigned char* lds = (LAS unsigned char*)shm;
    const int tid = my_tid(), wave = tid >> 6;
    int ph = 0;
#define PHASE_BEGIN if (ph >= ph_lo && ph < ph_hi) {
#define PHASE_END } ++ph; if (use_sync && ph > ph_lo && ph < ph_hi) grid.sync();
    PHASE_BEGIN if (EN(4)) phase0(p, shm); PHASE_END
    PHASE_BEGIN if (EN(8)) phase_rows(p, -1); PHASE_END
#pragma unroll 1
    for (int l = 0; l < 4; ++l) {
        const int lj = l >> 1;
        PHASE_BEGIN
            pg8::Gemm g; g.A = (const bf16_t*)(p.ws + OFF_H); g.Bt = (const bf16_t*)(p.ws + OFF_WTIN) + (size_t)l * 5120 * 2048; g.M = MROWS; g.N = INW; g.K = DM;
            pg8::StaticOrder S; S.init(g.M, g.N, (int)gridDim.x, (int)blockIdx.x);
            EpiProj E; E.O = (bf16_t*)(p.ws + OFF_PROJ); E.outk = p.out + (size_t)MROWS * DM; E.outv = E.outk + (size_t)32 * 2 * 256 * 512; E.even = (l & 1) == 0; E.j = lj;
            __syncthreads();
            if (EN(6)) pg8::gemm_phase<EpiProj, pg8::StaticOrder, false>(lds, g, S, E, nullptr);
            __syncthreads();
        PHASE_END
        if ((l & 1) == 0) {
            PHASE_BEGIN if (EN(3)) phase_even_prep(p); PHASE_END
            PHASE_BEGIN
                if (blockIdx.x < 32) {
                    pg8::Gemm g; g.A = (const bf16_t*)(p.ws + OFF_TW2K); g.Bt = (const bf16_t*)(p.ws + OFF_YTS); g.M = 2048; g.N = 1024; g.K = 4096;
                    asm volatile("" : "+s"(g.A), "+s"(g.Bt), "+s"(g.M), "+s"(g.N), "+s"(g.K));
                    pg8::StaticOrder S; S.init(g.M, g.N, 32, (int)blockIdx.x);
                    EpiFnet E; E.proj = (const bf16_t*)(p.ws + OFF_PROJ); E.O = (bf16_t*)(p.ws + OFF_O); E.rowbase0 = NPROMPT; E.T = 2048;
                    __syncthreads();
                    if (EN(5)) pg8::gemm_phase<EpiFnet, pg8::StaticOrder, false>(lds, g, S, E, nullptr);
                    __syncthreads();
                } else {
                    const int nb = (int)gridDim.x - 32;
                    for (int task = ((int)blockIdx.x - 32) * 8 + wave; task < 4608; task += nb * 8) { if (EN(0)) attn_task(p, task, lj); }
                    __syncthreads();
                    pg8::Gemm g; g.A = (const bf16_t*)(p.ws + OFF_TW256); g.Bt = (const bf16_t*)(p.ws + OFF_YTP); g.M = 256; g.N = 16384; g.K = 512;
                    asm volatile("" : "+s"(g.A), "+s"(g.Bt), "+s"(g.M), "+s"(g.N), "+s"(g.K));
                    pg8::StaticOrder S; S.init(g.M, g.N, nb, (int)blockIdx.x - 32);
                    EpiFnet E; E.proj = (const bf16_t*)(p.ws + OFF_PROJ); E.O = (bf16_t*)(p.ws + OFF_O); E.rowbase0 = 0; E.T = 256;
                    if (EN(5)) pg8::gemm_phase<EpiFnet, pg8::StaticOrder, false>(lds, g, S, E, nullptr);
                    __syncthreads();
                }
            PHASE_END
        } else {
            PHASE_BEGIN
                for (int item = blockIdx.x; item < 384; item += gridDim.x) { if (EN(2)) sgu_item(p, item, lj, lds); }
                const int NW = (int)gridDim.x * 8, gw = NW - 1 - ((int)blockIdx.x * 8 + wave);
                for (int task = gw; task < 1536; task += NW) { if (EN(1)) pool_task(p, task, lj); }
            PHASE_END
        }
        PHASE_BEGIN
            pg8::Gemm g; g.A = (const bf16_t*)(p.ws + OFF_O); g.Bt = (const bf16_t*)(p.ws + OFF_WTOUT) + (size_t)l * 2048 * 2048; g.M = MROWS; g.N = DM; g.K = DM;
            pg8::StaticOrder S; S.init(g.M, g.N, (int)gridDim.x, (int)blockIdx.x);
            EpiY E; E.C = (float*)(p.ws + OFF_Y);
            __syncthreads();
            if (EN(7)) pg8::gemm_phase<EpiY, pg8::StaticOrder, false>(lds, g, S, E, nullptr);
            __syncthreads();
        PHASE_END
        PHASE_BEGIN if (EN(8)) phase_rows(p, l); PHASE_END
    }
}

extern "C" void kernel_launch(void* const* d_in, const int* in_sizes, int n_in, void* d_out, int out_size, void* d_ws, size_t ws_size, hipStream_t stream) {
    constexpr size_t kDynLds = 131072;
    static int grid_blocks = 0;
    if (!grid_blocks) {
        int dev = 0, cus = 0, per_cu = 0;
        (void)hipGetDevice(&dev);
        (void)hipDeviceGetAttribute(&cus, hipDeviceAttributeMultiprocessorCount, dev);
        (void)hipFuncSetAttribute((const void*)fwd_megakernel, hipFuncAttributeMaxDynamicSharedMemorySize, (int)kDynLds);
        (void)hipOccupancyMaxActiveBlocksPerMultiprocessor(&per_cu, fwd_megakernel, 512, kDynLds);
        if (per_cu < 1) { fprintf(stderr, "occupancy query returned %d\n", per_cu); per_cu = 1; }
        if (per_cu > 1) per_cu = 1;
        grid_blocks = cus * per_cu;
        if (grid_blocks > 256) grid_blocks = 256;
    }
    if (ws_size < WS_NEED) { fprintf(stderr, "workspace too small: %zu < %zu\n", ws_size, WS_NEED); return; }
    Params p{};
    for (int i = 0; i < 18; ++i) p.in[i] = (const float*)d_in[i];
    p.out = (float*)d_out; p.ws = (unsigned char*)d_ws;
#if MK_SPLIT
    for (int ph = 0; ph < 22; ++ph) {
        int lo = ph, hi = ph + 1, us = 0;
        void* args[] = {(void*)&p, (void*)&lo, (void*)&hi, (void*)&us};
        hipLaunchCooperativeKernel((const void*)fwd_megakernel, dim3(grid_blocks), dim3(512), args, kDynLds, stream);
    }
#else
    int lo = 0, hi = 1000, us = 1;
    void* args[] = {(void*)&p, (void*)&lo, (void*)&hi, (void*)&us};
    hipError_t e = hipLaunchCooperativeKernel((const void*)fwd_megakernel, dim3(grid_blocks), dim3(512), args, kDynLds, stream);
    if (e != hipSuccess) fprintf(stderr, "cooperative launch failed: %s (grid %d)\n", hipGetErrorString(e), grid_blocks);
#endif
}
```

```cpp
#include <hip/hip_runtime.h>
#include <hip/hip_cooperative_groups.h>
#include <cstdio>
namespace cg = cooperative_groups;
namespace pg8 {
#define PG8_LAS __attribute__((address_space(3)))
typedef unsigned short bf16_t;
typedef short bf16x8 __attribute__((ext_vector_type(8)));
typedef float f32x4 __attribute__((ext_vector_type(4)));
typedef unsigned u32x4 __attribute__((ext_vector_type(4)));
constexpr int BM = 256, BK = 64, HALF = 128, HTB = HALF * BK * 2  , STAGE_BYTES = 8 * HTB, NXCD = 8, WGM = 8;

__host__ __device__ __forceinline__ int lds_byte(int r, int c) { const int st = (r >> 4) * 2 + (c >> 5), rr = r & 15, cc = c & 31, ob = rr * 64 + cc * 2; return st * 1024 + (ob ^ (((ob >> 9) & 1) << 5)); }
__host__ __device__ __forceinline__ void stage_rc(int b, int& R, int& C) { const int st = b / 1024, sb = b % 1024, swz = sb ^ (((sb >> 9) & 1) << 5); R = (st >> 1) * 16 + swz / 64; C = (st & 1) * 32 + (swz % 64) / 2; }
__host__ __device__ __forceinline__ int perm32(int rho) { const int n = rho >> 4, i = rho & 15; return 8 * (i >> 2) + 4 * n + (i & 3); }

struct Unit { int pm, pn; };
struct Gemm { const bf16_t* A; const bf16_t* Bt; int M, N, K; };

struct StaticOrder {
    int nM, nN, nwg, G, c;
    __host__ __device__ void init(int M, int N, int G_, int c_) { nM = M / BM; nN = N / BM; nwg = nM * nN; G = G_; c = c_; }
    __host__ __device__ bool next(int i, Unit& u) const {
        const long L = (long)i * G + c; if (L >= nwg) return false;
        int wgid = (int)L; { const int q = nwg / NXCD, r = nwg % NXCD, xcd = wgid % NXCD, off = wgid / NXCD; wgid = (xcd < r ? xcd * (q + 1) : r * (q + 1) + (xcd - r) * q) + off; }
        const int nig = WGM * nN, gid = wgid / nig, fm = gid * WGM, gsz = (nM - fm) < WGM ? (nM - fm) : WGM;
        u.pm = fm + ((wgid % nig) % gsz); u.pn = (wgid % nig) / gsz; return true;
    }
    __device__ __forceinline__ void a_ready(const Unit&) const {}
    __device__ __forceinline__ void done(const Unit&) const {}
};
typedef __bf16 bf16x2_t __attribute__((ext_vector_type(2)));
typedef float f32x2_t __attribute__((ext_vector_type(2)));
__device__ __forceinline__ unsigned cvt_pk_bf16(float lo, float hi) { const f32x2_t v = {lo, hi}; const bf16x2_t r = __builtin_convertvector(v, bf16x2_t); return __builtin_bit_cast(unsigned, r); }
template <class Epi, class Sched, bool STAMP = false>
__device__ __forceinline__ void gemm_phase(PG8_LAS unsigned char* lds, const Gemm g, const Sched& S, const Epi& E, unsigned long long* stamps) {
    int tid_ = threadIdx.x; asm volatile("" : "+v"(tid_));
    const int tid = tid_, wid = __builtin_amdgcn_readfirstlane(tid >> 6), lane = tid & 63, wr = wid >> 2, wc = wid & 3, fr = lane & 15, fq = lane >> 4;
    const int K = g.K, nt = K / BK;
    int ts_lo = 0, ts_hi = 0, nts = 0; const unsigned long long rt_entry = STAMP ? (unsigned long long)wall_clock64() : 0ull;
#define PG8_STAMP() do { if (STAMP && wid == 0 && nts < 64) { const unsigned long long _c = (unsigned long long)clock64(); \
        ts_lo = (lane == nts) ? (int)(unsigned)_c : ts_lo; ts_hi = (lane == nts) ? (int)(unsigned)(_c >> 32) : ts_hi; ++nts; } } while (0)
    PG8_STAMP();
    unsigned voffA[2], voffB[2];
#pragma unroll
    for (int i = 0; i < 2; ++i) { int R, C; stage_rc(tid * 16 + i * 8192, R, C); const int Rb = Epi::PERM ? ((R & ~31) + perm32(R & 31)) : R;
        voffA[i] = (unsigned)(R * K + C) * 2u; voffB[i] = (unsigned)(Rb * K + C) * 2u; }
    const size_t kstep = (size_t)(BK * 2);
    const size_t hstep = (size_t)HALF * K * 2;
    const size_t tstep = 2 * hstep;
    const unsigned ldsw = (unsigned)wid * 1024u;
    const int aoff = lds_byte(wr * 64 + fr, fq * 8), boff = lds_byte(wc * 32 + fr, fq * 8);
#define PG8_SA(b, h) (((b) * 2 + (h)) * HTB)
#define PG8_SB(b, h) ((4 + (b) * 2 + (h)) * HTB)
#define PG8_STAGE(bufoff, gbase, voff) do { _Pragma("unroll") for (int _i = 0; _i < 2; ++_i) \
        __builtin_amdgcn_global_load_lds((const unsigned*)((const char*)(gbase) + (voff)[_i]), (PG8_LAS unsigned*)(lds + (bufoff) + ldsw + _i * 8192), 16, 0, 0); } while (0)
#define PG8_LDA(dst, b, h) do { _Pragma("unroll") for (int m = 0; m < 4; ++m) _Pragma("unroll") for (int k = 0; k < 2; ++k) dst[m][k] = *(const PG8_LAS bf16x8*)(lds + PG8_SA(b, h) + aoff + m * 2048 + k * 1024); } while (0)
#define PG8_LDB(dst, b, h) do { _Pragma("unroll") for (int n = 0; n < 2; ++n) _Pragma("unroll") for (int k = 0; k < 2; ++k) dst[n][k] = *(const PG8_LAS bf16x8*)(lds + PG8_SB(b, h) + boff + n * 2048 + k * 1024); } while (0)
#define PG8_MMA(ai, bj, At, Bt) do { __builtin_amdgcn_s_setprio(1); _Pragma("unroll") for (int m = 0; m < 4; ++m) _Pragma("unroll") for (int n = 0; n < 2; ++n) _Pragma("unroll") for (int k = 0; k < 2; ++k) \
        acc[ai][bj][m][n] = __builtin_amdgcn_mfma_f32_16x16x32_bf16(Bt[n][k], At[m][k], acc[ai][bj][m][n], 0, 0, 0); __builtin_amdgcn_s_setprio(0); } while (0)
#define PG8_WAIT_V(n) asm volatile("s_waitcnt vmcnt(" #n ")" ::: "memory")
#define PG8_WAIT_L(n) asm volatile("s_waitcnt lgkmcnt(" #n ")" ::: "memory")
#define PG8_BAR __builtin_amdgcn_s_barrier()
#define PG8_SCHED __builtin_amdgcn_sched_barrier(0)
    Unit cur, nxt; int ui = 0;
    if (!S.next(0, cur)) return;
    f32x4 acc[2][2][4][2];
#pragma unroll
    for (int a = 0; a < 2; ++a)
#pragma unroll
        for (int b = 0; b < 2; ++b)
#pragma unroll
            for (int m = 0; m < 4; ++m)
#pragma unroll
                for (int n = 0; n < 2; ++n) acc[a][b][m][n] = (f32x4){0.f, 0.f, 0.f, 0.f};
    bf16x8 At[4][2], B0[2][2], B1[2][2];
    const char* cA = (const char*)g.A + (size_t)cur.pm * tstep; const char* cB = (const char*)g.Bt + (size_t)cur.pn * tstep;
    S.a_ready(cur);
    PG8_STAGE(PG8_SB(0, 0), cB, voffB); PG8_STAGE(PG8_SA(0, 0), cA, voffA); PG8_STAGE(PG8_SB(0, 1), cB + hstep, voffB); PG8_STAGE(PG8_SA(0, 1), cA + hstep, voffA);
    if (wr == 1) PG8_BAR;
    PG8_WAIT_V(4); PG8_BAR;
    PG8_STAGE(PG8_SB(1, 0), cB + kstep, voffB); PG8_STAGE(PG8_SA(1, 0), cA + kstep, voffA); PG8_STAGE(PG8_SB(1, 1), cB + hstep + kstep, voffB);
    PG8_WAIT_V(6); PG8_BAR;
    PG8_STAMP();
    for (;;) {
        const bool has_next = S.next(ui + 1, nxt);
        const char* nA = has_next ? (const char*)g.A + (size_t)nxt.pm * tstep : cA; const char* nB = has_next ? (const char*)g.Bt + (size_t)nxt.pn * tstep : cB;
        for (int t = 0; t < nt; t += 2) {
            const bool last = (t == nt - 2);
            const char* a1 = cA + (size_t)(t + 1) * kstep;
            const char* a2 = last ? nA : cA + (size_t)(t + 2) * kstep; const char* b2 = last ? nB : cB + (size_t)(t + 2) * kstep;
            const char* a3 = a2 + kstep; const char* b3 = b2 + kstep;
            if (last && has_next) S.a_ready(nxt);
            PG8_LDB(B0, 0, 0); PG8_SCHED; PG8_LDA(At, 0, 0); PG8_STAGE(PG8_SA(1, 1), a1 + hstep, voffA);
            PG8_WAIT_L(8); PG8_BAR; PG8_WAIT_L(0); PG8_MMA(0, 0, At, B0); PG8_BAR; PG8_SCHED;
            PG8_LDB(B1, 0, 1); PG8_STAGE(PG8_SB(0, 0), b2, voffB);
            PG8_BAR; PG8_WAIT_L(0); PG8_MMA(0, 1, At, B1); PG8_BAR;
            PG8_LDA(At, 0, 1); PG8_STAGE(PG8_SA(0, 0), a2, voffA);
            PG8_BAR; PG8_WAIT_L(0); PG8_MMA(1, 0, At, B0); PG8_BAR; PG8_SCHED;
            PG8_STAGE(PG8_SB(0, 1), b2 + hstep, voffB);
            PG8_WAIT_V(6); PG8_BAR; PG8_MMA(1, 1, At, B1); PG8_BAR;
            PG8_LDB(B0, 1, 0); PG8_SCHED; PG8_LDA(At, 1, 0); PG8_STAGE(PG8_SA(0, 1), a2 + hstep, voffA);
            PG8_WAIT_L(8); PG8_BAR; PG8_WAIT_L(0); PG8_MMA(0, 0, At, B0); PG8_BAR; PG8_SCHED;
            PG8_LDB(B1, 1, 1); PG8_STAGE(PG8_SB(1, 0), b3, voffB);
            PG8_BAR; PG8_WAIT_L(0); PG8_MMA(0, 1, At, B1); PG8_BAR;
            PG8_LDA(At, 1, 1); PG8_STAGE(PG8_SA(1, 0), a3, voffA);
            PG8_BAR; PG8_WAIT_L(0); PG8_MMA(1, 0, At, B0); PG8_BAR; PG8_SCHED;
            PG8_STAGE(PG8_SB(1, 1), b3 + hstep, voffB);
            PG8_WAIT_V(6); PG8_BAR; PG8_MMA(1, 1, At, B1); PG8_BAR;
        }
        PG8_STAMP();
        if constexpr (!Epi::AFTER_DRAIN) { E(acc, cur, wr, wc, fr, fq); S.done(cur); }
        PG8_STAMP();
        if (!has_next) break;
#pragma unroll
        for (int a = 0; a < 2; ++a)
#pragma unroll
            for (int b = 0; b < 2; ++b)
#pragma unroll
                for (int m = 0; m < 4; ++m)
#pragma unroll
                    for (int n = 0; n < 2; ++n) acc[a][b][m][n] = (f32x4){0.f, 0.f, 0.f, 0.f};
        cur = nxt; cA = nA; cB = nB; ++ui;
    }
    PG8_WAIT_V(0);
    if (wr == 0) PG8_BAR;
    PG8_BAR;
    if constexpr (Epi::AFTER_DRAIN) { E.fused(acc, cur, wr, wc, fr, fq, lds, wid, lane); S.done(cur); }
    PG8_STAMP();
    if (STAMP && wid == 0) { stamps[lane] = lane < nts ? (((unsigned long long)(unsigned)ts_hi << 32) | (unsigned)ts_lo) : 0ull;
        if (lane == 62) stamps[62] = rt_entry; if (lane == 63) stamps[63] = (unsigned long long)wall_clock64(); }
#undef PG8_STAMP
#undef PG8_SA
#undef PG8_SB
#undef PG8_STAGE
#undef PG8_LDA
#undef PG8_LDB
#undef PG8_MMA
#undef PG8_WAIT_V
#undef PG8_WAIT_L
#undef PG8_BAR
#undef PG8_SCHED
}
}


using pg8::bf16_t; using pg8::bf16x8; using pg8::f32x4; using pg8::u32x4; using pg8::cvt_pk_bf16;
typedef float f32x16 __attribute__((ext_vector_type(16)));
typedef short bf16x4 __attribute__((ext_vector_type(4)));
typedef unsigned u32x2 __attribute__((ext_vector_type(2)));
#define LAS __attribute__((address_space(3)))

constexpr int DM = 2048, MROWS = 12288, NPROMPT = 8192, INW = 5120;
constexpr float LOG2E = 1.4426950408889634f;

constexpr size_t OFF_WTIN  = 0;
constexpr size_t OFF_WTOUT = OFF_WTIN  + (size_t)4 * 5120 * 2048 * 2;
constexpr size_t OFF_MOD   = OFF_WTOUT + (size_t)4 * 2048 * 2048 * 2;
constexpr size_t OFF_H     = OFF_MOD   + (size_t)4 * 3 * 6144 * 4;
constexpr size_t OFF_PROJ  = OFF_H     + (size_t)MROWS * 2048 * 2;
constexpr size_t OFF_O     = OFF_PROJ  + (size_t)MROWS * 5120 * 2;
constexpr size_t OFF_Y     = OFF_O     + (size_t)MROWS * 2048 * 2;
constexpr size_t OFF_VT    = OFF_Y     + (size_t)MROWS * 2048 * 4;
constexpr size_t OFF_CTXK  = OFF_VT    + (size_t)MROWS * 512 * 2;
constexpr size_t OFF_CTXVT = OFF_CTXK  + (size_t)2 * 2 * 256 * 512 * 2;
constexpr size_t OFF_YTP   = OFF_CTXVT + (size_t)2 * 2 * 256 * 512 * 2;
constexpr size_t OFF_YTS   = OFF_YTP   + (size_t)32 * 512 * 512 * 2;
constexpr size_t OFF_TW256 = OFF_YTS   + (size_t)2 * 512 * 4096 * 2;
constexpr size_t OFF_TW2K  = OFF_TW256 + (size_t)256 * 512 * 2;
constexpr size_t OFF_CCS   = OFF_TW2K  + (size_t)2048 * 4096 * 2;
constexpr size_t OFF_POOLW = OFF_CCS   + (size_t)256 * 128 * 2;
constexpr size_t OFF_SGUW  = OFF_POOLW + (size_t)2 * 4 * 256 * 256 * 2;
constexpr size_t OFF_BAR   = OFF_SGUW  + (size_t)2 * 4 * 128 * 128 * 2;
constexpr size_t OFF_YH    = OFF_BAR + 16384;
constexpr size_t OFF_XB    = OFF_YH + 8192;
constexpr size_t WS_NEED   = OFF_XB + (size_t)MROWS * 2048 * 2;

struct Params { const float* in[18]; float* out; unsigned char* ws; };
enum { I_XP = 0, I_XS, I_CK, I_CV, I_C, I_CCTX, I_WADA, I_BADA, I_NPRE, I_NPOST, I_WIN, I_WOUT, I_SINK, I_POOLW, I_POOLS, I_SGUN, I_SGUW, I_SGUB };

__device__ __forceinline__ int my_tid() { int t = threadIdx.x; asm volatile("" : "+v"(t)); return t; }
__device__ __forceinline__ float bflo(unsigned w) { return __uint_as_float(w << 16); }
__device__ __forceinline__ float bfhi(unsigned w) { return __uint_as_float(w & 0xffff0000u); }
__device__ __forceinline__ float bf1(bf16_t b) { return __uint_as_float(((unsigned)b) << 16); }
__device__ __forceinline__ float silu(float x) { return x * __builtin_amdgcn_rcpf(1.f + __builtin_amdgcn_exp2f(-1.4426950408889634f * x)); }
__device__ __forceinline__ bf16_t f2bf(float f) { return (bf16_t)(cvt_pk_bf16(f, 0.f) & 0xffffu); }
__device__ __forceinline__ float wave_sum(float v) {
#pragma unroll
    for (int o = 32; o >= 1; o >>= 1) v += __shfl_xor(v, o);
    return v;
}
__device__ __forceinline__ bf16x8 ld16(const bf16_t* p) { return *(const bf16x8*)p; }
__device__ __forceinline__ bf16x8 ld8x2(const bf16_t* p0, const bf16_t* p1) {
    const bf16x4 a = *(const bf16x4*)p0, b = *(const bf16x4*)p1;
    return __builtin_shufflevector(a, b, 0, 1, 2, 3, 4, 5, 6, 7);
}
#define GAS __attribute__((address_space(1)))
__device__ __forceinline__ bf16x8 ldg16(const bf16_t* p) { return *(const GAS bf16x8*)p; }
__device__ __forceinline__ bf16x8 ldg8x2(const bf16_t* p0, const bf16_t* p1) {
    const bf16x4 a = *(const GAS bf16x4*)p0, b = *(const GAS bf16x4*)p1;
    return __builtin_shufflevector(a, b, 0, 1, 2, 3, 4, 5, 6, 7);
}
__device__ __forceinline__ f32x16 mfma32(bf16x8 a, bf16x8 b, f32x16 c) { return __builtin_amdgcn_mfma_f32_32x32x16_bf16(a, b, c, 0, 0, 0); }

__device__ __forceinline__ void transpose_tiles(const Params& p, unsigned char* smem, const int l) {
    float* tile = (float*)smem + 3 * 2048 + 8 * 3 * 256;
    volatile int* slot = (volatile int*)(tile + 128 * 129);
    const int tid = my_tid();
    unsigned* qcnt = (unsigned*)(p.ws + OFF_BAR) + 3500 + l;
    const float* win = p.in[I_WIN] + (size_t)l * 2048 * 5120; const float* wout = p.in[I_WOUT] + (size_t)l * 2048 * 2048;
    bf16_t* wtin = (bf16_t*)(p.ws + OFF_WTIN) + (size_t)l * 5120 * 2048; bf16_t* wtout = (bf16_t*)(p.ws + OFF_WTOUT) + (size_t)l * 2048 * 2048;
    __syncthreads();
    if (tid == 0) *slot = (int)atomicAdd(qcnt, 1u);
    __syncthreads();
    int cur = *slot;
    const int rr = tid >> 5, c4 = (tid & 31) * 4, nn = tid >> 2, kq0 = tid & 3;
    while (cur < 896) {
        int nxt = 0;
        if (tid == 0) nxt = (int)atomicAdd(qcnt, 1u);
        const float* src; bf16_t* dst; int N, kt, nt;
        if (cur < 640) { kt = cur / 40; nt = cur % 40; N = 5120; src = win; dst = wtin; }
        else { const int r = cur - 640; kt = r >> 4; nt = r & 15; N = 2048; src = wout; dst = wtout; }
        const int k0 = kt * 128, n0 = nt * 128;
        f32x4 v[8];
#pragma unroll
        for (int i = 0; i < 8; ++i) v[i] = __builtin_nontemporal_load((const GAS f32x4*)(src + (size_t)(k0 + rr + 16 * i) * N + n0 + c4));
#pragma unroll
        for (int i = 0; i < 8; ++i) { float* tp = tile + (rr + 16 * i) * 129 + c4; tp[0] = v[i][0]; tp[1] = v[i][1]; tp[2] = v[i][2]; tp[3] = v[i][3]; }
        __syncthreads();
#pragma unroll
        for (int jj = 0; jj < 4; ++jj) {
            const int kq = kq0 + 4 * jj;
            float t[8];
#pragma unroll
            for (int e = 0; e < 8; ++e) t[e] = tile[(kq * 8 + e) * 129 + nn];
            u32x4 w; w.x = cvt_pk_bf16(t[0], t[1]); w.y = cvt_pk_bf16(t[2], t[3]); w.z = cvt_pk_bf16(t[4], t[5]); w.w = cvt_pk_bf16(t[6], t[7]);
            *(GAS u32x4*)(dst + (size_t)(n0 + nn) * 2048 + k0 + kq * 8) = w;
        }
        if (tid == 0) *slot = nxt;
        __syncthreads();
        cur = *slot;
    }
}

__device__ __forceinline__ void phase0(const Params& p, unsigned char* smem) {
    float* sc = (float*)smem;
    float* red = sc + 3 * 2048;
    const int tid = my_tid(), wave = tid >> 6, lane = tid & 63;
    for (int i = tid; i < 3 * 2048; i += 512) {
        const int ci = i >> 11, k = i & 2047;
        const float v = ci == 0 ? p.in[I_CCTX][k] : p.in[I_C][(ci - 1) * 2048 + k];
        sc[i] = silu(v);
    }
    __syncthreads();
    float* mod = (float*)(p.ws + OFF_MOD);
    for (int item = blockIdx.x; item < 192; item += gridDim.x) {
        const int l = item / 48, rem = item % 48, n0 = (rem >> 1) * 256, kh = rem & 1;
        const float* wp = p.in[I_WADA] + ((size_t)l * 2048 + kh * 1024 + wave * 128) * 6144 + n0 + lane * 4;
        const float* s0 = sc + kh * 1024 + wave * 128;
        f32x4 a0 = {0.f, 0.f, 0.f, 0.f}, a1 = a0, a2 = a0;
#pragma unroll 8
        for (int kk = 0; kk < 128; ++kk) {
            const f32x4 wv = __builtin_nontemporal_load((const GAS f32x4*)(wp + (size_t)kk * 6144));
            a0 += wv * s0[kk]; a1 += wv * s0[2048 + kk]; a2 += wv * s0[4096 + kk];
        }
        *(f32x4*)(red + (wave * 3 + 0) * 256 + lane * 4) = a0; *(f32x4*)(red + (wave * 3 + 1) * 256 + lane * 4) = a1; *(f32x4*)(red + (wave * 3 + 2) * 256 + lane * 4) = a2;
        __syncthreads();
        for (int o = tid; o < 768; o += 512) {
            const int ci = o >> 8, col = o & 255;
            float s_ = kh == 0 ? p.in[I_BADA][l * 6144 + n0 + col] : 0.f;
#pragma unroll
            for (int w = 0; w < 8; ++w) s_ += red[(w * 3 + ci) * 256 + col];
            atomicAdd(mod + (l * 3 + ci) * 6144 + n0 + col, s_);
        }
        __syncthreads();
    }
    const int lcv = gridDim.x == 256 ? 1 : 4;
#pragma unroll 1
    for (int l = 0; l < lcv; ++l) transpose_tiles(p, smem, l);
    const int gt = blockIdx.x * 512 + tid, NT = gridDim.x * 512;
    {
        bf16_t* o = (bf16_t*)(p.ws + OFF_POOLW);
        for (int idx = gt; idx < 2 * 4 * 256 * 256; idx += NT) {
            const int lg = idx >> 16, mt = (idx >> 13) & 7, s_ = (idx >> 9) & 15, ln = (idx >> 3) & 63, jj = idx & 7;
            const int d = mt * 32 + (ln & 31), c = s_ * 16 + (ln >> 5) * 8 + jj;
            o[idx] = f2bf(p.in[I_POOLW][(lg * 256 + c) * 256 + d]);
        }
    }
    {
        bf16_t* o = (bf16_t*)(p.ws + OFF_SGUW);
        for (int idx = gt; idx < 2 * 4 * 128 * 128; idx += NT) {
            const int lh = idx >> 14, nt = (idx >> 12) & 3, s_ = (idx >> 9) & 7, ln = (idx >> 3) & 63, jj = idx & 7;
            const int pp = nt * 32 + (ln & 31), qq = s_ * 16 + (ln >> 5) * 8 + jj;
            o[idx] = f2bf(p.in[I_SGUW][(lh * 128 + pp) * 128 + qq]);
        }
    }
    {
        bf16_t* o = (bf16_t*)(p.ws + OFF_CCS);
        for (int idx = gt; idx < 256 * 128; idx += NT) {
            const int nt_ = idx >> 12, s_ = (idx >> 9) & 7, ln = (idx >> 3) & 63, jj = idx & 7;
            const int R = nt_ * 32 + (ln & 31), c = s_ * 16 + (ln >> 5) * 8 + jj, cs = R >> 7, cp = R & 127; const float x = (float)((c * cp) & 127) * (1.f / 128.f);
            const float v = cs ? __builtin_amdgcn_sinf(x) : __builtin_amdgcn_cosf(x);
            o[idx] = f2bf(v * 0.08838834764831845f);
        }
    }
    {
        bf16_t* o = (bf16_t*)(p.ws + OFF_TW256);
        for (int idx = gt; idx < 256 * 512; idx += NT) {
            const int tp = idx >> 9, k = idx & 511, t = k & 255, isS = k >> 8; const float x = (float)((t * tp) & 255) * (1.f / 256.f);
            const float v = isS ? -__builtin_amdgcn_sinf(x) : __builtin_amdgcn_cosf(x);
            o[idx] = f2bf(v * 0.0625f);
        }
    }
    {
        unsigned* o = (unsigned*)(p.ws + OFF_TW2K);
        for (int idx = gt; idx < 2048 * 1024; idx += NT) {
            const int tp = idx >> 10, k = (idx & 1023) * 2, t = k & 1023, isS = k >> 10;
            const float x0 = (float)((t * tp) & 2047) * (1.f / 2048.f), x1 = (float)(((t + 1) * tp) & 2047) * (1.f / 2048.f);
            float v0 = isS ? -__builtin_amdgcn_sinf(x0) : __builtin_amdgcn_cosf(x0);
            const float v1 = isS ? -__builtin_amdgcn_sinf(x1) : __builtin_amdgcn_cosf(x1);
            if (k == 1024) v0 = (tp & 1) ? -1.f : 1.f;
            o[idx] = cvt_pk_bf16(v0 * 0.022097086912079608f, v1 * 0.022097086912079608f);
        }
    }
    {
        bf16_t* ok = (bf16_t*)(p.ws + OFF_CTXK); bf16_t* ov = (bf16_t*)(p.ws + OFF_CTXVT);
        for (int idx = gt; idx < 2 * 2 * 256 * 512; idx += NT) {
            ok[idx] = f2bf(p.in[I_CK][idx]);
            const int t = idx & 255, dim = (idx >> 8) & 127, kvh = (idx >> 15) & 3, bj = idx >> 17;
            ov[idx] = f2bf(p.in[I_CV][((bj * 256 + t) * 4 + kvh) * 128 + dim]);
        }
    }
}

__device__ __forceinline__ void phase_rows(const Params& p, const int l) {
    const int tid = my_tid(), wave = tid >> 6, lane = tid & 63;
    const float* mod = (const float*)(p.ws + OFF_MOD);
    const bf16_t* ybuf = (const bf16_t*)(p.ws + OFF_Y);
    bf16_t* hbuf = (bf16_t*)(p.ws + OFF_H);
    for (int row = blockIdx.x * 8 + wave; row < MROWS; row += gridDim.x * 8) {
        const int ci = row < NPROMPT ? 0 : 1 + ((row - NPROMPT) >> 11);
        bf16_t* xb = (bf16_t*)(p.ws + OFF_XB) + (size_t)row * DM;
        f32x4 x[8];
        if (l <= 0) {
            const float* xs = row < NPROMPT ? p.in[I_XP] + (size_t)row * DM : p.in[I_XS] + (size_t)(row - NPROMPT) * DM;
#pragma unroll
            for (int i = 0; i < 8; ++i) x[i] = __builtin_nontemporal_load((const GAS f32x4*)(xs + i * 256 + lane * 4));
        } else {
#pragma unroll
            for (int i = 0; i < 8; ++i) { const u32x2 xw = __builtin_nontemporal_load((const GAS u32x2*)(xb + i * 256 + lane * 4)); x[i][0] = bflo(xw.x); x[i][1] = bfhi(xw.x); x[i][2] = bflo(xw.y); x[i][3] = bfhi(xw.y); }
        }
        if (l >= 0) {
            f32x4 y[8]; float ss = 0.f;
#pragma unroll
            for (int i = 0; i < 8; ++i) { const u32x2 yw = __builtin_nontemporal_load((const GAS u32x2*)(ybuf + (size_t)row * DM + i * 256 + lane * 4)); y[i][0] = bflo(yw.x); y[i][1] = bfhi(yw.x); y[i][2] = bflo(yw.y); y[i][3] = bfhi(yw.y); ss += y[i][0] * y[i][0] + y[i][1] * y[i][1] + y[i][2] * y[i][2] + y[i][3] * y[i][3]; }
            ss = wave_sum(ss);
            const float r = rsqrtf(ss * (1.f / 2048.f) + 1e-6f);
            const float* gate = mod + (l * 3 + ci) * 6144 + 4096; const float* np = p.in[I_NPOST] + l * 2048;
#pragma unroll
            for (int i = 0; i < 8; ++i) {
                const f32x4 g = *(const f32x4*)(gate + i * 256 + lane * 4), w = *(const f32x4*)(np + i * 256 + lane * 4);
#pragma unroll
                for (int e = 0; e < 4; ++e) x[i][e] += g[e] * (y[i][e] * r * w[e]);
                if (l == 3) *(GAS f32x4*)(p.out + (size_t)row * DM + i * 256 + lane * 4) = x[i];
                else { u32x2 xo; xo.x = cvt_pk_bf16(x[i][0], x[i][1]); xo.y = cvt_pk_bf16(x[i][2], x[i][3]); *(GAS u32x2*)(xb + i * 256 + lane * 4) = xo; }
            }
        }
        if (l < 3) {
            const int l1 = l + 1;
            float ss = 0.f;
#pragma unroll
            for (int i = 0; i < 8; ++i) ss += x[i][0] * x[i][0] + x[i][1] * x[i][1] + x[i][2] * x[i][2] + x[i][3] * x[i][3];
            ss = wave_sum(ss);
            const float r = rsqrtf(ss * (1.f / 2048.f) + 1e-6f);
            const float* shift = mod + (l1 * 3 + ci) * 6144; const float* scale = shift + 2048; const float* np = p.in[I_NPRE] + l1 * 2048;
#pragma unroll
            for (int i = 0; i < 8; ++i) {
                const f32x4 sh = *(const f32x4*)(shift + i * 256 + lane * 4), sl = *(const f32x4*)(scale + i * 256 + lane * 4), w = *(const f32x4*)(np + i * 256 + lane * 4);
                float hv[4];
#pragma unroll
                for (int e = 0; e < 4; ++e) hv[e] = (x[i][e] * r * w[e]) * (1.f + sl[e]) + sh[e];
                u32x2 o; o.x = cvt_pk_bf16(hv[0], hv[1]); o.y = cvt_pk_bf16(hv[2], hv[3]);
                *(u32x2*)(hbuf + (size_t)row * DM + i * 256 + lane * 4) = o;
            }
        }
    }
}

struct EpiProj {
    static constexpr bool PERM = true, AFTER_DRAIN = false;
    bf16_t* O; float* outk; float* outv; int even, j;
    __device__ __forceinline__ void operator()(const f32x4 (&acc)[2][2][4][2], const pg8::Unit& u, int wr, int wc, int fr, int fq) const {
        asm volatile("" : "+v"(fr), "+v"(fq));
        const int rloc0 = wr * 64 + fr, col0 = u.pn * 256 + wc * 32 + 8 * fq;
        const bool kv = even && u.pm < 32 && u.pn >= 6 && u.pn < 10;
        float* cbase = nullptr;
        if (kv) cbase = (u.pn < 8 ? outk : outv) + ((size_t)(u.pm * 2 + j) * 256) * 512 + ((u.pn & 1) * 256 + wc * 32 + 8 * fq);
#pragma unroll
        for (int ai = 0; ai < 2; ++ai)
#pragma unroll
            for (int m = 0; m < 4; ++m) {
                const int rloc = rloc0 + ai * 128 + m * 16;
                bf16_t* rowp = O + (size_t)(u.pm * 256 + rloc) * INW + col0;
#pragma unroll
                for (int bj = 0; bj < 2; ++bj) {
                    const f32x4 v0 = acc[ai][bj][m][0], v1 = acc[ai][bj][m][1];
                    u32x4 w; w.x = cvt_pk_bf16(v0[0], v0[1]); w.y = cvt_pk_bf16(v0[2], v0[3]); w.z = cvt_pk_bf16(v1[0], v1[1]); w.w = cvt_pk_bf16(v1[2], v1[3]);
                    *(u32x4*)(rowp + bj * 128) = w;
                    if (kv) { float* cp = cbase + (size_t)rloc * 512 + bj * 128; *(f32x4*)cp = v0; *(f32x4*)(cp + 4) = v1; }
                    __builtin_amdgcn_sched_barrier(0);
                }
            }
    }
};
struct EpiY {
    static constexpr bool PERM = true, AFTER_DRAIN = false;
    bf16_t* C;
    __device__ __forceinline__ void operator()(const f32x4 (&acc)[2][2][4][2], const pg8::Unit& u, int wr, int wc, int fr, int fq) const {
        asm volatile("" : "+v"(fr), "+v"(fq));
        const int row0 = u.pm * 256 + wr * 64 + fr, col0 = u.pn * 256 + wc * 32 + 8 * fq;
#pragma unroll
        for (int ai = 0; ai < 2; ++ai)
#pragma unroll
            for (int m = 0; m < 4; ++m) {
                bf16_t* rowp = C + (size_t)(row0 + ai * 128 + m * 16) * DM + col0;
#pragma unroll
                for (int bj = 0; bj < 2; ++bj) {
                    const f32x4 v0 = acc[ai][bj][m][0], v1 = acc[ai][bj][m][1];
                    u32x4 w; w.x = cvt_pk_bf16(v0[0], v0[1]); w.y = cvt_pk_bf16(v0[2], v0[3]); w.z = cvt_pk_bf16(v1[0], v1[1]); w.w = cvt_pk_bf16(v1[2], v1[3]);
                    *(u32x4*)(rowp + bj * 128) = w;
                }
            }
    }
};
struct EpiFnet {
    static constexpr bool PERM = true, AFTER_DRAIN = false;
    const bf16_t* proj; bf16_t* O; int rowbase0, T; const float* yh;
    __device__ __forceinline__ void operator()(const f32x4 (&acc)[2][2][4][2], const pg8::Unit& u, int wr, int wc, int fr, int fq) const {
        asm volatile("" : "+v"(fr), "+v"(fq));
        const int row0 = rowbase0 + (u.pn >> 1) * T + u.pm * 256 + wr * 64 + fr, col0 = (u.pn & 1) * 256 + wc * 32 + 8 * fq;
#pragma unroll
        for (int ai = 0; ai < 2; ++ai)
#pragma unroll
            for (int m = 0; m < 4; ++m) {
                const size_t row = (size_t)(row0 + ai * 128 + m * 16);
#pragma unroll
                for (int bj = 0; bj < 2; ++bj) {
                    const u32x4 g = *(const u32x4*)(proj + row * INW + 4608 + col0 + bj * 128);
                    f32x4 v0 = acc[ai][bj][m][0], v1 = acc[ai][bj][m][1];
                    if (yh) { const float sg = (fr & 1) ? -0.022097086912079608f : 0.022097086912079608f; const float* yp = yh + (u.pn >> 1) * 512 + col0 + bj * 128;
                        const f32x4 y0 = *(const GAS f32x4*)yp, y1 = *(const GAS f32x4*)(yp + 4); v0 += y0 * sg; v1 += y1 * sg; }
                    u32x4 w;
                    w.x = cvt_pk_bf16(v0[0] * silu(bflo(g.x)), v0[1] * silu(bfhi(g.x))); w.y = cvt_pk_bf16(v0[2] * silu(bflo(g.y)), v0[3] * silu(bfhi(g.y)));
                    w.z = cvt_pk_bf16(v1[0] * silu(bflo(g.z)), v1[1] * silu(bfhi(g.z))); w.w = cvt_pk_bf16(v1[2] * silu(bflo(g.w)), v1[3] * silu(bfhi(g.w)));
                    *(u32x4*)(O + row * DM + 1536 + col0 + bj * 128) = w;
                    __builtin_amdgcn_sched_barrier(0);
                }
            }
    }
};

__device__ __forceinline__ void phase_even_prep(const Params& p, const int lj) {
    const int tid = my_tid(), wave = tid >> 6, lane = tid & 63, l32 = lane & 31, h = lane >> 5;
    bf16_t* proj = (bf16_t*)(p.ws + OFF_PROJ);
    const bf16_t* ccs = (const bf16_t*)(p.ws + OFF_CCS);
    for (int task = blockIdx.x * 8 + wave; task < 256 * 4; task += gridDim.x * 8) {
        const int rb = task >> 2, g = task & 3, row0 = rb * 32;
        bf16x8 af[8];
        const bf16_t* ap = proj + (size_t)(row0 + l32) * INW + 4096 + g * 128 + 8 * h;
#pragma unroll
        for (int s = 0; s < 8; ++s) af[s] = ld16(ap + 16 * s);
        bf16_t* yt; int T, tl0;
        if (row0 < NPROMPT) { T = 256; tl0 = row0 & 255; yt = (bf16_t*)(p.ws + OFF_YTP) + (size_t)(row0 >> 8) * 512 * 512; }
        else { T = 2048; tl0 = (row0 - NPROMPT) & 2047; yt = (bf16_t*)(p.ws + OFF_YTS) + (size_t)((row0 - NPROMPT) >> 11) * 512 * 4096; }
#pragma unroll 1
        for (int nt = 0; nt < 8; ++nt) {
            const int R = nt * 32 + l32;
            const bf16_t* bp = ccs + (size_t)nt * 4096 + lane * 8;
            f32x16 acc;
#pragma unroll
            for (int r = 0; r < 16; ++r) acc[r] = 0.f;
#pragma unroll
            for (int s = 0; s < 8; ++s) acc = mfma32(af[s], ldg16(bp + 512 * s), acc);
            const int cs = R >> 7, cp = R & 127;
            bf16_t* dst = yt + (size_t)(g * 128 + cp) * (2 * T) + cs * T + tl0 + 4 * h;
#pragma unroll
            for (int q = 0; q < 4; ++q) {
                u32x2 w; w.x = cvt_pk_bf16(acc[4 * q], acc[4 * q + 1]); w.y = cvt_pk_bf16(acc[4 * q + 2], acc[4 * q + 3]);
                *(u32x2*)(dst + 8 * q) = w;
            }
        }
    }
    for (int task = (gridDim.x * 8 - 1) - (blockIdx.x * 8 + wave); task < 256; task += gridDim.x * 8) {
        const int g = task & 3, kb = (task >> 2) & 31, b = task >> 7;
        const int t = kb * 32 + l32, tp = (t == 0) ? 0 : 2048 - t;
        const bf16_t* xa = proj + (size_t)(NPROMPT + b * 2048 + t) * INW + 4096 + g * 128 + 8 * h;
        const bf16_t* ya = proj + (size_t)(NPROMPT + b * 2048 + tp) * INW + 4096 + g * 128 + 8 * h;
        bf16x8 ae[8], ao[8];
#pragma unroll
        for (int s = 0; s < 8; ++s) {
            const u32x4 x = *(const GAS u32x4*)(xa + 16 * s), y = *(const GAS u32x4*)(ya + 16 * s);
            u32x4 e, o;
#pragma unroll
            for (int q = 0; q < 4; ++q) {
                const unsigned xw = q == 0 ? x.x : q == 1 ? x.y : q == 2 ? x.z : x.w, yw = q == 0 ? y.x : q == 1 ? y.y : q == 2 ? y.z : y.w;
                const float x0 = bflo(xw), x1 = bfhi(xw), y0 = bflo(yw), y1 = bfhi(yw);
                const unsigned ew = (t == 0) ? xw : cvt_pk_bf16(x0 + y0, x1 + y1), ow = (t == 0) ? 0u : cvt_pk_bf16(x0 - y0, x1 - y1);
                if (q == 0) { e.x = ew; o.x = ow; } else if (q == 1) { e.y = ew; o.y = ow; } else if (q == 2) { e.z = ew; o.z = ow; } else { e.w = ew; o.w = ow; }
            }
            ae[s] = __builtin_bit_cast(bf16x8, e); ao[s] = __builtin_bit_cast(bf16x8, o);
        }
        bf16_t* yt = (bf16_t*)(p.ws + OFF_YTS) + (size_t)(lj * 2 + b) * 512 * 2048;
#pragma unroll 1
        for (int nt = 0; nt < 4; ++nt) {
            const bf16_t* bp = ccs + (size_t)nt * 4096 + lane * 8;
            f32x16 acc;
#pragma unroll
            for (int r = 0; r < 16; ++r) acc[r] = 0.f;
#pragma unroll
            for (int s = 0; s < 8; ++s) acc = mfma32(ae[s], ldg16(bp + 512 * s), acc);
            bf16_t* dst = yt + (size_t)(g * 128 + nt * 32 + l32) * 2048 + kb * 32 + 4 * h;
#pragma unroll
            for (int q = 0; q < 4; ++q) { u32x2 w; w.x = cvt_pk_bf16(acc[4 * q], acc[4 * q + 1]); w.y = cvt_pk_bf16(acc[4 * q + 2], acc[4 * q + 3]); *(GAS u32x2*)(dst + 8 * q) = w; }
        }
#pragma unroll 1
        for (int nt = 0; nt < 4; ++nt) {
            const bf16_t* bp = ccs + (size_t)(nt + 4) * 4096 + lane * 8;
            f32x16 acc;
#pragma unroll
            for (int r = 0; r < 16; ++r) acc[r] = 0.f;
#pragma unroll
            for (int s = 0; s < 8; ++s) acc = mfma32(ao[s], ldg16(bp + 512 * s), acc);
            bf16_t* dst = yt + (size_t)(g * 128 + nt * 32 + l32) * 2048 + 1024 + kb * 32 + 4 * h;
#pragma unroll
            for (int q = 0; q < 4; ++q) { u32x2 w; w.x = cvt_pk_bf16(acc[4 * q], acc[4 * q + 1]); w.y = cvt_pk_bf16(acc[4 * q + 2], acc[4 * q + 3]); *(GAS u32x2*)(dst + 8 * q) = w; }
        }
    }
    const int gt = blockIdx.x * 512 + tid, NT = gridDim.x * 512;
    for (int idx = gt; idx < 1024; idx += NT) {
        const int b = idx >> 9, n = idx & 511, g = n >> 7, cp = n & 127;
        const bf16_t* up = proj + (size_t)(NPROMPT + b * 2048 + 1024) * INW + 4096 + g * 128;
        float a = 0.f;
        u32x4 uv[16];
#pragma unroll
        for (int i = 0; i < 16; ++i) uv[i] = *(const GAS u32x4*)(up + 8 * i);
#pragma unroll
        for (int i = 0; i < 16; ++i)
#pragma unroll
            for (int e = 0; e < 4; ++e) {
                const unsigned w = e == 0 ? uv[i].x : e == 1 ? uv[i].y : e == 2 ? uv[i].z : uv[i].w; const int c = i * 8 + e * 2;
                a += bflo(w) * __builtin_amdgcn_cosf((float)((c * cp) & 127) * (1.f / 128.f)) + bfhi(w) * __builtin_amdgcn_cosf((float)(((c + 1) * cp) & 127) * (1.f / 128.f));
            }
        ((float*)(p.ws + OFF_YH))[lj * 1024 + idx] = a * 0.08838834764831845f;
    }
    for (int idx = gt; idx < 4096 * 16 * 2 * 4; idx += NT) {
        const int ib = idx & 3, a = (idx >> 2) & 1, head = (idx >> 3) & 15, rs = idx >> 7;
        const int t = rs & 2047; const float pos = (float)(a == 0 ? (t >> 6) : (t & 63));
        bf16_t* x1p = proj + (size_t)(NPROMPT + rs) * INW + head * 128 + a * 64 + ib * 8;
        const u32x4 x1 = *(const u32x4*)x1p, x2 = *(const u32x4*)(x1p + 32);
        u32x4 o1, o2;
#pragma unroll
        for (int e = 0; e < 4; ++e) {
            const unsigned w1 = e == 0 ? x1.x : e == 1 ? x1.y : e == 2 ? x1.z : x1.w, w2 = e == 0 ? x2.x : e == 1 ? x2.y : e == 2 ? x2.z : x2.w;
            float r1[2], r2[2];
#pragma unroll
            for (int q = 0; q < 2; ++q) {
                const int i = ib * 8 + e * 2 + q;
                const float inv = __builtin_amdgcn_exp2f(-(float)i * (13.287712379549449f / 32.f));
                const float rev = pos * inv * 0.15915494309189535f;
                const float cc = __builtin_amdgcn_cosf(rev), sn = __builtin_amdgcn_sinf(rev);
                const float a1 = q ? bfhi(w1) : bflo(w1), a2 = q ? bfhi(w2) : bflo(w2);
                r1[q] = a1 * cc - a2 * sn; r2[q] = a2 * cc + a1 * sn;
            }
            const unsigned p1 = cvt_pk_bf16(r1[0], r1[1]), p2 = cvt_pk_bf16(r2[0], r2[1]);
            if (e == 0) { o1.x = p1; o2.x = p2; } else if (e == 1) { o1.y = p1; o2.y = p2; } else if (e == 2) { o1.z = p1; o2.z = p2; } else { o1.w = p1; o2.w = p2; }
        }
        *(u32x4*)x1p = o1; *(u32x4*)(x1p + 32) = o2;
    }
    bf16_t* vt = (bf16_t*)(p.ws + OFF_VT);
    for (int idx = gt; idx < 1536 * 512; idx += NT) {
        const int cd = idx & 511, r8 = idx >> 9, row0 = r8 * 8;
        int rowbase, T;
        if (row0 < NPROMPT) { rowbase = row0 & ~255; T = 256; } else { rowbase = NPROMPT + ((row0 - NPROMPT) & ~2047); T = 2048; }
        const bf16_t* src = proj + (size_t)row0 * INW + 2048 + cd;
        unsigned short v[8];
#pragma unroll
        for (int j = 0; j < 8; ++j) v[j] = src[(size_t)j * INW];
        u32x4 w; w.x = v[0] | ((unsigned)v[1] << 16); w.y = v[2] | ((unsigned)v[3] << 16); w.z = v[4] | ((unsigned)v[5] << 16); w.w = v[6] | ((unsigned)v[7] << 16);
        *(u32x4*)(vt + (size_t)rowbase * 512 + (size_t)cd * T + (row0 - rowbase)) = w;
    }
}

constexpr int AT_KROW = 272, AT_VROW = 136, AT_KBYTES = 64 * AT_KROW, AT_BUF = AT_KBYTES + 128 * AT_VROW;
__device__ __forceinline__ void attn_item(const Params& p, const int item, const int j, LAS unsigned char* lds) {
    const int tid = my_tid(), wave = __builtin_amdgcn_readfirstlane(tid >> 6), lane = tid & 63, l32 = lane & 31, h = lane >> 5;
    int rowbase, T, qh, bs = -1, q0c = 0;
    if (item < 192) { bs = item / 96; const int rem = item % 96; qh = rem >> 3; q0c = (rem & 7) * 256; rowbase = NPROMPT + bs * 2048; T = 2048; }
    else { const int pi = item - 192; rowbase = (pi / 12) * 256; qh = pi % 12; T = 256; }
    const int kvh = qh / 3, q0 = q0c + wave * 32;
    const bf16_t* proj = (const bf16_t*)(p.ws + OFF_PROJ);
    bf16x8 qf[8];
    {
        const bf16_t* qp = proj + (size_t)(rowbase + q0 + l32) * INW + qh * 128 + 8 * h;
#pragma unroll
        for (int s = 0; s < 8; ++s) qf[s] = ldg16(qp + 16 * s);
    }
    float m = p.in[I_SINK][j * 12 + qh] * LOG2E, lsum = (h == 0) ? 1.f : 0.f;
    f32x16 oacc[4];
#pragma unroll
    for (int dt = 0; dt < 4; ++dt)
#pragma unroll
        for (int r = 0; r < 16; ++r) oacc[dt][r] = 0.f;
    int kl0 = 0, kl1 = 256, nctx = 0;
    if (bs >= 0) { kl0 = max(0, q0c - 128); kl1 = min(T, q0c + 384); nctx = 4; }
    const int nlc = (kl1 - kl0) >> 6, nch = nlc + nctx;
    const bf16_t* kg = proj + (size_t)rowbase * INW + 1536 + kvh * 128;
    const bf16_t* vg = (const bf16_t*)(p.ws + OFF_VT) + (size_t)rowbase * 512 + (size_t)(kvh * 128) * T;
    const bf16_t* ckg = (const bf16_t*)(p.ws + OFF_CTXK) + (size_t)((max(bs, 0) * 2 + j) * 256) * 512 + kvh * 128;
    const bf16_t* cvg = (const bf16_t*)(p.ws + OFF_CTXVT) + (size_t)(((max(bs, 0) * 2 + j) * 4 + kvh) * 128) * 256;
    const int krow = tid >> 4, kc16 = tid & 15, vrow = tid >> 3, vc16 = tid & 7;
    u32x4 skA[2], svA[2], skB[2], svB[2];
    auto stage_load = [&](const int ci, u32x4 (&sk)[2], u32x4 (&sv)[2]) {
        const bf16_t* kb; const bf16_t* vb; size_t kst, vst;
        if (ci < nlc) { const int ks = kl0 + 64 * ci; kb = kg + (size_t)ks * INW; kst = INW; vb = vg + ks; vst = (size_t)T; }
        else { const int ks = 64 * (ci - nlc); kb = ckg + (size_t)ks * 512; kst = 512; vb = cvg + ks; vst = 256; }
#pragma unroll
        for (int i = 0; i < 2; ++i) {
            sk[i] = *(const GAS u32x4*)(kb + (size_t)(krow + 32 * i) * kst + kc16 * 8);
            sv[i] = *(const GAS u32x4*)(vb + (size_t)(vrow + 64 * i) * vst + vc16 * 8);
        }
    };
    auto stage_store = [&](const int b, const u32x4 (&sk)[2], const u32x4 (&sv)[2]) {
        LAS unsigned char* base = lds + b * AT_BUF;
#pragma unroll
        for (int i = 0; i < 2; ++i) {
            *(LAS u32x4*)(base + (krow + 32 * i) * AT_KROW + kc16 * 16) = sk[i];
            LAS unsigned char* vd = base + AT_KBYTES + (vrow + 64 * i) * AT_VROW + vc16 * 16;
            u32x2 lo, hi; lo.x = sv[i].x; lo.y = sv[i].y; hi.x = sv[i].z; hi.y = sv[i].w;
            *(LAS u32x2*)vd = lo; *(LAS u32x2*)(vd + 8) = hi;
        }
    };
    constexpr float sc = 0.08838834764831845f * LOG2E;
    __syncthreads();
    stage_load(0, skA, svA); stage_store(0, skA, svA);
    if (nch > 1) stage_load(1, skA, svA);
    __syncthreads();
    auto chunk_step = [&](const int ci, u32x4 (&skc)[2], u32x4 (&svc)[2], u32x4 (&skn)[2], u32x4 (&svn)[2]) {
        if (ci + 2 < nch) stage_load(ci + 2, skn, svn);
        const LAS unsigned char* kbuf = lds + (ci & 1) * AT_BUF;
        const LAS unsigned char* vbuf = kbuf + AT_KBYTES;
        const bool local = ci < nlc;
        const int kc0 = kl0 + 64 * ci;
#pragma unroll 1
        for (int tt = 0; tt < 2; ++tt) {
            const int kt = kc0 + 32 * tt;
            bool masked = false;
            if (local && bs >= 0) { const int d = kt - (q0 - 128); if (d < 0 || d > 256) continue; masked = (d == 0 || d == 256); }
            bf16x8 kf[8];
            const LAS unsigned char* kp = kbuf + (tt * 32 + l32) * AT_KROW + 16 * h;
#pragma unroll
            for (int ks = 0; ks < 8; ++ks) kf[ks] = *(const LAS bf16x8*)(kp + 32 * ks);
            f32x16 s;
#pragma unroll
            for (int r = 0; r < 16; ++r) s[r] = 0.f;
            __builtin_amdgcn_s_setprio(1);
#pragma unroll
            for (int ks = 0; ks < 8; ++ks) s = mfma32(kf[ks], qf[ks], s);
            __builtin_amdgcn_s_setprio(0);
            bf16x8 vf[8];
            const LAS unsigned char* vp = vbuf + l32 * AT_VROW + (tt * 32 + 4 * h) * 2;
#pragma unroll
            for (int dt = 0; dt < 4; ++dt)
#pragma unroll
                for (int c = 0; c < 2; ++c) {
                    const bf16x4 a = *(const LAS bf16x4*)(vp + dt * 32 * AT_VROW + c * 32), b = *(const LAS bf16x4*)(vp + dt * 32 * AT_VROW + c * 32 + 16);
                    vf[dt * 2 + c] = __builtin_shufflevector(a, b, 0, 1, 2, 3, 4, 5, 6, 7);
                }
            float tmax = -3.0e38f;
            if (masked) {
                const int dqk = (q0 + l32) - kt - 4 * h;
#pragma unroll
                for (int r = 0; r < 16; ++r) { const int d = dqk - (8 * (r >> 2) + (r & 3)); if (d > 128 || d < -128) s[r] = -1.0e30f; tmax = fmaxf(tmax, s[r]); }
            } else {
#pragma unroll
                for (int r = 0; r < 16; ++r) tmax = fmaxf(tmax, s[r]);
            }
            { const auto rr = __builtin_amdgcn_permlane32_swap(__float_as_uint(tmax), __float_as_uint(tmax), false, false);
              tmax = fmaxf(__uint_as_float(rr[0]), __uint_as_float(rr[1])) * sc; }
            if (!__all(tmax - m <= 8.0f)) {
                const float mn = fmaxf(m, tmax), alpha = __builtin_amdgcn_exp2f(m - mn);
                m = mn; lsum *= alpha;
#pragma unroll
                for (int dt = 0; dt < 4; ++dt)
#pragma unroll
                    for (int r = 0; r < 16; ++r) oacc[dt][r] *= alpha;
            }
            float ps = 0.f;
#pragma unroll
            for (int r = 0; r < 16; ++r) { s[r] = __builtin_amdgcn_exp2f(__builtin_fmaf(s[r], sc, -m)); ps += s[r]; }
            lsum += ps;
            bf16x8 pb[2];
#pragma unroll
            for (int c = 0; c < 2; ++c) {
                u32x4 w; w.x = cvt_pk_bf16(s[8 * c + 0], s[8 * c + 1]); w.y = cvt_pk_bf16(s[8 * c + 2], s[8 * c + 3]); w.z = cvt_pk_bf16(s[8 * c + 4], s[8 * c + 5]); w.w = cvt_pk_bf16(s[8 * c + 6], s[8 * c + 7]);
                pb[c] = __builtin_bit_cast(bf16x8, w);
            }
            __builtin_amdgcn_s_setprio(1);
#pragma unroll
            for (int dt = 0; dt < 4; ++dt)
#pragma unroll
                for (int c = 0; c < 2; ++c) oacc[dt] = mfma32(vf[dt * 2 + c], pb[c], oacc[dt]);
            __builtin_amdgcn_s_setprio(0);
        }
        if (ci + 1 < nch) stage_store((ci + 1) & 1, skc, svc);
        __syncthreads();
    };
#pragma unroll 1
    for (int ci = 0; ci < nch; ci += 2) {
        chunk_step(ci, skA, svA, skB, svB);
        if (ci + 1 < nch) chunk_step(ci + 1, skB, svB, skA, svA);
    }
    const float lt = lsum + __shfl_xor(lsum, 32), inv = 1.f / lt;
    const size_t row = (size_t)(rowbase + q0 + l32);
    const bf16_t* gp = proj + row * INW + 2560 + qh * 128 + 4 * h;
    bf16_t* op = (bf16_t*)(p.ws + OFF_O) + row * DM + qh * 128 + 4 * h;
#pragma unroll
    for (int dt = 0; dt < 4; ++dt)
#pragma unroll
        for (int g4 = 0; g4 < 4; ++g4) {
            const u32x2 g = *(const GAS u32x2*)(gp + 32 * dt + 8 * g4);
            u32x2 w;
            w.x = cvt_pk_bf16(oacc[dt][4 * g4 + 0] * inv * silu(bflo(g.x)), oacc[dt][4 * g4 + 1] * inv * silu(bfhi(g.x)));
            w.y = cvt_pk_bf16(oacc[dt][4 * g4 + 2] * inv * silu(bflo(g.y)), oacc[dt][4 * g4 + 3] * inv * silu(bfhi(g.y)));
            *(GAS u32x2*)(op + 32 * dt + 8 * g4) = w;
        }
}

constexpr int PL_PITCH = 528;
constexpr int PL_POOLED = 80 * 528;
template <int HW>
__device__ __forceinline__ void pool_body(const Params& p, const int lj, const int g, const int row0, const int rowbase, const int T, LAS unsigned char* lds,
                                          const int tid, const int wave, const int lane, const int l32, const int h) {
    const bf16_t* proj = (const bf16_t*)(p.ws + OFF_PROJ);
    const int tl0 = row0 - rowbase;
    constexpr int NR = 64 + 2 * HW;
    bf16x8 afr[2][16];
    {
        const bf16_t* wt_ = (const bf16_t*)(p.ws + OFF_POOLW) + (size_t)((lj * 4 + g) * 8 + 2 * (wave >> 1)) * 8192 + lane * 8;
#pragma unroll
        for (int s = 0; s < 16; ++s) { afr[0][s] = ldg16(wt_ + 512 * s); afr[1][s] = ldg16(wt_ + 8192 + 512 * s); }
    }
    for (int idx = tid; idx < NR * 32; idx += 512) {
        const int r = idx >> 5, c16 = idx & 31, tt = tl0 - HW + r;
        u32x4 v; v.x = 0u; v.y = 0u; v.z = 0u; v.w = 0u;
        if (tt >= 0 && tt < T) v = *(const GAS u32x4*)(proj + (size_t)(rowbase + tt) * INW + g * 256 + c16 * 8);
        *(LAS u32x4*)(lds + r * PL_PITCH + c16 * 16) = v;
    }
    __syncthreads();
    const int ts = wave & 1, mp = wave >> 1;
    {
        const int tl = tl0 + ts * 32 + l32;
        const float rc = 1.f / (float)(min(tl + HW, T) - max(tl - HW, 0));
        const LAS unsigned char* sp = lds + (ts * 32 + l32) * PL_PITCH + 16 * h;
        LAS unsigned char* pp = lds + PL_POOLED + (ts * 32 + l32) * PL_PITCH + 16 * h;
#pragma unroll 1
        for (int s4 = 0; s4 < 4; ++s4) {
            const int s = mp * 4 + s4;
            float sum[8];
#pragma unroll
            for (int e = 0; e < 8; ++e) sum[e] = 0.f;
#pragma unroll
            for (int d = 0; d < 2 * HW; ++d) {
                const u32x4 v = *(const LAS u32x4*)(sp + d * PL_PITCH + 32 * s);
                sum[0] += bflo(v.x); sum[1] += bfhi(v.x); sum[2] += bflo(v.y); sum[3] += bfhi(v.y);
                sum[4] += bflo(v.z); sum[5] += bfhi(v.z); sum[6] += bflo(v.w); sum[7] += bfhi(v.w);
            }
            const u32x4 sv = *(const LAS u32x4*)(sp + HW * PL_PITCH + 32 * s);
            u32x4 w;
            w.x = cvt_pk_bf16(sum[0] * rc - bflo(sv.x), sum[1] * rc - bfhi(sv.x)); w.y = cvt_pk_bf16(sum[2] * rc - bflo(sv.y), sum[3] * rc - bfhi(sv.y));
            w.z = cvt_pk_bf16(sum[4] * rc - bflo(sv.z), sum[5] * rc - bfhi(sv.z)); w.w = cvt_pk_bf16(sum[6] * rc - bflo(sv.w), sum[7] * rc - bfhi(sv.w));
            *(LAS u32x4*)(pp + 32 * s) = w;
        }
    }
    __syncthreads();
    const LAS unsigned char* bp_ = lds + PL_POOLED + (ts * 32 + l32) * PL_PITCH + 16 * h;
    f32x16 acc[2];
#pragma unroll
    for (int m2 = 0; m2 < 2; ++m2)
#pragma unroll
        for (int r = 0; r < 16; ++r) acc[m2][r] = 0.f;
#pragma unroll
    for (int s = 0; s < 16; ++s) {
        const bf16x8 bfr = *(const LAS bf16x8*)(bp_ + 32 * s);
        acc[0] = mfma32(afr[0][s], bfr, acc[0]); acc[1] = mfma32(afr[1][s], bfr, acc[1]);
    }
    const int row = row0 + ts * 32 + l32;
    const float* psc = p.in[I_POOLS] + lj * 1024 + g * 256 + 4 * h;
    const bf16_t* gp = proj + (size_t)row * INW + 1024 + g * 256 + 4 * h;
    bf16_t* op = (bf16_t*)(p.ws + OFF_O) + (size_t)row * DM + g * 256 + 4 * h;
#pragma unroll
    for (int m2 = 0; m2 < 2; ++m2)
#pragma unroll
        for (int g4 = 0; g4 < 4; ++g4) {
            const int c0 = (2 * mp + m2) * 32 + 8 * g4;
            const u32x2 gg = *(const GAS u32x2*)(gp + c0);
            const f32x4 ps = *(const GAS f32x4*)(psc + c0);
            u32x2 w;
            w.x = cvt_pk_bf16(acc[m2][4 * g4 + 0] * ps[0] * silu(bflo(gg.x)), acc[m2][4 * g4 + 1] * ps[1] * silu(bfhi(gg.x)));
            w.y = cvt_pk_bf16(acc[m2][4 * g4 + 2] * ps[2] * silu(bflo(gg.y)), acc[m2][4 * g4 + 3] * ps[3] * silu(bfhi(gg.y)));
            *(GAS u32x2*)(op + c0) = w;
        }
}
__device__ __forceinline__ void pool_item(const Params& p, const int item, const int lj, LAS unsigned char* lds) {
    const int tid = my_tid(), wave = __builtin_amdgcn_readfirstlane(tid >> 6), lane = tid & 63, l32 = lane & 31, h = lane >> 5;
    const int tb = item >> 2, gs = item & 3, g = gs == 0 ? 0 : gs == 1 ? 3 : gs == 2 ? 1 : 2;
    const int row0 = tb * 64;
    int rowbase, T;
    if (row0 < NPROMPT) { rowbase = row0 & ~255; T = 256; } else { rowbase = NPROMPT + ((row0 - NPROMPT) & ~2047); T = 2048; }
    __syncthreads();
    if (g == 0) pool_body<1>(p, lj, g, row0, rowbase, T, lds, tid, wave, lane, l32, h);
    else if (g == 1) pool_body<2>(p, lj, g, row0, rowbase, T, lds, tid, wave, lane, l32, h);
    else if (g == 2) pool_body<4>(p, lj, g, row0, rowbase, T, lds, tid, wave, lane, l32, h);
    else pool_body<8>(p, lj, g, row0, rowbase, T, lds, tid, wave, lane, l32, h);
}

constexpr int SGU_PITCH = 260;
__device__ __forceinline__ void sgu_item(const Params& p, const int item, const int lj, LAS unsigned char* lds) {
    const int tid = my_tid(), wave = tid >> 6, lane = tid & 63, l32 = lane & 31, h = lane >> 5;
    const int ch = item >> 2, hd = item & 3, R0 = ch * 128;
    const bf16_t* proj = (const bf16_t*)(p.ws + OFF_PROJ);
    LAS bf16_t* vn = (LAS bf16_t*)lds;
    __syncthreads();
    bf16x8 wfr[4][8];
    {
        const bf16_t* wb_ = (const bf16_t*)(p.ws + OFF_SGUW) + (size_t)(lj * 4 + hd) * 16384 + lane * 8;
#pragma unroll
        for (int nt = 0; nt < 2; ++nt)
#pragma unroll
            for (int s = 0; s < 8; ++s) wfr[nt][s] = ldg16(wb_ + (size_t)nt * 4096 + 512 * s);
    }
    {
        const int q = tid >> 2, qt = tid & 3;
        const bf16_t* vp = proj + (size_t)(R0 + q) * INW + 3072 + hd * 256 + qt * 64;
        u32x4 v[8];
#pragma unroll
        for (int i = 0; i < 8; ++i) v[i] = *(const GAS u32x4*)(vp + 8 * i);
        float sm = 0.f;
#pragma unroll
        for (int i = 0; i < 8; ++i) sm += (bflo(v[i].x) + bfhi(v[i].x)) + (bflo(v[i].y) + bfhi(v[i].y)) + (bflo(v[i].z) + bfhi(v[i].z)) + (bflo(v[i].w) + bfhi(v[i].w));
        sm += __shfl_xor(sm, 1); sm += __shfl_xor(sm, 2);
        const float mu = sm * (1.f / 256.f);
        float sq = 0.f;
#pragma unroll
        for (int i = 0; i < 8; ++i) {
            float d;
            d = bflo(v[i].x) - mu; sq += d * d; d = bfhi(v[i].x) - mu; sq += d * d; d = bflo(v[i].y) - mu; sq += d * d; d = bfhi(v[i].y) - mu; sq += d * d;
            d = bflo(v[i].z) - mu; sq += d * d; d = bfhi(v[i].z) - mu; sq += d * d; d = bflo(v[i].w) - mu; sq += d * d; d = bfhi(v[i].w) - mu; sq += d * d;
        }
        sq += __shfl_xor(sq, 1); sq += __shfl_xor(sq, 2);
        const float rs = rsqrtf(sq * (1.f / 256.f) + 1e-6f);
        const float* gnp = p.in[I_SGUN] + lj * 1024 + hd * 256 + qt * 64;
        LAS bf16_t* dst = vn + q * SGU_PITCH + qt * 64;
#pragma unroll
        for (int i = 0; i < 8; ++i) {
            const f32x4 g0 = *(const f32x4*)(gnp + 8 * i), g1 = *(const f32x4*)(gnp + 8 * i + 4);
            u32x2 w0, w1;
            w0.x = cvt_pk_bf16((bflo(v[i].x) - mu) * rs * g0[0], (bfhi(v[i].x) - mu) * rs * g0[1]); w0.y = cvt_pk_bf16((bflo(v[i].y) - mu) * rs * g0[2], (bfhi(v[i].y) - mu) * rs * g0[3]);
            w1.x = cvt_pk_bf16((bflo(v[i].z) - mu) * rs * g1[0], (bfhi(v[i].z) - mu) * rs * g1[1]); w1.y = cvt_pk_bf16((bflo(v[i].w) - mu) * rs * g1[2], (bfhi(v[i].w) - mu) * rs * g1[3]);
            *(LAS u32x2*)(dst + 8 * i) = w0; *(LAS u32x2*)(dst + 8 * i + 4) = w1;
        }
    }
    __syncthreads();
    {
        const bf16_t* wb_ = (const bf16_t*)(p.ws + OFF_SGUW) + (size_t)(lj * 4 + hd) * 16384 + lane * 8;
#pragma unroll
        for (int nt = 2; nt < 4; ++nt)
#pragma unroll
            for (int s = 0; s < 8; ++s) wfr[nt][s] = ldg16(wb_ + (size_t)nt * 4096 + 512 * s);
    }
    bf16x8 af[8];
    {
        const int c = wave * 32 + l32;
#pragma unroll
        for (int s = 0; s < 8; ++s) {
            unsigned short e[8];
#pragma unroll
            for (int jj = 0; jj < 8; ++jj) e[jj] = vn[(16 * s + 8 * h + jj) * SGU_PITCH + c];
            u32x4 w; w.x = e[0] | ((unsigned)e[1] << 16); w.y = e[2] | ((unsigned)e[3] << 16); w.z = e[4] | ((unsigned)e[5] << 16); w.w = e[6] | ((unsigned)e[7] << 16);
            af[s] = __builtin_bit_cast(bf16x8, w);
        }
    }
    __syncthreads();
#pragma unroll
    for (int nt = 0; nt < 4; ++nt) {
        const int pp = nt * 32 + l32;
        f32x16 acc;
#pragma unroll
        for (int r = 0; r < 16; ++r) acc[r] = 0.f;
#pragma unroll
        for (int s = 0; s < 8; ++s) acc = mfma32(af[s], wfr[nt][s], acc);
        const float bias = p.in[I_SGUB][(lj * 4 + hd) * 128 + pp];
        LAS unsigned char* mp_ = lds + pp * PL_PITCH + (wave * 32 + 4 * h) * 2;
#pragma unroll
        for (int g4 = 0; g4 < 4; ++g4) {
            u32x2 w; w.x = cvt_pk_bf16(acc[4 * g4 + 0] + bias, acc[4 * g4 + 1] + bias); w.y = cvt_pk_bf16(acc[4 * g4 + 2] + bias, acc[4 * g4 + 3] + bias);
            *(LAS u32x2*)(mp_ + 16 * g4) = w;
        }
    }
    __syncthreads();
#pragma unroll 2
    for (int idx = tid; idx < 128 * 32; idx += 512) {
        const int pp = idx >> 5, c16 = idx & 31;
        const size_t row = (size_t)(R0 + pp);
        const int cb = hd * 256 + c16 * 8;
        const u32x4 mx = *(const LAS u32x4*)(lds + pp * PL_PITCH + c16 * 16);
        const u32x4 uu = *(const GAS u32x4*)(proj + row * INW + 2048 + cb), gg = *(const GAS u32x4*)(proj + row * INW + 4096 + cb);
        u32x4 w;
        w.x = cvt_pk_bf16(bflo(uu.x) * bflo(mx.x) * silu(bflo(gg.x)), bfhi(uu.x) * bfhi(mx.x) * silu(bfhi(gg.x)));
        w.y = cvt_pk_bf16(bflo(uu.y) * bflo(mx.y) * silu(bflo(gg.y)), bfhi(uu.y) * bfhi(mx.y) * silu(bfhi(gg.y)));
        w.z = cvt_pk_bf16(bflo(uu.z) * bflo(mx.z) * silu(bflo(gg.z)), bfhi(uu.z) * bfhi(mx.z) * silu(bfhi(gg.z)));
        w.w = cvt_pk_bf16(bflo(uu.w) * bflo(mx.w) * silu(bflo(gg.w)), bfhi(uu.w) * bfhi(mx.w) * silu(bfhi(gg.w)));
        *(GAS u32x4*)((bf16_t*)(p.ws + OFF_O) + row * DM + 1024 + cb) = w;
    }
}

#ifndef MK_SPLIT
#define MK_SPLIT 0
#endif

#define XB_TMO      128
#define XB_XCNT(j)  (256  + 64 * (j))
#define XB_XSUB(j)  (1280 + 64 * (j))
#define XB_XGEN(j)  (2304 + 64 * (j))
#define XB_TOP      3328
#define XB_TOPGEN   3392
#define XCD_BAR_WORDS 3456
#define XB_SPIN_CAP (1u << 18)

__device__ __forceinline__ unsigned xb_ld(unsigned* p)              { return __hip_atomic_load(p, __ATOMIC_RELAXED, __HIP_MEMORY_SCOPE_AGENT); }
__device__ __forceinline__ unsigned xb_add(unsigned* p, unsigned v) { return __hip_atomic_fetch_add(p, v, __ATOMIC_RELAXED, __HIP_MEMORY_SCOPE_AGENT); }
__device__ __forceinline__ unsigned xb_xcc_id() { return (unsigned)__builtin_amdgcn_s_getreg((3 << 11) | 20) & 0xFu; }
#define XB_SPIN(cond, bar) do { unsigned _sp = 0; while (cond) { __builtin_amdgcn_s_sleep(1); \
    if ((++_sp & 255u) == 0u) { if (xb_ld(&(bar)[XB_TMO])) break; if (_sp > XB_SPIN_CAP) { atomicAdd(&(bar)[XB_TMO], 1u); break; } } } } while (0)

struct XcdBarrier {
    unsigned* bar; unsigned x;
    volatile LAS unsigned* st;
};

__device__ __forceinline__ XcdBarrier xcd_barrier_post(unsigned* bar, volatile LAS unsigned* st) {
    XcdBarrier b; b.bar = bar; b.x = xb_xcc_id(); b.st = st;
    if (threadIdx.x == 0) (void)xb_add(&bar[XB_XCNT(b.x)], 1u);
    return b;
}
__device__ __forceinline__ void xcd_barrier_complete(unsigned* bar, unsigned x, unsigned& nloc, unsigned& nx) {
    const unsigned G = gridDim.x * gridDim.y * gridDim.z;
    unsigned sum, cnt, mine, sp = 0u;
    for (;;) {
        sum = 0u; cnt = 0u; mine = 0u;
#pragma unroll
        for (unsigned j = 0; j < 16; ++j) { const unsigned c = xb_ld(&bar[XB_XCNT(j)]); sum += c; cnt += (c > 0u) ? 1u : 0u; mine = (j == x) ? c : mine; }
        if (sum == G) break;
        __builtin_amdgcn_s_sleep(1);
        if ((++sp & 255u) == 0u) { if (xb_ld(&bar[XB_TMO])) break; if (sp > XB_SPIN_CAP) { atomicAdd(&bar[XB_TMO], 1u); break; } }
    }
    nloc = mine > 0u ? mine : 1u; nx = cnt > 0u ? cnt : 1u;
}

__device__ __forceinline__ void xcd_barrier(const XcdBarrier& b) {
    asm volatile("s_waitcnt vmcnt(0)" ::: "memory");
    __syncthreads();
    if (threadIdx.x == 0) {
        unsigned* bar = b.bar;
        __builtin_amdgcn_s_waitcnt(0);
        unsigned nloc = b.st[0], nx = b.st[1];
        if (nloc == 0u) { xcd_barrier_complete(bar, b.x, nloc, nx); b.st[0] = nloc; b.st[1] = nx; }
        const unsigned old = xb_add(&bar[XB_XSUB(b.x)], 1u);
        const unsigned gen = old / nloc;
        if (old + 1u == (gen + 1u) * nloc) {
            __builtin_amdgcn_fence(__ATOMIC_RELEASE, "agent");
            asm volatile("s_waitcnt vmcnt(0)" ::: "memory");
            const unsigned og = xb_add(&bar[XB_TOP], 1u);
            const unsigned tg = og / nx;
            if (og + 1u == (tg + 1u) * nx) xb_add(&bar[XB_TOPGEN], 1u);
            else XB_SPIN(xb_ld(&bar[XB_TOPGEN]) == tg, bar);
            __builtin_amdgcn_fence(__ATOMIC_ACQUIRE, "agent");
            xb_add(&bar[XB_XGEN(b.x)], 1u);
            asm volatile("s_waitcnt vmcnt(0)" ::: "memory");
        } else {
            XB_SPIN(xb_ld(&bar[XB_XGEN(b.x)]) == gen, bar);
            __builtin_amdgcn_fence(__ATOMIC_ACQUIRE, "agent");
            asm volatile("s_waitcnt vmcnt(0)" ::: "memory");
        }
    }
    __syncthreads();
}

#ifndef MK_ENABLE
#define MK_ENABLE 0x1ff
#endif
#define EN(x) (((MK_ENABLE) >> (x)) & 1)
#ifndef MK_DUP
#define MK_DUP 0
#endif
#define DUP(x) (1 + (((MK_DUP) >> (x)) & 1))
__global__ __launch_bounds__(512, 2) void fwd_megakernel(const Params p, const int ph_lo, const int ph_hi, const int use_sync) {
    extern __shared__ __attribute__((aligned(16))) unsigned char shm[];
    cg::grid_group grid = cg::this_grid();
    LAS unsigned char* lds = (LAS unsigned char*)shm;
    const int tid = my_tid(), wave = __builtin_amdgcn_readfirstlane(tid >> 6);
    if (use_sync == 2) grid.sync();
    volatile LAS unsigned* xst = (volatile LAS unsigned*)(lds + 131072);
    if (threadIdx.x < 4) xst[threadIdx.x] = 0u;
    __syncthreads();
    const XcdBarrier xb = xcd_barrier_post((unsigned*)(p.ws + OFF_BAR), xst);
    int ph = 0;
#define PHASE_BEGIN if (ph >= ph_lo && ph < ph_hi) { Params q = p; asm volatile("" : "+s"(q.ws), "+s"(q.out));
#define PHASE_END } ++ph; if (use_sync && ph > ph_lo && ph < ph_hi) xcd_barrier(xb);
#define PHASE_END_LAST } ++ph;
    PHASE_BEGIN for (int rep = 0; rep < DUP(3); ++rep) { if (EN(4)) phase0(q, shm); __syncthreads(); } if (MK_DUP & 1) { for (int i = 0; i < 20; ++i) xcd_barrier(xb); } PHASE_END
    PHASE_BEGIN if (EN(8)) phase_rows(q, -1); PHASE_END
#pragma unroll 1
    for (int l = 0; l < 4; ++l) {
        const int lj = l >> 1;
        PHASE_BEGIN
_Pragma("unroll 1") for (int rep = 0; rep < DUP(4); ++rep) {
            pg8::Gemm g; g.A = (const bf16_t*)(q.ws + OFF_H); g.Bt = (const bf16_t*)(q.ws + OFF_WTIN) + (size_t)l * 5120 * 2048; g.M = MROWS; g.N = INW; g.K = DM;
            pg8::StaticOrder S; S.init(g.M, g.N, (int)gridDim.x, (int)blockIdx.x);
            EpiProj E; E.O = (bf16_t*)(q.ws + OFF_PROJ); E.outk = q.out + (size_t)MROWS * DM; E.outv = E.outk + (size_t)32 * 2 * 256 * 512; E.even = (l & 1) == 0; E.j = lj;
            __syncthreads();
            if (EN(6)) pg8::gemm_phase<EpiProj, pg8::StaticOrder, false>(lds, g, S, E, nullptr);
            __syncthreads();
}
        PHASE_END
        if ((l & 1) == 0) {
            PHASE_BEGIN if (EN(3)) phase_even_prep(q, lj); PHASE_END
            PHASE_BEGIN
_Pragma("unroll 1") for (int rep = 0; rep < DUP(1); ++rep) {                if (blockIdx.x < 32) {
                    pg8::Gemm g; g.A = (const bf16_t*)(q.ws + OFF_TW2K); g.Bt = (const bf16_t*)(q.ws + OFF_YTS) + (size_t)lj * 1024 * 2048; g.M = 2048; g.N = 1024; g.K = 2048;
                    asm volatile("" : "+s"(g.A), "+s"(g.Bt), "+s"(g.M), "+s"(g.N), "+s"(g.K));
                    pg8::StaticOrder S; S.init(g.M, g.N, 32, (int)blockIdx.x);
                    EpiFnet E; E.proj = (const bf16_t*)(q.ws + OFF_PROJ); E.O = (bf16_t*)(q.ws + OFF_O); E.rowbase0 = NPROMPT; E.T = 2048; E.yh = (const float*)(q.ws + OFF_YH) + lj * 1024;
                    __syncthreads();
                    _Pragma("unroll 1") for (int rep2 = 0; rep2 < DUP(7); ++rep2) { if (EN(5)) pg8::gemm_phase<EpiFnet, pg8::StaticOrder, false>(lds, g, S, E, nullptr);
                    __syncthreads(); }
                } else {
                    const int nb = (int)gridDim.x - 32;
                    int fc, fG;
                    if (gridDim.x == 256) {
                        const int xq = (int)blockIdx.x & 7, kq_ = ((int)blockIdx.x >> 3) - 4;
                        if (kq_ < 24) {
#pragma unroll 1
                            for (int u = 0; u < 3; ++u) {
                                int item;
                                if (u == 0) item = (xq >> 2) * 96 + ((xq & 3) * 3 + (kq_ >> 3)) * 8 + (kq_ & 7);
                                else { const int pk = 2 * kq_ + (u - 1), gp_ = xq + 8 * (pk / 3); item = 192 + (gp_ >> 2) * 12 + (gp_ & 3) * 3 + pk % 3; }
                                if (EN(0)) attn_item(q, item, lj, lds);
                            }
                            fc = -1;
                        } else fc = xq * 4 + (kq_ - 24);
                        fG = 32;
                    } else {
                        for (int item = (int)blockIdx.x - 32; item < 576; item += nb) { if (EN(0)) attn_item(q, item, lj, lds); }
                        fc = (int)blockIdx.x - ((int)gridDim.x - 64); fG = 64;
                    }
                    __syncthreads();
                    pg8::Gemm g; g.A = (const bf16_t*)(q.ws + OFF_TW256); g.Bt = (const bf16_t*)(q.ws + OFF_YTP); g.M = 256; g.N = 16384; g.K = 512;
                    asm volatile("" : "+s"(g.A), "+s"(g.Bt), "+s"(g.M), "+s"(g.N), "+s"(g.K));
                    pg8::StaticOrder S; S.init(g.M, g.N, fG, fc);
                    EpiFnet E; E.proj = (const bf16_t*)(q.ws + OFF_PROJ); E.O = (bf16_t*)(q.ws + OFF_O); E.rowbase0 = 0; E.T = 256; E.yh = nullptr;
                    if (EN(5) && fc >= 0) pg8::gemm_phase<EpiFnet, pg8::StaticOrder, false>(lds, g, S, E, nullptr);
                    __syncthreads();
                }
}
            PHASE_END
        } else {
            PHASE_BEGIN
_Pragma("unroll 1") for (int rep = 0; rep < DUP(2); ++rep) {                for (int item = blockIdx.x; item < 384; item += gridDim.x) { if (EN(2)) sgu_item(q, item, lj, lds); }
                {
                    const int bx = (int)blockIdx.x, np = bx < 128 ? 2 : 4, first = bx < 128 ? 2 * bx : 256 + 4 * (bx - 128);
                    if (gridDim.x == 256) { for (int k = 0; k < np; ++k) { if (EN(1)) pool_item(q, first + k, lj, lds); } }
                    else { for (int k = bx; k < 768; k += (int)gridDim.x) { if (EN(1)) pool_item(q, k, lj, lds); } }
                }
                __syncthreads();
}
            PHASE_END
        }
        PHASE_BEGIN
_Pragma("unroll 1") for (int rep = 0; rep < DUP(5); ++rep) {
            pg8::Gemm g; g.A = (const bf16_t*)(q.ws + OFF_O); g.Bt = (const bf16_t*)(q.ws + OFF_WTOUT) + (size_t)l * 2048 * 2048; g.M = MROWS; g.N = DM; g.K = DM;
            pg8::StaticOrder S; S.init(g.M, g.N, (int)gridDim.x, (int)blockIdx.x);
            EpiY E; E.C = (bf16_t*)(q.ws + OFF_Y);
            __syncthreads();
            if (EN(7)) pg8::gemm_phase<EpiY, pg8::StaticOrder, false>(lds, g, S, E, nullptr);
            __syncthreads();
            if (EN(4) && gridDim.x == 256 && blockIdx.x >= 128 && l < 3) transpose_tiles(q, shm, l + 1);
}
        PHASE_END
        if (l < 3) { PHASE_BEGIN if (EN(8)) phase_rows(q, l); PHASE_END } else { PHASE_BEGIN if (EN(8)) phase_rows(q, l); PHASE_END_LAST }
    }
}

extern "C" void kernel_launch(void* const* d_in, const int* in_sizes, int n_in, void* d_out, int out_size, void* d_ws, size_t ws_size, hipStream_t stream) {
    constexpr size_t kDynLds = 131072 + 16;
    static int grid_blocks = 0;
    if (!grid_blocks) {
        int dev = 0, cus = 0, per_cu = 0;
        (void)hipGetDevice(&dev);
        (void)hipDeviceGetAttribute(&cus, hipDeviceAttributeMultiprocessorCount, dev);
        (void)hipFuncSetAttribute((const void*)fwd_megakernel, hipFuncAttributeMaxDynamicSharedMemorySize, (int)kDynLds);
        (void)hipOccupancyMaxActiveBlocksPerMultiprocessor(&per_cu, fwd_megakernel, 512, kDynLds);
        if (per_cu < 1) { fprintf(stderr, "occupancy query returned %d\n", per_cu); per_cu = 1; }
        if (per_cu > 1) per_cu = 1;
        grid_blocks = cus * per_cu;
        if (grid_blocks > 256) grid_blocks = 256;
    }
    if (ws_size < WS_NEED) { fprintf(stderr, "workspace too small: %zu < %zu\n", ws_size, WS_NEED); return; }
    Params p{};
    for (int i = 0; i < 18; ++i) p.in[i] = (const float*)d_in[i];
    p.out = (float*)d_out; p.ws = (unsigned char*)d_ws;
#if MK_SPLIT
    for (int ph = 0; ph < 22; ++ph) {
        int lo = ph, hi = ph + 1, us = 0;
        void* args[] = {(void*)&p, (void*)&lo, (void*)&hi, (void*)&us};
        hipLaunchCooperativeKernel((const void*)fwd_megakernel, dim3(grid_blocks), dim3(512), args, kDynLds, stream);
    }
#else
    (void)hipMemsetAsync((unsigned char*)d_ws + OFF_BAR, 0, 16384, stream);
    (void)hipMemsetAsync((unsigned char*)d_ws + OFF_MOD, 0, (size_t)4 * 3 * 6144 * 4, stream);
    int lo = 0, hi = 1000, us = 1;
    void* args[] = {(void*)&p, (void*)&lo, (void*)&hi, (void*)&us};
    hipError_t e = hipLaunchCooperativeKernel((const void*)fwd_megakernel, dim3(grid_blocks), dim3(512), args, kDynLds, stream);
    if (e != hipSuccess) fprintf(stderr, "cooperative launch failed: %s (grid %d)\n", hipGetErrorString(e), grid_blocks);
#endif
}
```

```cpp
#include <hip/hip_runtime.h>
#include <hip/hip_cooperative_groups.h>
#include <cstdio>
namespace cg = cooperative_groups;
namespace pg8 {
#define PG8_LAS __attribute__((address_space(3)))
typedef unsigned short bf16_t;
typedef short bf16x8 __attribute__((ext_vector_type(8)));
typedef float f32x4 __attribute__((ext_vector_type(4)));
typedef unsigned u32x4 __attribute__((ext_vector_type(4)));
constexpr int BM = 256, BK = 64, HALF = 128, HTB = HALF * BK * 2  , STAGE_BYTES = 8 * HTB, NXCD = 8, WGM = 8;

__host__ __device__ __forceinline__ int lds_byte(int r, int c) { const int st = (r >> 4) * 2 + (c >> 5), rr = r & 15, cc = c & 31, ob = rr * 64 + cc * 2; return st * 1024 + (ob ^ (((ob >> 9) & 1) << 5)); }
__host__ __device__ __forceinline__ void stage_rc(int b, int& R, int& C) { const int st = b / 1024, sb = b % 1024, swz = sb ^ (((sb >> 9) & 1) << 5); R = (st >> 1) * 16 + swz / 64; C = (st & 1) * 32 + (swz % 64) / 2; }
__host__ __device__ __forceinline__ int perm32(int rho) { const int n = rho >> 4, i = rho & 15; return 8 * (i >> 2) + 4 * n + (i & 3); }

struct Unit { int pm, pn; };
struct Gemm { const bf16_t* A; const bf16_t* Bt; int M, N, K; };

struct StaticOrder {
    int nM, nN, nwg, G, c;
    __host__ __device__ void init(int M, int N, int G_, int c_) { nM = M / BM; nN = N / BM; nwg = nM * nN; G = G_; c = c_; }
    __host__ __device__ bool next(int i, Unit& u) const {
        const long L = (long)i * G + c; if (L >= nwg) return false;
        int wgid = (int)L; { const int q = nwg / NXCD, r = nwg % NXCD, xcd = wgid % NXCD, off = wgid / NXCD; wgid = (xcd < r ? xcd * (q + 1) : r * (q + 1) + (xcd - r) * q) + off; }
        const int nig = WGM * nN, gid = wgid / nig, fm = gid * WGM, gsz = (nM - fm) < WGM ? (nM - fm) : WGM;
        u.pm = fm + ((wgid % nig) % gsz); u.pn = (wgid % nig) / gsz; return true;
    }
    __device__ __forceinline__ void a_ready(const Unit&) const {}
    __device__ __forceinline__ void done(const Unit&) const {}
};
typedef __bf16 bf16x2_t __attribute__((ext_vector_type(2)));
typedef float f32x2_t __attribute__((ext_vector_type(2)));
__device__ __forceinline__ unsigned cvt_pk_bf16(float lo, float hi) { const f32x2_t v = {lo, hi}; const bf16x2_t r = __builtin_convertvector(v, bf16x2_t); return __builtin_bit_cast(unsigned, r); }
template <class Epi, class Sched, bool STAMP = false>
__device__ __forceinline__ void gemm_phase(PG8_LAS unsigned char* lds, const Gemm g, const Sched& S, const Epi& E, unsigned long long* stamps) {
    int tid_ = threadIdx.x; asm volatile("" : "+v"(tid_));
    const int tid = tid_, wid = __builtin_amdgcn_readfirstlane(tid >> 6), lane = tid & 63, wr = wid >> 2, wc = wid & 3, fr = lane & 15, fq = lane >> 4;
    const int K = g.K, nt = K / BK;
    int ts_lo = 0, ts_hi = 0, nts = 0; const unsigned long long rt_entry = STAMP ? (unsigned long long)wall_clock64() : 0ull;
#define PG8_STAMP() do { if (STAMP && wid == 0 && nts < 64) { const unsigned long long _c = (unsigned long long)clock64(); \
        ts_lo = (lane == nts) ? (int)(unsigned)_c : ts_lo; ts_hi = (lane == nts) ? (int)(unsigned)(_c >> 32) : ts_hi; ++nts; } } while (0)
    PG8_STAMP();
    unsigned voffA[2], voffB[2];
#pragma unroll
    for (int i = 0; i < 2; ++i) { int R, C; stage_rc(tid * 16 + i * 8192, R, C); const int Rb = Epi::PERM ? ((R & ~31) + perm32(R & 31)) : R;
        voffA[i] = (unsigned)(R * K + C) * 2u; voffB[i] = (unsigned)(Rb * K + C) * 2u; }
    const size_t kstep = (size_t)(BK * 2);
    const size_t hstep = (size_t)HALF * K * 2;
    const size_t tstep = 2 * hstep;
    const unsigned ldsw = (unsigned)wid * 1024u;
    const int aoff = lds_byte(wr * 64 + fr, fq * 8), boff = lds_byte(wc * 32 + fr, fq * 8);
#define PG8_SA(b, h) (((b) * 2 + (h)) * HTB)
#define PG8_SB(b, h) ((4 + (b) * 2 + (h)) * HTB)
#define PG8_STAGE(bufoff, gbase, voff) do { _Pragma("unroll") for (int _i = 0; _i < 2; ++_i) \
        __builtin_amdgcn_global_load_lds((const unsigned*)((const char*)(gbase) + (voff)[_i]), (PG8_LAS unsigned*)(lds + (bufoff) + ldsw + _i * 8192), 16, 0, 0); } while (0)
#define PG8_LDA(dst, b, h) do { _Pragma("unroll") for (int m = 0; m < 4; ++m) _Pragma("unroll") for (int k = 0; k < 2; ++k) dst[m][k] = *(const PG8_LAS bf16x8*)(lds + PG8_SA(b, h) + aoff + m * 2048 + k * 1024); } while (0)
#define PG8_LDB(dst, b, h) do { _Pragma("unroll") for (int n = 0; n < 2; ++n) _Pragma("unroll") for (int k = 0; k < 2; ++k) dst[n][k] = *(const PG8_LAS bf16x8*)(lds + PG8_SB(b, h) + boff + n * 2048 + k * 1024); } while (0)
#define PG8_MMA(ai, bj, At, Bt) do { __builtin_amdgcn_s_setprio(1); _Pragma("unroll") for (int m = 0; m < 4; ++m) _Pragma("unroll") for (int n = 0; n < 2; ++n) _Pragma("unroll") for (int k = 0; k < 2; ++k) \
        acc[ai][bj][m][n] = __builtin_amdgcn_mfma_f32_16x16x32_bf16(Bt[n][k], At[m][k], acc[ai][bj][m][n], 0, 0, 0); __builtin_amdgcn_s_setprio(0); } while (0)
#define PG8_WAIT_V(n) asm volatile("s_waitcnt vmcnt(" #n ")" ::: "memory")
#define PG8_WAIT_L(n) asm volatile("s_waitcnt lgkmcnt(" #n ")" ::: "memory")
#define PG8_BAR __builtin_amdgcn_s_barrier()
#define PG8_SCHED __builtin_amdgcn_sched_barrier(0)
    Unit cur, nxt; int ui = 0;
    if (!S.next(0, cur)) return;
    f32x4 acc[2][2][4][2];
#pragma unroll
    for (int a = 0; a < 2; ++a)
#pragma unroll
        for (int b = 0; b < 2; ++b)
#pragma unroll
            for (int m = 0; m < 4; ++m)
#pragma unroll
                for (int n = 0; n < 2; ++n) acc[a][b][m][n] = (f32x4){0.f, 0.f, 0.f, 0.f};
    bf16x8 At[4][2], B0[2][2], B1[2][2];
    const char* cA = (const char*)g.A + (size_t)cur.pm * tstep; const char* cB = (const char*)g.Bt + (size_t)cur.pn * tstep;
    S.a_ready(cur);
    PG8_STAGE(PG8_SB(0, 0), cB, voffB); PG8_STAGE(PG8_SA(0, 0), cA, voffA); PG8_STAGE(PG8_SB(0, 1), cB + hstep, voffB); PG8_STAGE(PG8_SA(0, 1), cA + hstep, voffA);
    if (wr == 1) PG8_BAR;
    PG8_WAIT_V(4); PG8_BAR;
    PG8_STAGE(PG8_SB(1, 0), cB + kstep, voffB); PG8_STAGE(PG8_SA(1, 0), cA + kstep, voffA); PG8_STAGE(PG8_SB(1, 1), cB + hstep + kstep, voffB);
    PG8_WAIT_V(6); PG8_BAR;
    PG8_STAMP();
    for (;;) {
        const bool has_next = S.next(ui + 1, nxt);
        const char* nA = has_next ? (const char*)g.A + (size_t)nxt.pm * tstep : cA; const char* nB = has_next ? (const char*)g.Bt + (size_t)nxt.pn * tstep : cB;
        for (int t = 0; t < nt; t += 2) {
            const bool last = (t == nt - 2);
            const char* a1 = cA + (size_t)(t + 1) * kstep;
            const char* a2 = last ? nA : cA + (size_t)(t + 2) * kstep; const char* b2 = last ? nB : cB + (size_t)(t + 2) * kstep;
            const char* a3 = a2 + kstep; const char* b3 = b2 + kstep;
            if (last && has_next) S.a_ready(nxt);
            PG8_LDB(B0, 0, 0); PG8_SCHED; PG8_LDA(At, 0, 0); PG8_STAGE(PG8_SA(1, 1), a1 + hstep, voffA);
            PG8_WAIT_L(8); PG8_BAR; PG8_WAIT_L(0); PG8_MMA(0, 0, At, B0); PG8_BAR; PG8_SCHED;
            PG8_LDB(B1, 0, 1); PG8_STAGE(PG8_SB(0, 0), b2, voffB);
            PG8_BAR; PG8_WAIT_L(0); PG8_MMA(0, 1, At, B1); PG8_BAR;
            PG8_LDA(At, 0, 1); PG8_STAGE(PG8_SA(0, 0), a2, voffA);
            PG8_BAR; PG8_WAIT_L(0); PG8_MMA(1, 0, At, B0); PG8_BAR; PG8_SCHED;
            PG8_STAGE(PG8_SB(0, 1), b2 + hstep, voffB);
            PG8_WAIT_V(6); PG8_BAR; PG8_MMA(1, 1, At, B1); PG8_BAR;
            PG8_LDB(B0, 1, 0); PG8_SCHED; PG8_LDA(At, 1, 0); PG8_STAGE(PG8_SA(0, 1), a2 + hstep, voffA);
            PG8_WAIT_L(8); PG8_BAR; PG8_WAIT_L(0); PG8_MMA(0, 0, At, B0); PG8_BAR; PG8_SCHED;
            PG8_LDB(B1, 1, 1); PG8_STAGE(PG8_SB(1, 0), b3, voffB);
            PG8_BAR; PG8_WAIT_L(0); PG8_MMA(0, 1, At, B1); PG8_BAR;
            PG8_LDA(At, 1, 1); PG8_STAGE(PG8_SA(1, 0), a3, voffA);
            PG8_BAR; PG8_WAIT_L(0); PG8_MMA(1, 0, At, B0); PG8_BAR; PG8_SCHED;
            PG8_STAGE(PG8_SB(1, 1), b3 + hstep, voffB);
            PG8_WAIT_V(6); PG8_BAR; PG8_MMA(1, 1, At, B1); PG8_BAR;
        }
        PG8_STAMP();
        if constexpr (!Epi::AFTER_DRAIN) { E(acc, cur, wr, wc, fr, fq); S.done(cur); }
        PG8_STAMP();
        if (!has_next) break;
#pragma unroll
        for (int a = 0; a < 2; ++a)
#pragma unroll
            for (int b = 0; b < 2; ++b)
#pragma unroll
                for (int m = 0; m < 4; ++m)
#pragma unroll
                    for (int n = 0; n < 2; ++n) acc[a][b][m][n] = (f32x4){0.f, 0.f, 0.f, 0.f};
        cur = nxt; cA = nA; cB = nB; ++ui;
    }
    PG8_WAIT_V(0);
    if (wr == 0) PG8_BAR;
    PG8_BAR;
    if constexpr (Epi::AFTER_DRAIN) { E.fused(acc, cur, wr, wc, fr, fq, lds, wid, lane); S.done(cur); }
    PG8_STAMP();
    if (STAMP && wid == 0) { stamps[lane] = lane < nts ? (((unsigned long long)(unsigned)ts_hi << 32) | (unsigned)ts_lo) : 0ull;
        if (lane == 62) stamps[62] = rt_entry; if (lane == 63) stamps[63] = (unsigned long long)wall_clock64(); }
#undef PG8_STAMP
#undef PG8_SA
#undef PG8_SB
#undef PG8_STAGE
#undef PG8_LDA
#undef PG8_LDB
#undef PG8_MMA
#undef PG8_WAIT_V
#undef PG8_WAIT_L
#undef PG8_BAR
#undef PG8_SCHED
}
}


using pg8::bf16_t; using pg8::bf16x8; using pg8::f32x4; using pg8::u32x4; using pg8::cvt_pk_bf16;
typedef float f32x16 __attribute__((ext_vector_type(16)));
typedef short bf16x4 __attribute__((ext_vector_type(4)));
typedef unsigned u32x2 __attribute__((ext_vector_type(2)));
#define LAS __attribute__((address_space(3)))

constexpr int DM = 2048, MROWS = 12288, NPROMPT = 8192, INW = 5120;
constexpr float LOG2E = 1.4426950408889634f;

constexpr size_t OFF_WTIN  = 0;
constexpr size_t OFF_WTOUT = OFF_WTIN  + (size_t)4 * 5120 * 2048 * 2;
constexpr size_t OFF_MOD   = OFF_WTOUT + (size_t)4 * 2048 * 2048 * 2;
constexpr size_t OFF_H     = OFF_MOD   + (size_t)4 * 3 * 6144 * 4;
constexpr size_t OFF_PROJ  = OFF_H     + (size_t)MROWS * 2048 * 2;
constexpr size_t OFF_O     = OFF_PROJ  + (size_t)MROWS * 5120 * 2;
constexpr size_t OFF_Y     = OFF_O     + (size_t)MROWS * 2048 * 2;
constexpr size_t OFF_VT    = OFF_Y     + (size_t)MROWS * 2048 * 4;
constexpr size_t OFF_CTXK  = OFF_VT    + (size_t)MROWS * 512 * 2;
constexpr size_t OFF_CTXVT = OFF_CTXK  + (size_t)2 * 2 * 256 * 512 * 2;
constexpr size_t OFF_YTP   = OFF_CTXVT + (size_t)2 * 2 * 256 * 512 * 2;
constexpr size_t OFF_YTS   = OFF_YTP   + (size_t)32 * 512 * 512 * 2;
constexpr size_t OFF_TW256 = OFF_YTS   + (size_t)2 * 512 * 4096 * 2;
constexpr size_t OFF_TW2K  = OFF_TW256 + (size_t)256 * 512 * 2;
constexpr size_t OFF_CCS   = OFF_TW2K  + (size_t)2048 * 4096 * 2;
constexpr size_t OFF_POOLW = OFF_CCS   + (size_t)256 * 128 * 2;
constexpr size_t OFF_SGUW  = OFF_POOLW + (size_t)2 * 4 * 256 * 256 * 2;
constexpr size_t OFF_BAR   = OFF_SGUW  + (size_t)2 * 4 * 128 * 128 * 2;
constexpr size_t OFF_YH    = OFF_BAR + 16384;
constexpr size_t OFF_XB    = OFF_YH + 8192;
constexpr size_t WS_NEED   = OFF_XB + (size_t)MROWS * 2048 * 2;

struct Params { const float* in[18]; float* out; unsigned char* ws; };
enum { I_XP = 0, I_XS, I_CK, I_CV, I_C, I_CCTX, I_WADA, I_BADA, I_NPRE, I_NPOST, I_WIN, I_WOUT, I_SINK, I_POOLW, I_POOLS, I_SGUN, I_SGUW, I_SGUB };

__device__ __forceinline__ int my_tid() { int t = threadIdx.x; asm volatile("" : "+v"(t)); return t; }
__device__ __forceinline__ float bflo(unsigned w) { return __uint_as_float(w << 16); }
__device__ __forceinline__ float bfhi(unsigned w) { return __uint_as_float(w & 0xffff0000u); }
__device__ __forceinline__ float bf1(bf16_t b) { return __uint_as_float(((unsigned)b) << 16); }
__device__ __forceinline__ float silu(float x) { return x * __builtin_amdgcn_rcpf(1.f + __builtin_amdgcn_exp2f(-1.4426950408889634f * x)); }
__device__ __forceinline__ bf16_t f2bf(float f) { return (bf16_t)(cvt_pk_bf16(f, 0.f) & 0xffffu); }
__device__ __forceinline__ float wave_sum(float v) {
#pragma unroll
    for (int o = 32; o >= 1; o >>= 1) v += __shfl_xor(v, o);
    return v;
}
__device__ __forceinline__ bf16x8 ld16(const bf16_t* p) { return *(const bf16x8*)p; }
__device__ __forceinline__ bf16x8 ld8x2(const bf16_t* p0, const bf16_t* p1) {
    const bf16x4 a = *(const bf16x4*)p0, b = *(const bf16x4*)p1;
    return __builtin_shufflevector(a, b, 0, 1, 2, 3, 4, 5, 6, 7);
}
#define GAS __attribute__((address_space(1)))
__device__ __forceinline__ bf16x8 ldg16(const bf16_t* p) { return *(const GAS bf16x8*)p; }
__device__ __forceinline__ bf16x8 ldg8x2(const bf16_t* p0, const bf16_t* p1) {
    const bf16x4 a = *(const GAS bf16x4*)p0, b = *(const GAS bf16x4*)p1;
    return __builtin_shufflevector(a, b, 0, 1, 2, 3, 4, 5, 6, 7);
}
__device__ __forceinline__ f32x16 mfma32(bf16x8 a, bf16x8 b, f32x16 c) { return __builtin_amdgcn_mfma_f32_32x32x16_bf16(a, b, c, 0, 0, 0); }

__device__ __forceinline__ void transpose_tiles(const Params& p, unsigned char* smem, const int l) {
    float* tile = (float*)smem + 3 * 2048 + 8 * 3 * 256;
    volatile int* slot = (volatile int*)(tile + 128 * 129);
    const int tid = my_tid();
    unsigned* qcnt = (unsigned*)(p.ws + OFF_BAR) + 3500 + l;
    const float* win = p.in[I_WIN] + (size_t)l * 2048 * 5120; const float* wout = p.in[I_WOUT] + (size_t)l * 2048 * 2048;
    bf16_t* wtin = (bf16_t*)(p.ws + OFF_WTIN) + (size_t)l * 5120 * 2048; bf16_t* wtout = (bf16_t*)(p.ws + OFF_WTOUT) + (size_t)l * 2048 * 2048;
    __syncthreads();
    if (tid == 0) *slot = (int)atomicAdd(qcnt, 1u);
    __syncthreads();
    int cur = *slot;
    const int rr = tid >> 5, c4 = (tid & 31) * 4, nn = tid >> 2, kq0 = tid & 3;
    while (cur < 896) {
        int nxt = 0;
        if (tid == 0) nxt = (int)atomicAdd(qcnt, 1u);
        const float* src; bf16_t* dst; int N, kt, nt;
        if (cur < 640) { kt = cur / 40; nt = cur % 40; N = 5120; src = win; dst = wtin; }
        else { const int r = cur - 640; kt = r >> 4; nt = r & 15; N = 2048; src = wout; dst = wtout; }
        const int k0 = kt * 128, n0 = nt * 128;
        f32x4 v[8];
#pragma unroll
        for (int i = 0; i < 8; ++i) v[i] = __builtin_nontemporal_load((const GAS f32x4*)(src + (size_t)(k0 + rr + 16 * i) * N + n0 + c4));
#pragma unroll
        for (int i = 0; i < 8; ++i) { float* tp = tile + (rr + 16 * i) * 129 + c4; tp[0] = v[i][0]; tp[1] = v[i][1]; tp[2] = v[i][2]; tp[3] = v[i][3]; }
        __syncthreads();
#pragma unroll
        for (int jj = 0; jj < 4; ++jj) {
            const int kq = kq0 + 4 * jj;
            float t[8];
#pragma unroll
            for (int e = 0; e < 8; ++e) t[e] = tile[(kq * 8 + e) * 129 + nn];
            u32x4 w; w.x = cvt_pk_bf16(t[0], t[1]); w.y = cvt_pk_bf16(t[2], t[3]); w.z = cvt_pk_bf16(t[4], t[5]); w.w = cvt_pk_bf16(t[6], t[7]);
            *(GAS u32x4*)(dst + (size_t)(n0 + nn) * 2048 + k0 + kq * 8) = w;
        }
        if (tid == 0) *slot = nxt;
        __syncthreads();
        cur = *slot;
    }
}

__device__ __forceinline__ void phase0(const Params& p, unsigned char* smem) {
    float* sc = (float*)smem;
    float* red = sc + 3 * 2048;
    const int tid = my_tid(), wave = tid >> 6, lane = tid & 63;
    for (int i = tid; i < 3 * 2048; i += 512) {
        const int ci = i >> 11, k = i & 2047;
        const float v = ci == 0 ? p.in[I_CCTX][k] : p.in[I_C][(ci - 1) * 2048 + k];
        sc[i] = silu(v);
    }
    __syncthreads();
    float* mod = (float*)(p.ws + OFF_MOD);
    for (int item = blockIdx.x; item < 192; item += gridDim.x) {
        const int l = item / 48, rem = item % 48, n0 = (rem >> 1) * 256, kh = rem & 1;
        const float* wp = p.in[I_WADA] + ((size_t)l * 2048 + kh * 1024 + wave * 128) * 6144 + n0 + lane * 4;
        const float* s0 = sc + kh * 1024 + wave * 128;
        f32x4 a0 = {0.f, 0.f, 0.f, 0.f}, a1 = a0, a2 = a0;
#pragma unroll 8
        for (int kk = 0; kk < 128; ++kk) {
            const f32x4 wv = __builtin_nontemporal_load((const GAS f32x4*)(wp + (size_t)kk * 6144));
            a0 += wv * s0[kk]; a1 += wv * s0[2048 + kk]; a2 += wv * s0[4096 + kk];
        }
        *(f32x4*)(red + (wave * 3 + 0) * 256 + lane * 4) = a0; *(f32x4*)(red + (wave * 3 + 1) * 256 + lane * 4) = a1; *(f32x4*)(red + (wave * 3 + 2) * 256 + lane * 4) = a2;
        __syncthreads();
        for (int o = tid; o < 768; o += 512) {
            const int ci = o >> 8, col = o & 255;
            float s_ = kh == 0 ? p.in[I_BADA][l * 6144 + n0 + col] : 0.f;
#pragma unroll
            for (int w = 0; w < 8; ++w) s_ += red[(w * 3 + ci) * 256 + col];
            atomicAdd(mod + (l * 3 + ci) * 6144 + n0 + col, s_);
        }
        __syncthreads();
    }
    const int lcv = gridDim.x == 256 ? 1 : 4;
#pragma unroll 1
    for (int l = 0; l < lcv; ++l) transpose_tiles(p, smem, l);
    const int gt = blockIdx.x * 512 + tid, NT = gridDim.x * 512;
    {
        bf16_t* o = (bf16_t*)(p.ws + OFF_POOLW);
        for (int idx = gt; idx < 2 * 4 * 256 * 256; idx += NT) {
            const int lg = idx >> 16, mt = (idx >> 13) & 7, s_ = (idx >> 9) & 15, ln = (idx >> 3) & 63, jj = idx & 7;
            const int d = mt * 32 + (ln & 31), c = s_ * 16 + (ln >> 5) * 8 + jj;
            o[idx] = f2bf(p.in[I_POOLW][(lg * 256 + c) * 256 + d]);
        }
    }
    {
        bf16_t* o = (bf16_t*)(p.ws + OFF_SGUW);
        for (int idx = gt; idx < 2 * 4 * 128 * 128; idx += NT) {
            const int lh = idx >> 14, nt = (idx >> 12) & 3, s_ = (idx >> 9) & 7, ln = (idx >> 3) & 63, jj = idx & 7;
            const int pp = nt * 32 + (ln & 31), qq = s_ * 16 + (ln >> 5) * 8 + jj;
            o[idx] = f2bf(p.in[I_SGUW][(lh * 128 + pp) * 128 + qq]);
        }
    }
    {
        bf16_t* o = (bf16_t*)(p.ws + OFF_CCS);
        for (int idx = gt; idx < 256 * 128; idx += NT) {
            const int nt_ = idx >> 12, s_ = (idx >> 9) & 7, ln = (idx >> 3) & 63, jj = idx & 7;
            const int R = nt_ * 32 + (ln & 31), c = s_ * 16 + (ln >> 5) * 8 + jj, cs = R >> 7, cp = R & 127; const float x = (float)((c * cp) & 127) * (1.f / 128.f);
            const float v = cs ? __builtin_amdgcn_sinf(x) : __builtin_amdgcn_cosf(x);
            o[idx] = f2bf(v * 0.08838834764831845f);
        }
    }
    {
        bf16_t* o = (bf16_t*)(p.ws + OFF_TW256);
        for (int idx = gt; idx < 256 * 512; idx += NT) {
            const int tp = idx >> 9, k = idx & 511, t = k & 255, isS = k >> 8; const float x = (float)((t * tp) & 255) * (1.f / 256.f);
            const float v = isS ? -__builtin_amdgcn_sinf(x) : __builtin_amdgcn_cosf(x);
            o[idx] = f2bf(v * 0.0625f);
        }
    }
    {
        unsigned* o = (unsigned*)(p.ws + OFF_TW2K);
        for (int idx = gt; idx < 2048 * 1024; idx += NT) {
            const int tp = idx >> 10, k = (idx & 1023) * 2, t = k & 1023, isS = k >> 10;
            const float x0 = (float)((t * tp) & 2047) * (1.f / 2048.f), x1 = (float)(((t + 1) * tp) & 2047) * (1.f / 2048.f);
            float v0 = isS ? -__builtin_amdgcn_sinf(x0) : __builtin_amdgcn_cosf(x0);
            const float v1 = isS ? -__builtin_amdgcn_sinf(x1) : __builtin_amdgcn_cosf(x1);
            if (k == 1024) v0 = (tp & 1) ? -1.f : 1.f;
            o[idx] = cvt_pk_bf16(v0 * 0.022097086912079608f, v1 * 0.022097086912079608f);
        }
    }
    {
        bf16_t* ok = (bf16_t*)(p.ws + OFF_CTXK); bf16_t* ov = (bf16_t*)(p.ws + OFF_CTXVT);
        for (int idx = gt; idx < 2 * 2 * 256 * 512; idx += NT) {
            ok[idx] = f2bf(p.in[I_CK][idx]);
            const int t = idx & 255, dim = (idx >> 8) & 127, kvh = (idx >> 15) & 3, bj = idx >> 17;
            ov[idx] = f2bf(p.in[I_CV][((bj * 256 + t) * 4 + kvh) * 128 + dim]);
        }
    }
}

__device__ __forceinline__ void phase_rows(const Params& p, const int l) {
    const int tid = my_tid(), wave = tid >> 6, lane = tid & 63;
    const float* mod = (const float*)(p.ws + OFF_MOD);
    const bf16_t* ybuf = (const bf16_t*)(p.ws + OFF_Y);
    bf16_t* hbuf = (bf16_t*)(p.ws + OFF_H);
    for (int row = blockIdx.x * 8 + wave; row < MROWS; row += gridDim.x * 8) {
        const int ci = row < NPROMPT ? 0 : 1 + ((row - NPROMPT) >> 11);
        bf16_t* xb = (bf16_t*)(p.ws + OFF_XB) + (size_t)row * DM;
        f32x4 x[8];
        if (l <= 0) {
            const float* xs = row < NPROMPT ? p.in[I_XP] + (size_t)row * DM : p.in[I_XS] + (size_t)(row - NPROMPT) * DM;
#pragma unroll
            for (int i = 0; i < 8; ++i) x[i] = __builtin_nontemporal_load((const GAS f32x4*)(xs + i * 256 + lane * 4));
        } else {
#pragma unroll
            for (int i = 0; i < 8; ++i) { const u32x2 xw = __builtin_nontemporal_load((const GAS u32x2*)(xb + i * 256 + lane * 4)); x[i][0] = bflo(xw.x); x[i][1] = bfhi(xw.x); x[i][2] = bflo(xw.y); x[i][3] = bfhi(xw.y); }
        }
        if (l >= 0) {
            f32x4 y[8]; float ss = 0.f;
#pragma unroll
            for (int i = 0; i < 8; ++i) { const u32x2 yw = __builtin_nontemporal_load((const GAS u32x2*)(ybuf + (size_t)row * DM + i * 256 + lane * 4)); y[i][0] = bflo(yw.x); y[i][1] = bfhi(yw.x); y[i][2] = bflo(yw.y); y[i][3] = bfhi(yw.y); ss += y[i][0] * y[i][0] + y[i][1] * y[i][1] + y[i][2] * y[i][2] + y[i][3] * y[i][3]; }
            ss = wave_sum(ss);
            const float r = rsqrtf(ss * (1.f / 2048.f) + 1e-6f);
            const float* gate = mod + (l * 3 + ci) * 6144 + 4096; const float* np = p.in[I_NPOST] + l * 2048;
#pragma unroll
            for (int i = 0; i < 8; ++i) {
                const f32x4 g = *(const f32x4*)(gate + i * 256 + lane * 4), w = *(const f32x4*)(np + i * 256 + lane * 4);
#pragma unroll
                for (int e = 0; e < 4; ++e) x[i][e] += g[e] * (y[i][e] * r * w[e]);
                if (l == 3) *(GAS f32x4*)(p.out + (size_t)row * DM + i * 256 + lane * 4) = x[i];
                else { u32x2 xo; xo.x = cvt_pk_bf16(x[i][0], x[i][1]); xo.y = cvt_pk_bf16(x[i][2], x[i][3]); *(GAS u32x2*)(xb + i * 256 + lane * 4) = xo; }
            }
        }
        if (l < 3) {
            const int l1 = l + 1;
            float ss = 0.f;
#pragma unroll
            for (int i = 0; i < 8; ++i) ss += x[i][0] * x[i][0] + x[i][1] * x[i][1] + x[i][2] * x[i][2] + x[i][3] * x[i][3];
            ss = wave_sum(ss);
            const float r = rsqrtf(ss * (1.f / 2048.f) + 1e-6f);
            const float* shift = mod + (l1 * 3 + ci) * 6144; const float* scale = shift + 2048; const float* np = p.in[I_NPRE] + l1 * 2048;
#pragma unroll
            for (int i = 0; i < 8; ++i) {
                const f32x4 sh = *(const f32x4*)(shift + i * 256 + lane * 4), sl = *(const f32x4*)(scale + i * 256 + lane * 4), w = *(const f32x4*)(np + i * 256 + lane * 4);
                float hv[4];
#pragma unroll
                for (int e = 0; e < 4; ++e) hv[e] = (x[i][e] * r * w[e]) * (1.f + sl[e]) + sh[e];
                u32x2 o; o.x = cvt_pk_bf16(hv[0], hv[1]); o.y = cvt_pk_bf16(hv[2], hv[3]);
                *(u32x2*)(hbuf + (size_t)row * DM + i * 256 + lane * 4) = o;
            }
        }
    }
}

struct EpiProj {
    static constexpr bool PERM = true, AFTER_DRAIN = false;
    bf16_t* O; float* outk; float* outv; int even, j;
    __device__ __forceinline__ void operator()(const f32x4 (&acc)[2][2][4][2], const pg8::Unit& u, int wr, int wc, int fr, int fq) const {
        asm volatile("" : "+v"(fr), "+v"(fq));
        const int rloc0 = wr * 64 + fr, col0 = u.pn * 256 + wc * 32 + 8 * fq;
        const bool kv = even && u.pm < 32 && u.pn >= 6 && u.pn < 10;
        float* cbase = nullptr;
        if (kv) cbase = (u.pn < 8 ? outk : outv) + ((size_t)(u.pm * 2 + j) * 256) * 512 + ((u.pn & 1) * 256 + wc * 32 + 8 * fq);
#pragma unroll
        for (int ai = 0; ai < 2; ++ai)
#pragma unroll
            for (int m = 0; m < 4; ++m) {
                const int rloc = rloc0 + ai * 128 + m * 16;
                bf16_t* rowp = O + (size_t)(u.pm * 256 + rloc) * INW + col0;
#pragma unroll
                for (int bj = 0; bj < 2; ++bj) {
                    const f32x4 v0 = acc[ai][bj][m][0], v1 = acc[ai][bj][m][1];
                    u32x4 w; w.x = cvt_pk_bf16(v0[0], v0[1]); w.y = cvt_pk_bf16(v0[2], v0[3]); w.z = cvt_pk_bf16(v1[0], v1[1]); w.w = cvt_pk_bf16(v1[2], v1[3]);
                    *(u32x4*)(rowp + bj * 128) = w;
                    if (kv) { float* cp = cbase + (size_t)rloc * 512 + bj * 128; *(f32x4*)cp = v0; *(f32x4*)(cp + 4) = v1; }
                    __builtin_amdgcn_sched_barrier(0);
                }
            }
    }
};
struct EpiY {
    static constexpr bool PERM = true, AFTER_DRAIN = false;
    bf16_t* C;
    __device__ __forceinline__ void operator()(const f32x4 (&acc)[2][2][4][2], const pg8::Unit& u, int wr, int wc, int fr, int fq) const {
        asm volatile("" : "+v"(fr), "+v"(fq));
        const int row0 = u.pm * 256 + wr * 64 + fr, col0 = u.pn * 256 + wc * 32 + 8 * fq;
#pragma unroll
        for (int ai = 0; ai < 2; ++ai)
#pragma unroll
            for (int m = 0; m < 4; ++m) {
                bf16_t* rowp = C + (size_t)(row0 + ai * 128 + m * 16) * DM + col0;
#pragma unroll
                for (int bj = 0; bj < 2; ++bj) {
                    const f32x4 v0 = acc[ai][bj][m][0], v1 = acc[ai][bj][m][1];
                    u32x4 w; w.x = cvt_pk_bf16(v0[0], v0[1]); w.y = cvt_pk_bf16(v0[2], v0[3]); w.z = cvt_pk_bf16(v1[0], v1[1]); w.w = cvt_pk_bf16(v1[2], v1[3]);
                    *(u32x4*)(rowp + bj * 128) = w;
                }
            }
    }
};
struct EpiFnet {
    static constexpr bool PERM = true, AFTER_DRAIN = false;
    const bf16_t* proj; bf16_t* O; int rowbase0, T; const float* yh;
    __device__ __forceinline__ void operator()(const f32x4 (&acc)[2][2][4][2], const pg8::Unit& u, int wr, int wc, int fr, int fq) const {
        asm volatile("" : "+v"(fr), "+v"(fq));
        const int row0 = rowbase0 + (u.pn >> 1) * T + u.pm * 256 + wr * 64 + fr, col0 = (u.pn & 1) * 256 + wc * 32 + 8 * fq;
#pragma unroll
        for (int ai = 0; ai < 2; ++ai)
#pragma unroll
            for (int m = 0; m < 4; ++m) {
                const size_t row = (size_t)(row0 + ai * 128 + m * 16);
#pragma unroll
                for (int bj = 0; bj < 2; ++bj) {
                    const u32x4 g = *(const u32x4*)(proj + row * INW + 4608 + col0 + bj * 128);
                    f32x4 v0 = acc[ai][bj][m][0], v1 = acc[ai][bj][m][1];
                    if (yh) { const float sg = (fr & 1) ? -0.022097086912079608f : 0.022097086912079608f; const float* yp = yh + (u.pn >> 1) * 512 + col0 + bj * 128;
                        const f32x4 y0 = *(const GAS f32x4*)yp, y1 = *(const GAS f32x4*)(yp + 4); v0 += y0 * sg; v1 += y1 * sg; }
                    u32x4 w;
                    w.x = cvt_pk_bf16(v0[0] * silu(bflo(g.x)), v0[1] * silu(bfhi(g.x))); w.y = cvt_pk_bf16(v0[2] * silu(bflo(g.y)), v0[3] * silu(bfhi(g.y)));
                    w.z = cvt_pk_bf16(v1[0] * silu(bflo(g.z)), v1[1] * silu(bfhi(g.z))); w.w = cvt_pk_bf16(v1[2] * silu(bflo(g.w)), v1[3] * silu(bfhi(g.w)));
                    *(u32x4*)(O + row * DM + 1536 + col0 + bj * 128) = w;
                    __builtin_amdgcn_sched_barrier(0);
                }
            }
    }
};

__device__ __forceinline__ void phase_even_prep(const Params& p, const int lj, LAS unsigned char* lds) {
    const int tid = my_tid(), wave = tid >> 6, lane = tid & 63, l32 = lane & 31, h = lane >> 5;
    bf16_t* proj = (bf16_t*)(p.ws + OFF_PROJ);
    const bf16_t* ccs = (const bf16_t*)(p.ws + OFF_CCS);
    if ((int)blockIdx.x * 8 < 1024 || (int)(gridDim.x * 8 - 1) - ((int)blockIdx.x * 8 + 7) < 256) {
#pragma unroll
        for (int i = 0; i < 8; ++i) { const int idx = tid + 512 * i; *(LAS u32x4*)(lds + idx * 16) = *(const GAS u32x4*)(ccs + idx * 8); }
        __syncthreads();
    }
    for (int task = blockIdx.x * 8 + wave; task < 256 * 4; task += gridDim.x * 8) {
        const int rb = task >> 2, g = task & 3, row0 = rb * 32;
        bf16x8 af[8];
        const bf16_t* ap = proj + (size_t)(row0 + l32) * INW + 4096 + g * 128 + 8 * h;
#pragma unroll
        for (int s = 0; s < 8; ++s) af[s] = ld16(ap + 16 * s);
        bf16_t* yt; int T, tl0;
        if (row0 < NPROMPT) { T = 256; tl0 = row0 & 255; yt = (bf16_t*)(p.ws + OFF_YTP) + (size_t)(row0 >> 8) * 512 * 512; }
        else { T = 2048; tl0 = (row0 - NPROMPT) & 2047; yt = (bf16_t*)(p.ws + OFF_YTS) + (size_t)((row0 - NPROMPT) >> 11) * 512 * 4096; }
#pragma unroll 1
        for (int nt = 0; nt < 8; ++nt) {
            const int R = nt * 32 + l32;
            const LAS unsigned char* bp = lds + nt * 8192 + lane * 16;
            f32x16 acc;
#pragma unroll
            for (int r = 0; r < 16; ++r) acc[r] = 0.f;
#pragma unroll
            for (int s = 0; s < 8; ++s) acc = mfma32(af[s], *(const LAS bf16x8*)(bp + 1024 * s), acc);
            const int cs = R >> 7, cp = R & 127;
            bf16_t* dst = yt + (size_t)(g * 128 + cp) * (2 * T) + cs * T + tl0 + 4 * h;
#pragma unroll
            for (int q = 0; q < 4; ++q) {
                u32x2 w; w.x = cvt_pk_bf16(acc[4 * q], acc[4 * q + 1]); w.y = cvt_pk_bf16(acc[4 * q + 2], acc[4 * q + 3]);
                *(u32x2*)(dst + 8 * q) = w;
            }
        }
    }
    for (int task = (gridDim.x * 8 - 1) - (blockIdx.x * 8 + wave); task < 256; task += gridDim.x * 8) {
        const int g = task & 3, kb = (task >> 2) & 31, b = task >> 7;
        const int t = kb * 32 + l32, tp = (t == 0) ? 0 : 2048 - t;
        const bf16_t* xa = proj + (size_t)(NPROMPT + b * 2048 + t) * INW + 4096 + g * 128 + 8 * h;
        const bf16_t* ya = proj + (size_t)(NPROMPT + b * 2048 + tp) * INW + 4096 + g * 128 + 8 * h;
        bf16x8 ae[8], ao[8];
#pragma unroll
        for (int s = 0; s < 8; ++s) {
            const u32x4 x = *(const GAS u32x4*)(xa + 16 * s), y = *(const GAS u32x4*)(ya + 16 * s);
            u32x4 e, o;
#pragma unroll
            for (int q = 0; q < 4; ++q) {
                const unsigned xw = q == 0 ? x.x : q == 1 ? x.y : q == 2 ? x.z : x.w, yw = q == 0 ? y.x : q == 1 ? y.y : q == 2 ? y.z : y.w;
                const float x0 = bflo(xw), x1 = bfhi(xw), y0 = bflo(yw), y1 = bfhi(yw);
                const unsigned ew = (t == 0) ? xw : cvt_pk_bf16(x0 + y0, x1 + y1), ow = (t == 0) ? 0u : cvt_pk_bf16(x0 - y0, x1 - y1);
                if (q == 0) { e.x = ew; o.x = ow; } else if (q == 1) { e.y = ew; o.y = ow; } else if (q == 2) { e.z = ew; o.z = ow; } else { e.w = ew; o.w = ow; }
            }
            ae[s] = __builtin_bit_cast(bf16x8, e); ao[s] = __builtin_bit_cast(bf16x8, o);
        }
        bf16_t* yt = (bf16_t*)(p.ws + OFF_YTS) + (size_t)(lj * 2 + b) * 512 * 2048;
#pragma unroll 1
        for (int nt = 0; nt < 4; ++nt) {
            const LAS unsigned char* bp = lds + nt * 8192 + lane * 16;
            f32x16 acc;
#pragma unroll
            for (int r = 0; r < 16; ++r) acc[r] = 0.f;
#pragma unroll
            for (int s = 0; s < 8; ++s) acc = mfma32(ae[s], *(const LAS bf16x8*)(bp + 1024 * s), acc);
            bf16_t* dst = yt + (size_t)(g * 128 + nt * 32 + l32) * 2048 + kb * 32 + 4 * h;
#pragma unroll
            for (int q = 0; q < 4; ++q) { u32x2 w; w.x = cvt_pk_bf16(acc[4 * q], acc[4 * q + 1]); w.y = cvt_pk_bf16(acc[4 * q + 2], acc[4 * q + 3]); *(GAS u32x2*)(dst + 8 * q) = w; }
        }
#pragma unroll 1
        for (int nt = 0; nt < 4; ++nt) {
            const LAS unsigned char* bp = lds + (nt + 4) * 8192 + lane * 16;
            f32x16 acc;
#pragma unroll
            for (int r = 0; r < 16; ++r) acc[r] = 0.f;
#pragma unroll
            for (int s = 0; s < 8; ++s) acc = mfma32(ao[s], *(const LAS bf16x8*)(bp + 1024 * s), acc);
            bf16_t* dst = yt + (size_t)(g * 128 + nt * 32 + l32) * 2048 + 1024 + kb * 32 + 4 * h;
#pragma unroll
            for (int q = 0; q < 4; ++q) { u32x2 w; w.x = cvt_pk_bf16(acc[4 * q], acc[4 * q + 1]); w.y = cvt_pk_bf16(acc[4 * q + 2], acc[4 * q + 3]); *(GAS u32x2*)(dst + 8 * q) = w; }
        }
    }
    const int gt = blockIdx.x * 512 + tid, NT = gridDim.x * 512;
    for (int idx = gt; idx < 1024; idx += NT) {
        const int b = idx >> 9, n = idx & 511, g = n >> 7, cp = n & 127;
        const bf16_t* up = proj + (size_t)(NPROMPT + b * 2048 + 1024) * INW + 4096 + g * 128;
        float a = 0.f;
        u32x4 uv[16];
#pragma unroll
        for (int i = 0; i < 16; ++i) uv[i] = *(const GAS u32x4*)(up + 8 * i);
#pragma unroll
        for (int i = 0; i < 16; ++i)
#pragma unroll
            for (int e = 0; e < 4; ++e) {
                const unsigned w = e == 0 ? uv[i].x : e == 1 ? uv[i].y : e == 2 ? uv[i].z : uv[i].w; const int c = i * 8 + e * 2;
                a += bflo(w) * __builtin_amdgcn_cosf((float)((c * cp) & 127) * (1.f / 128.f)) + bfhi(w) * __builtin_amdgcn_cosf((float)(((c + 1) * cp) & 127) * (1.f / 128.f));
            }
        ((float*)(p.ws + OFF_YH))[lj * 1024 + idx] = a * 0.08838834764831845f;
    }
    for (int idx = gt; idx < 4096 * 16 * 2 * 4; idx += NT) {
        const int ib = idx & 3, a = (idx >> 2) & 1, head = (idx >> 3) & 15, rs = idx >> 7;
        const int t = rs & 2047; const float pos = (float)(a == 0 ? (t >> 6) : (t & 63));
        bf16_t* x1p = proj + (size_t)(NPROMPT + rs) * INW + head * 128 + a * 64 + ib * 8;
        const u32x4 x1 = *(const u32x4*)x1p, x2 = *(const u32x4*)(x1p + 32);
        u32x4 o1, o2;
#pragma unroll
        for (int e = 0; e < 4; ++e) {
            const unsigned w1 = e == 0 ? x1.x : e == 1 ? x1.y : e == 2 ? x1.z : x1.w, w2 = e == 0 ? x2.x : e == 1 ? x2.y : e == 2 ? x2.z : x2.w;
            float r1[2], r2[2];
#pragma unroll
            for (int q = 0; q < 2; ++q) {
                const int i = ib * 8 + e * 2 + q;
                const float inv = __builtin_amdgcn_exp2f(-(float)i * (13.287712379549449f / 32.f));
                const float rev = pos * inv * 0.15915494309189535f;
                const float cc = __builtin_amdgcn_cosf(rev), sn = __builtin_amdgcn_sinf(rev);
                const float a1 = q ? bfhi(w1) : bflo(w1), a2 = q ? bfhi(w2) : bflo(w2);
                r1[q] = a1 * cc - a2 * sn; r2[q] = a2 * cc + a1 * sn;
            }
            const unsigned p1 = cvt_pk_bf16(r1[0], r1[1]), p2 = cvt_pk_bf16(r2[0], r2[1]);
            if (e == 0) { o1.x = p1; o2.x = p2; } else if (e == 1) { o1.y = p1; o2.y = p2; } else if (e == 2) { o1.z = p1; o2.z = p2; } else { o1.w = p1; o2.w = p2; }
        }
        *(u32x4*)x1p = o1; *(u32x4*)(x1p + 32) = o2;
    }
    bf16_t* vt = (bf16_t*)(p.ws + OFF_VT);
    for (int idx = gt; idx < 1536 * 512; idx += NT) {
        const int cd = idx & 511, r8 = idx >> 9, row0 = r8 * 8;
        int rowbase, T;
        if (row0 < NPROMPT) { rowbase = row0 & ~255; T = 256; } else { rowbase = NPROMPT + ((row0 - NPROMPT) & ~2047); T = 2048; }
        const bf16_t* src = proj + (size_t)row0 * INW + 2048 + cd;
        unsigned short v[8];
#pragma unroll
        for (int j = 0; j < 8; ++j) v[j] = src[(size_t)j * INW];
        u32x4 w; w.x = v[0] | ((unsigned)v[1] << 16); w.y = v[2] | ((unsigned)v[3] << 16); w.z = v[4] | ((unsigned)v[5] << 16); w.w = v[6] | ((unsigned)v[7] << 16);
        *(u32x4*)(vt + (size_t)rowbase * 512 + (size_t)cd * T + (row0 - rowbase)) = w;
    }
}

constexpr int AT_KROW = 272, AT_VROW = 136, AT_KBYTES = 64 * AT_KROW, AT_BUF = AT_KBYTES + 128 * AT_VROW;
__device__ __forceinline__ void attn_item(const Params& p, const int item, const int j, LAS unsigned char* lds) {
    const int tid = my_tid(), wave = __builtin_amdgcn_readfirstlane(tid >> 6), lane = tid & 63, l32 = lane & 31, h = lane >> 5;
    int rowbase, T, qh, bs = -1, q0c = 0;
    if (item < 192) { bs = item / 96; const int rem = item % 96; qh = rem >> 3; q0c = (rem & 7) * 256; rowbase = NPROMPT + bs * 2048; T = 2048; }
    else { const int pi = item - 192; rowbase = (pi / 12) * 256; qh = pi % 12; T = 256; }
    const int kvh = qh / 3, q0 = q0c + wave * 32;
    const bf16_t* proj = (const bf16_t*)(p.ws + OFF_PROJ);
    bf16x8 qf[8];
    {
        const bf16_t* qp = proj + (size_t)(rowbase + q0 + l32) * INW + qh * 128 + 8 * h;
#pragma unroll
        for (int s = 0; s < 8; ++s) qf[s] = ldg16(qp + 16 * s);
    }
    float m = p.in[I_SINK][j * 12 + qh] * LOG2E, lsum = (h == 0) ? 1.f : 0.f;
    f32x16 oacc[4];
#pragma unroll
    for (int dt = 0; dt < 4; ++dt)
#pragma unroll
        for (int r = 0; r < 16; ++r) oacc[dt][r] = 0.f;
    int kl0 = 0, kl1 = 256, nctx = 0;
    if (bs >= 0) { kl0 = max(0, q0c - 128); kl1 = min(T, q0c + 384); nctx = 4; }
    const int nlc = (kl1 - kl0) >> 6, nch = nlc + nctx;
    const bf16_t* kg = proj + (size_t)rowbase * INW + 1536 + kvh * 128;
    const bf16_t* vg = (const bf16_t*)(p.ws + OFF_VT) + (size_t)rowbase * 512 + (size_t)(kvh * 128) * T;
    const bf16_t* ckg = (const bf16_t*)(p.ws + OFF_CTXK) + (size_t)((max(bs, 0) * 2 + j) * 256) * 512 + kvh * 128;
    const bf16_t* cvg = (const bf16_t*)(p.ws + OFF_CTXVT) + (size_t)(((max(bs, 0) * 2 + j) * 4 + kvh) * 128) * 256;
    const int krow = tid >> 4, kc16 = tid & 15, vrow = tid >> 3, vc16 = tid & 7;
    u32x4 skA[2], svA[2], skB[2], svB[2];
    auto stage_load = [&](const int ci, u32x4 (&sk)[2], u32x4 (&sv)[2]) {
        const bf16_t* kb; const bf16_t* vb; size_t kst, vst;
        if (ci < nlc) { const int ks = kl0 + 64 * ci; kb = kg + (size_t)ks * INW; kst = INW; vb = vg + ks; vst = (size_t)T; }
        else { const int ks = 64 * (ci - nlc); kb = ckg + (size_t)ks * 512; kst = 512; vb = cvg + ks; vst = 256; }
#pragma unroll
        for (int i = 0; i < 2; ++i) {
            sk[i] = *(const GAS u32x4*)(kb + (size_t)(krow + 32 * i) * kst + kc16 * 8);
            sv[i] = *(const GAS u32x4*)(vb + (size_t)(vrow + 64 * i) * vst + vc16 * 8);
        }
    };
    auto stage_store = [&](const int b, const u32x4 (&sk)[2], const u32x4 (&sv)[2]) {
        LAS unsigned char* base = lds + b * AT_BUF;
#pragma unroll
        for (int i = 0; i < 2; ++i) {
            *(LAS u32x4*)(base + (krow + 32 * i) * AT_KROW + kc16 * 16) = sk[i];
            LAS unsigned char* vd = base + AT_KBYTES + (vrow + 64 * i) * AT_VROW + vc16 * 16;
            u32x2 lo, hi; lo.x = sv[i].x; lo.y = sv[i].y; hi.x = sv[i].z; hi.y = sv[i].w;
            *(LAS u32x2*)vd = lo; *(LAS u32x2*)(vd + 8) = hi;
        }
    };
    constexpr float sc = 0.08838834764831845f * LOG2E;
    __syncthreads();
    stage_load(0, skA, svA); stage_store(0, skA, svA);
    if (nch > 1) stage_load(1, skA, svA);
    __syncthreads();
    auto chunk_step = [&](const int ci, u32x4 (&skc)[2], u32x4 (&svc)[2], u32x4 (&skn)[2], u32x4 (&svn)[2]) {
        if (ci + 2 < nch) stage_load(ci + 2, skn, svn);
        const LAS unsigned char* kbuf = lds + (ci & 1) * AT_BUF;
        const LAS unsigned char* vbuf = kbuf + AT_KBYTES;
        const bool local = ci < nlc;
        const int kc0 = kl0 + 64 * ci;
#pragma unroll 1
        for (int tt = 0; tt < 2; ++tt) {
            const int kt = kc0 + 32 * tt;
            bool masked = false;
            if (local && bs >= 0) { const int d = kt - (q0 - 128); if (d < 0 || d > 256) continue; masked = (d == 0 || d == 256); }
            bf16x8 kf[8];
            const LAS unsigned char* kp = kbuf + (tt * 32 + l32) * AT_KROW + 16 * h;
#pragma unroll
            for (int ks = 0; ks < 8; ++ks) kf[ks] = *(const LAS bf16x8*)(kp + 32 * ks);
            f32x16 s;
#pragma unroll
            for (int r = 0; r < 16; ++r) s[r] = 0.f;
#pragma unroll
            for (int ks = 0; ks < 8; ++ks) s = mfma32(kf[ks], qf[ks], s);
            bf16x8 vf[8];
            const LAS unsigned char* vp = vbuf + l32 * AT_VROW + (tt * 32 + 4 * h) * 2;
#pragma unroll
            for (int dt = 0; dt < 4; ++dt)
#pragma unroll
                for (int c = 0; c < 2; ++c) {
                    const bf16x4 a = *(const LAS bf16x4*)(vp + dt * 32 * AT_VROW + c * 32), b = *(const LAS bf16x4*)(vp + dt * 32 * AT_VROW + c * 32 + 16);
                    vf[dt * 2 + c] = __builtin_shufflevector(a, b, 0, 1, 2, 3, 4, 5, 6, 7);
                }
            float tmax = -3.0e38f;
            if (masked) {
                const int dqk = (q0 + l32) - kt - 4 * h;
#pragma unroll
                for (int r = 0; r < 16; ++r) { const int d = dqk - (8 * (r >> 2) + (r & 3)); if (d > 128 || d < -128) s[r] = -1.0e30f; tmax = fmaxf(tmax, s[r]); }
            } else {
#pragma unroll
                for (int r = 0; r < 16; ++r) tmax = fmaxf(tmax, s[r]);
            }
            { const auto rr = __builtin_amdgcn_permlane32_swap(__float_as_uint(tmax), __float_as_uint(tmax), false, false);
              tmax = fmaxf(__uint_as_float(rr[0]), __uint_as_float(rr[1])) * sc; }
            if (!__all(tmax - m <= 8.0f)) {
                const float mn = fmaxf(m, tmax), alpha = __builtin_amdgcn_exp2f(m - mn);
                m = mn; lsum *= alpha;
#pragma unroll
                for (int dt = 0; dt < 4; ++dt)
#pragma unroll
                    for (int r = 0; r < 16; ++r) oacc[dt][r] *= alpha;
            }
            float ps = 0.f;
#pragma unroll
            for (int r = 0; r < 16; ++r) { s[r] = __builtin_amdgcn_exp2f(__builtin_fmaf(s[r], sc, -m)); ps += s[r]; }
            lsum += ps;
            bf16x8 pb[2];
#pragma unroll
            for (int c = 0; c < 2; ++c) {
                u32x4 w; w.x = cvt_pk_bf16(s[8 * c + 0], s[8 * c + 1]); w.y = cvt_pk_bf16(s[8 * c + 2], s[8 * c + 3]); w.z = cvt_pk_bf16(s[8 * c + 4], s[8 * c + 5]); w.w = cvt_pk_bf16(s[8 * c + 6], s[8 * c + 7]);
                pb[c] = __builtin_bit_cast(bf16x8, w);
            }
#pragma unroll
            for (int dt = 0; dt < 4; ++dt)
#pragma unroll
                for (int c = 0; c < 2; ++c) oacc[dt] = mfma32(vf[dt * 2 + c], pb[c], oacc[dt]);
        }
        if (ci + 1 < nch) stage_store((ci + 1) & 1, skc, svc);
        __syncthreads();
    };
#pragma unroll 1
    for (int ci = 0; ci < nch; ci += 2) {
        chunk_step(ci, skA, svA, skB, svB);
        if (ci + 1 < nch) chunk_step(ci + 1, skB, svB, skA, svA);
    }
    const float lt = lsum + __shfl_xor(lsum, 32), inv = 1.f / lt;
    const size_t row = (size_t)(rowbase + q0 + l32);
    const bf16_t* gp = proj + row * INW + 2560 + qh * 128 + 4 * h;
    bf16_t* op = (bf16_t*)(p.ws + OFF_O) + row * DM + qh * 128 + 4 * h;
#pragma unroll
    for (int dt = 0; dt < 4; ++dt)
#pragma unroll
        for (int g4 = 0; g4 < 4; ++g4) {
            const u32x2 g = *(const GAS u32x2*)(gp + 32 * dt + 8 * g4);
            u32x2 w;
            w.x = cvt_pk_bf16(oacc[dt][4 * g4 + 0] * inv * silu(bflo(g.x)), oacc[dt][4 * g4 + 1] * inv * silu(bfhi(g.x)));
            w.y = cvt_pk_bf16(oacc[dt][4 * g4 + 2] * inv * silu(bflo(g.y)), oacc[dt][4 * g4 + 3] * inv * silu(bfhi(g.y)));
            *(GAS u32x2*)(op + 32 * dt + 8 * g4) = w;
        }
}

constexpr int PL_PITCH = 528;
constexpr int PL_POOLED = 80 * 528;
template <int HW>
__device__ __forceinline__ void pool_body(const Params& p, const int lj, const int g, const int row0, const int rowbase, const int T, LAS unsigned char* lds,
                                          const int tid, const int wave, const int lane, const int l32, const int h) {
    const bf16_t* proj = (const bf16_t*)(p.ws + OFF_PROJ);
    const int tl0 = row0 - rowbase;
    constexpr int NR = 64 + 2 * HW;
    bf16x8 afr[2][16];
    {
        const bf16_t* wt_ = (const bf16_t*)(p.ws + OFF_POOLW) + (size_t)((lj * 4 + g) * 8 + 2 * (wave >> 1)) * 8192 + lane * 8;
#pragma unroll
        for (int s = 0; s < 16; ++s) { afr[0][s] = ldg16(wt_ + 512 * s); afr[1][s] = ldg16(wt_ + 8192 + 512 * s); }
    }
    for (int idx = tid; idx < NR * 32; idx += 512) {
        const int r = idx >> 5, c16 = idx & 31, tt = tl0 - HW + r;
        u32x4 v; v.x = 0u; v.y = 0u; v.z = 0u; v.w = 0u;
        if (tt >= 0 && tt < T) v = *(const GAS u32x4*)(proj + (size_t)(rowbase + tt) * INW + g * 256 + c16 * 8);
        *(LAS u32x4*)(lds + r * PL_PITCH + c16 * 16) = v;
    }
    __syncthreads();
    const int ts = wave & 1, mp = wave >> 1;
    {
        const int tl = tl0 + ts * 32 + l32;
        const float rc = 1.f / (float)(min(tl + HW, T) - max(tl - HW, 0));
        const LAS unsigned char* sp = lds + (ts * 32 + l32) * PL_PITCH + 16 * h;
        LAS unsigned char* pp = lds + PL_POOLED + (ts * 32 + l32) * PL_PITCH + 16 * h;
#pragma unroll 1
        for (int s4 = 0; s4 < 4; ++s4) {
            const int s = mp * 4 + s4;
            float sum[8];
#pragma unroll
            for (int e = 0; e < 8; ++e) sum[e] = 0.f;
#pragma unroll
            for (int d = 0; d < 2 * HW; ++d) {
                const u32x4 v = *(const LAS u32x4*)(sp + d * PL_PITCH + 32 * s);
                sum[0] += bflo(v.x); sum[1] += bfhi(v.x); sum[2] += bflo(v.y); sum[3] += bfhi(v.y);
                sum[4] += bflo(v.z); sum[5] += bfhi(v.z); sum[6] += bflo(v.w); sum[7] += bfhi(v.w);
            }
            const u32x4 sv = *(const LAS u32x4*)(sp + HW * PL_PITCH + 32 * s);
            u32x4 w;
            w.x = cvt_pk_bf16(sum[0] * rc - bflo(sv.x), sum[1] * rc - bfhi(sv.x)); w.y = cvt_pk_bf16(sum[2] * rc - bflo(sv.y), sum[3] * rc - bfhi(sv.y));
            w.z = cvt_pk_bf16(sum[4] * rc - bflo(sv.z), sum[5] * rc - bfhi(sv.z)); w.w = cvt_pk_bf16(sum[6] * rc - bflo(sv.w), sum[7] * rc - bfhi(sv.w));
            *(LAS u32x4*)(pp + 32 * s) = w;
        }
    }
    __syncthreads();
    const LAS unsigned char* bp_ = lds + PL_POOLED + (ts * 32 + l32) * PL_PITCH + 16 * h;
    f32x16 acc[2];
#pragma unroll
    for (int m2 = 0; m2 < 2; ++m2)
#pragma unroll
        for (int r = 0; r < 16; ++r) acc[m2][r] = 0.f;
#pragma unroll
    for (int s = 0; s < 16; ++s) {
        const bf16x8 bfr = *(const LAS bf16x8*)(bp_ + 32 * s);
        acc[0] = mfma32(afr[0][s], bfr, acc[0]); acc[1] = mfma32(afr[1][s], bfr, acc[1]);
    }
    const int row = row0 + ts * 32 + l32;
    const float* psc = p.in[I_POOLS] + lj * 1024 + g * 256 + 4 * h;
    const bf16_t* gp = proj + (size_t)row * INW + 1024 + g * 256 + 4 * h;
    bf16_t* op = (bf16_t*)(p.ws + OFF_O) + (size_t)row * DM + g * 256 + 4 * h;
#pragma unroll
    for (int m2 = 0; m2 < 2; ++m2)
#pragma unroll
        for (int g4 = 0; g4 < 4; ++g4) {
            const int c0 = (2 * mp + m2) * 32 + 8 * g4;
            const u32x2 gg = *(const GAS u32x2*)(gp + c0);
            const f32x4 ps = *(const GAS f32x4*)(psc + c0);
            u32x2 w;
            w.x = cvt_pk_bf16(acc[m2][4 * g4 + 0] * ps[0] * silu(bflo(gg.x)), acc[m2][4 * g4 + 1] * ps[1] * silu(bfhi(gg.x)));
            w.y = cvt_pk_bf16(acc[m2][4 * g4 + 2] * ps[2] * silu(bflo(gg.y)), acc[m2][4 * g4 + 3] * ps[3] * silu(bfhi(gg.y)));
            *(GAS u32x2*)(op + c0) = w;
        }
}
__device__ __forceinline__ void pool_item(const Params& p, const int item, const int lj, LAS unsigned char* lds) {
    const int tid = my_tid(), wave = __builtin_amdgcn_readfirstlane(tid >> 6), lane = tid & 63, l32 = lane & 31, h = lane >> 5;
    const int tb = item >> 2, gs = item & 3, g = gs == 0 ? 0 : gs == 1 ? 3 : gs == 2 ? 1 : 2;
    const int row0 = tb * 64;
    int rowbase, T;
    if (row0 < NPROMPT) { rowbase = row0 & ~255; T = 256; } else { rowbase = NPROMPT + ((row0 - NPROMPT) & ~2047); T = 2048; }
    __syncthreads();
    if (g == 0) pool_body<1>(p, lj, g, row0, rowbase, T, lds, tid, wave, lane, l32, h);
    else if (g == 1) pool_body<2>(p, lj, g, row0, rowbase, T, lds, tid, wave, lane, l32, h);
    else if (g == 2) pool_body<4>(p, lj, g, row0, rowbase, T, lds, tid, wave, lane, l32, h);
    else pool_body<8>(p, lj, g, row0, rowbase, T, lds, tid, wave, lane, l32, h);
}

constexpr int SGU_PITCH = 260;
__device__ __forceinline__ void sgu_item(const Params& p, const int item, const int lj, LAS unsigned char* lds) {
    const int tid = my_tid(), wave = tid >> 6, lane = tid & 63, l32 = lane & 31, h = lane >> 5;
    const int ch = item >> 2, hd = item & 3, R0 = ch * 128;
    const bf16_t* proj = (const bf16_t*)(p.ws + OFF_PROJ);
    LAS bf16_t* vn = (LAS bf16_t*)lds;
    __syncthreads();
    bf16x8 wfr[4][8];
    {
        const bf16_t* wb_ = (const bf16_t*)(p.ws + OFF_SGUW) + (size_t)(lj * 4 + hd) * 16384 + lane * 8;
#pragma unroll
        for (int nt = 0; nt < 2; ++nt)
#pragma unroll
            for (int s = 0; s < 8; ++s) wfr[nt][s] = ldg16(wb_ + (size_t)nt * 4096 + 512 * s);
    }
    {
        const int q = tid >> 2, qt = tid & 3;
        const bf16_t* vp = proj + (size_t)(R0 + q) * INW + 3072 + hd * 256 + qt * 64;
        u32x4 v[8];
#pragma unroll
        for (int i = 0; i < 8; ++i) v[i] = *(const GAS u32x4*)(vp + 8 * i);
        float sm = 0.f;
#pragma unroll
        for (int i = 0; i < 8; ++i) sm += (bflo(v[i].x) + bfhi(v[i].x)) + (bflo(v[i].y) + bfhi(v[i].y)) + (bflo(v[i].z) + bfhi(v[i].z)) + (bflo(v[i].w) + bfhi(v[i].w));
        sm += __shfl_xor(sm, 1); sm += __shfl_xor(sm, 2);
        const float mu = sm * (1.f / 256.f);
        float sq = 0.f;
#pragma unroll
        for (int i = 0; i < 8; ++i) {
            float d;
            d = bflo(v[i].x) - mu; sq += d * d; d = bfhi(v[i].x) - mu; sq += d * d; d = bflo(v[i].y) - mu; sq += d * d; d = bfhi(v[i].y) - mu; sq += d * d;
            d = bflo(v[i].z) - mu; sq += d * d; d = bfhi(v[i].z) - mu; sq += d * d; d = bflo(v[i].w) - mu; sq += d * d; d = bfhi(v[i].w) - mu; sq += d * d;
        }
        sq += __shfl_xor(sq, 1); sq += __shfl_xor(sq, 2);
        const float rs = rsqrtf(sq * (1.f / 256.f) + 1e-6f);
        const float* gnp = p.in[I_SGUN] + lj * 1024 + hd * 256 + qt * 64;
        LAS bf16_t* dst = vn + q * SGU_PITCH + qt * 64;
#pragma unroll
        for (int i = 0; i < 8; ++i) {
            const f32x4 g0 = *(const f32x4*)(gnp + 8 * i), g1 = *(const f32x4*)(gnp + 8 * i + 4);
            u32x2 w0, w1;
            w0.x = cvt_pk_bf16((bflo(v[i].x) - mu) * rs * g0[0], (bfhi(v[i].x) - mu) * rs * g0[1]); w0.y = cvt_pk_bf16((bflo(v[i].y) - mu) * rs * g0[2], (bfhi(v[i].y) - mu) * rs * g0[3]);
            w1.x = cvt_pk_bf16((bflo(v[i].z) - mu) * rs * g1[0], (bfhi(v[i].z) - mu) * rs * g1[1]); w1.y = cvt_pk_bf16((bflo(v[i].w) - mu) * rs * g1[2], (bfhi(v[i].w) - mu) * rs * g1[3]);
            *(LAS u32x2*)(dst + 8 * i) = w0; *(LAS u32x2*)(dst + 8 * i + 4) = w1;
        }
    }
    __syncthreads();
    {
        const bf16_t* wb_ = (const bf16_t*)(p.ws + OFF_SGUW) + (size_t)(lj * 4 + hd) * 16384 + lane * 8;
#pragma unroll
        for (int nt = 2; nt < 4; ++nt)
#pragma unroll
            for (int s = 0; s < 8; ++s) wfr[nt][s] = ldg16(wb_ + (size_t)nt * 4096 + 512 * s);
    }
    bf16x8 af[8];
    {
        const int c = wave * 32 + l32;
#pragma unroll
        for (int s = 0; s < 8; ++s) {
            unsigned short e[8];
#pragma unroll
            for (int jj = 0; jj < 8; ++jj) e[jj] = vn[(16 * s + 8 * h + jj) * SGU_PITCH + c];
            u32x4 w; w.x = e[0] | ((unsigned)e[1] << 16); w.y = e[2] | ((unsigned)e[3] << 16); w.z = e[4] | ((unsigned)e[5] << 16); w.w = e[6] | ((unsigned)e[7] << 16);
            af[s] = __builtin_bit_cast(bf16x8, w);
        }
    }
    __syncthreads();
#pragma unroll
    for (int nt = 0; nt < 4; ++nt) {
        const int pp = nt * 32 + l32;
        f32x16 acc;
#pragma unroll
        for (int r = 0; r < 16; ++r) acc[r] = 0.f;
#pragma unroll
        for (int s = 0; s < 8; ++s) acc = mfma32(af[s], wfr[nt][s], acc);
        const float bias = p.in[I_SGUB][(lj * 4 + hd) * 128 + pp];
        LAS unsigned char* mp_ = lds + pp * PL_PITCH + (wave * 32 + 4 * h) * 2;
#pragma unroll
        for (int g4 = 0; g4 < 4; ++g4) {
            u32x2 w; w.x = cvt_pk_bf16(acc[4 * g4 + 0] + bias, acc[4 * g4 + 1] + bias); w.y = cvt_pk_bf16(acc[4 * g4 + 2] + bias, acc[4 * g4 + 3] + bias);
            *(LAS u32x2*)(mp_ + 16 * g4) = w;
        }
    }
    __syncthreads();
#pragma unroll 2
    for (int idx = tid; idx < 128 * 32; idx += 512) {
        const int pp = idx >> 5, c16 = idx & 31;
        const size_t row = (size_t)(R0 + pp);
        const int cb = hd * 256 + c16 * 8;
        const u32x4 mx = *(const LAS u32x4*)(lds + pp * PL_PITCH + c16 * 16);
        const u32x4 uu = *(const GAS u32x4*)(proj + row * INW + 2048 + cb), gg = *(const GAS u32x4*)(proj + row * INW + 4096 + cb);
        u32x4 w;
        w.x = cvt_pk_bf16(bflo(uu.x) * bflo(mx.x) * silu(bflo(gg.x)), bfhi(uu.x) * bfhi(mx.x) * silu(bfhi(gg.x)));
        w.y = cvt_pk_bf16(bflo(uu.y) * bflo(mx.y) * silu(bflo(gg.y)), bfhi(uu.y) * bfhi(mx.y) * silu(bfhi(gg.y)));
        w.z = cvt_pk_bf16(bflo(uu.z) * bflo(mx.z) * silu(bflo(gg.z)), bfhi(uu.z) * bfhi(mx.z) * silu(bfhi(gg.z)));
        w.w = cvt_pk_bf16(bflo(uu.w) * bflo(mx.w) * silu(bflo(gg.w)), bfhi(uu.w) * bfhi(mx.w) * silu(bfhi(gg.w)));
        *(GAS u32x4*)((bf16_t*)(p.ws + OFF_O) + row * DM + 1024 + cb) = w;
    }
}

#ifndef MK_SPLIT
#define MK_SPLIT 0
#endif

#define XB_TMO      128
#define XB_XCNT(j)  (256  + 64 * (j))
#define XB_XSUB(j)  (1280 + 64 * (j))
#define XB_XGEN(j)  (2304 + 64 * (j))
#define XB_TOP      3328
#define XB_TOPGEN   3392
#define XCD_BAR_WORDS 3456
#define XB_SPIN_CAP (1u << 18)

__device__ __forceinline__ unsigned xb_ld(unsigned* p)              { return __hip_atomic_load(p, __ATOMIC_RELAXED, __HIP_MEMORY_SCOPE_AGENT); }
__device__ __forceinline__ unsigned xb_add(unsigned* p, unsigned v) { return __hip_atomic_fetch_add(p, v, __ATOMIC_RELAXED, __HIP_MEMORY_SCOPE_AGENT); }
__device__ __forceinline__ unsigned xb_xcc_id() { return (unsigned)__builtin_amdgcn_s_getreg((3 << 11) | 20) & 0xFu; }
#define XB_SPIN(cond, bar) do { unsigned _sp = 0; while (cond) { __builtin_amdgcn_s_sleep(1); \
    if ((++_sp & 255u) == 0u) { if (xb_ld(&(bar)[XB_TMO])) break; if (_sp > XB_SPIN_CAP) { atomicAdd(&(bar)[XB_TMO], 1u); break; } } } } while (0)

struct XcdBarrier {
    unsigned* bar; unsigned x;
    volatile LAS unsigned* st;
};

__device__ __forceinline__ XcdBarrier xcd_barrier_post(unsigned* bar, volatile LAS unsigned* st) {
    XcdBarrier b; b.bar = bar; b.x = xb_xcc_id(); b.st = st;
    if (threadIdx.x == 0) (void)xb_add(&bar[XB_XCNT(b.x)], 1u);
    return b;
}
__device__ __forceinline__ void xcd_barrier_complete(unsigned* bar, unsigned x, unsigned& nloc, unsigned& nx) {
    const unsigned G = gridDim.x * gridDim.y * gridDim.z;
    unsigned sum, cnt, mine, sp = 0u;
    for (;;) {
        sum = 0u; cnt = 0u; mine = 0u;
#pragma unroll
        for (unsigned j = 0; j < 16; ++j) { const unsigned c = xb_ld(&bar[XB_XCNT(j)]); sum += c; cnt += (c > 0u) ? 1u : 0u; mine = (j == x) ? c : mine; }
        if (sum == G) break;
        __builtin_amdgcn_s_sleep(1);
        if ((++sp & 255u) == 0u) { if (xb_ld(&bar[XB_TMO])) break; if (sp > XB_SPIN_CAP) { atomicAdd(&bar[XB_TMO], 1u); break; } }
    }
    nloc = mine > 0u ? mine : 1u; nx = cnt > 0u ? cnt : 1u;
}

__device__ __forceinline__ void xcd_barrier(const XcdBarrier& b) {
    asm volatile("s_waitcnt vmcnt(0)" ::: "memory");
    __syncthreads();
    if (threadIdx.x == 0) {
        unsigned* bar = b.bar;
        __builtin_amdgcn_s_waitcnt(0);
        unsigned nloc = b.st[0], nx = b.st[1];
        if (nloc == 0u) { xcd_barrier_complete(bar, b.x, nloc, nx); b.st[0] = nloc; b.st[1] = nx; }
        const unsigned old = xb_add(&bar[XB_XSUB(b.x)], 1u);
        const unsigned gen = old / nloc;
        if (old + 1u == (gen + 1u) * nloc) {
            __builtin_amdgcn_fence(__ATOMIC_RELEASE, "agent");
            asm volatile("s_waitcnt vmcnt(0)" ::: "memory");
            const unsigned og = xb_add(&bar[XB_TOP], 1u);
            const unsigned tg = og / nx;
            if (og + 1u == (tg + 1u) * nx) xb_add(&bar[XB_TOPGEN], 1u);
            else XB_SPIN(xb_ld(&bar[XB_TOPGEN]) == tg, bar);
            __builtin_amdgcn_fence(__ATOMIC_ACQUIRE, "agent");
            xb_add(&bar[XB_XGEN(b.x)], 1u);
            asm volatile("s_waitcnt vmcnt(0)" ::: "memory");
        } else {
            XB_SPIN(xb_ld(&bar[XB_XGEN(b.x)]) == gen, bar);
            __builtin_amdgcn_fence(__ATOMIC_ACQUIRE, "agent");
            asm volatile("s_waitcnt vmcnt(0)" ::: "memory");
        }
    }
    __syncthreads();
}

#ifndef MK_ENABLE
#define MK_ENABLE 0x1ff
#endif
#define EN(x) (((MK_ENABLE) >> (x)) & 1)
#ifndef MK_DUP
#define MK_DUP 0
#endif
#define DUP(x) (1 + (((MK_DUP) >> (x)) & 1))
__global__ __launch_bounds__(512, 2) void fwd_megakernel(const Params p, const int ph_lo, const int ph_hi, const int use_sync) {
    extern __shared__ __attribute__((aligned(16))) unsigned char shm[];
    cg::grid_group grid = cg::this_grid();
    LAS unsigned char* lds = (LAS unsigned char*)shm;
    const int tid = my_tid(), wave = __builtin_amdgcn_readfirstlane(tid >> 6);
    if (use_sync == 2) grid.sync();
    volatile LAS unsigned* xst = (volatile LAS unsigned*)(lds + 131072);
    if (threadIdx.x < 4) xst[threadIdx.x] = 0u;
    __syncthreads();
    const XcdBarrier xb = xcd_barrier_post((unsigned*)(p.ws + OFF_BAR), xst);
    int ph = 0;
#define PHASE_BEGIN if (ph >= ph_lo && ph < ph_hi) { Params q = p; asm volatile("" : "+s"(q.ws), "+s"(q.out));
#define PHASE_END } ++ph; if (use_sync && ph > ph_lo && ph < ph_hi) xcd_barrier(xb);
#define PHASE_END_LAST } ++ph;
    PHASE_BEGIN for (int rep = 0; rep < DUP(3); ++rep) { if (EN(4)) phase0(q, shm); __syncthreads(); } if (MK_DUP & 1) { for (int i = 0; i < 20; ++i) xcd_barrier(xb); } PHASE_END
    PHASE_BEGIN if (EN(8)) phase_rows(q, -1); PHASE_END
#pragma unroll 1
    for (int l = 0; l < 4; ++l) {
        const int lj = l >> 1;
        PHASE_BEGIN
_Pragma("unroll 1") for (int rep = 0; rep < DUP(4); ++rep) {
            pg8::Gemm g; g.A = (const bf16_t*)(q.ws + OFF_H); g.Bt = (const bf16_t*)(q.ws + OFF_WTIN) + (size_t)l * 5120 * 2048; g.M = MROWS; g.N = INW; g.K = DM;
            pg8::StaticOrder S; S.init(g.M, g.N, (int)gridDim.x, (int)blockIdx.x);
            EpiProj E; E.O = (bf16_t*)(q.ws + OFF_PROJ); E.outk = q.out + (size_t)MROWS * DM; E.outv = E.outk + (size_t)32 * 2 * 256 * 512; E.even = (l & 1) == 0; E.j = lj;
            __syncthreads();
            if (EN(6)) pg8::gemm_phase<EpiProj, pg8::StaticOrder, false>(lds, g, S, E, nullptr);
            __syncthreads();
}
        PHASE_END
        if ((l & 1) == 0) {
            PHASE_BEGIN if (EN(3)) phase_even_prep(q, lj, lds); PHASE_END
            PHASE_BEGIN
_Pragma("unroll 1") for (int rep = 0; rep < DUP(1); ++rep) {                if (blockIdx.x < 32) {
                    pg8::Gemm g; g.A = (const bf16_t*)(q.ws + OFF_TW2K); g.Bt = (const bf16_t*)(q.ws + OFF_YTS) + (size_t)lj * 1024 * 2048; g.M = 2048; g.N = 1024; g.K = 2048;
                    asm volatile("" : "+s"(g.A), "+s"(g.Bt), "+s"(g.M), "+s"(g.N), "+s"(g.K));
                    pg8::StaticOrder S; S.init(g.M, g.N, 32, (int)blockIdx.x);
                    EpiFnet E; E.proj = (const bf16_t*)(q.ws + OFF_PROJ); E.O = (bf16_t*)(q.ws + OFF_O); E.rowbase0 = NPROMPT; E.T = 2048; E.yh = (const float*)(q.ws + OFF_YH) + lj * 1024;
                    __syncthreads();
                    _Pragma("unroll 1") for (int rep2 = 0; rep2 < DUP(7); ++rep2) { if (EN(5)) pg8::gemm_phase<EpiFnet, pg8::StaticOrder, false>(lds, g, S, E, nullptr);
                    __syncthreads(); }
                } else {
                    const int nb = (int)gridDim.x - 32;
                    int fc, fG;
                    if (gridDim.x == 256) {
                        const int xq = (int)blockIdx.x & 7, kq_ = ((int)blockIdx.x >> 3) - 4;
                        if (kq_ < 24) {
#pragma unroll 1
                            for (int u = 0; u < 3; ++u) {
                                int item;
                                if (u == 0) item = (xq >> 2) * 96 + ((xq & 3) * 3 + (kq_ >> 3)) * 8 + (kq_ & 7);
                                else { const int pk = 2 * kq_ + (u - 1), gp_ = xq + 8 * (pk / 3); item = 192 + (gp_ >> 2) * 12 + (gp_ & 3) * 3 + pk % 3; }
                                if (EN(0)) attn_item(q, item, lj, lds);
                            }
                            fc = -1;
                        } else fc = xq * 4 + (kq_ - 24);
                        fG = 32;
                    } else {
                        for (int item = (int)blockIdx.x - 32; item < 576; item += nb) { if (EN(0)) attn_item(q, item, lj, lds); }
                        fc = (int)blockIdx.x - ((int)gridDim.x - 64); fG = 64;
                    }
                    __syncthreads();
                    pg8::Gemm g; g.A = (const bf16_t*)(q.ws + OFF_TW256); g.Bt = (const bf16_t*)(q.ws + OFF_YTP); g.M = 256; g.N = 16384; g.K = 512;
                    asm volatile("" : "+s"(g.A), "+s"(g.Bt), "+s"(g.M), "+s"(g.N), "+s"(g.K));
                    pg8::StaticOrder S; S.init(g.M, g.N, fG, fc);
                    EpiFnet E; E.proj = (const bf16_t*)(q.ws + OFF_PROJ); E.O = (bf16_t*)(q.ws + OFF_O); E.rowbase0 = 0; E.T = 256; E.yh = nullptr;
                    if (EN(5) && fc >= 0) pg8::gemm_phase<EpiFnet, pg8::StaticOrder, false>(lds, g, S, E, nullptr);
                    __syncthreads();
                }
}
            PHASE_END
        } else {
            PHASE_BEGIN
_Pragma("unroll 1") for (int rep = 0; rep < DUP(2); ++rep) {                for (int item = blockIdx.x; item < 384; item += gridDim.x) { if (EN(2)) sgu_item(q, item, lj, lds); }
                {
                    const int bx = (int)blockIdx.x, np = bx < 128 ? 2 : 4, first = bx < 128 ? 2 * bx : 256 + 4 * (bx - 128);
                    if (gridDim.x == 256) { for (int k = 0; k < np; ++k) { if (EN(1)) pool_item(q, first + k, lj, lds); } }
                    else { for (int k = bx; k < 768; k += (int)gridDim.x) { if (EN(1)) pool_item(q, k, lj, lds); } }
                }
                __syncthreads();
}
            PHASE_END
        }
        PHASE_BEGIN
_Pragma("unroll 1") for (int rep = 0; rep < DUP(5); ++rep) {
            pg8::Gemm g; g.A = (const bf16_t*)(q.ws + OFF_O); g.Bt = (const bf16_t*)(q.ws + OFF_WTOUT) + (size_t)l * 2048 * 2048; g.M = MROWS; g.N = DM; g.K = DM;
            pg8::StaticOrder S; S.init(g.M, g.N, (int)gridDim.x, (int)blockIdx.x);
            EpiY E; E.C = (bf16_t*)(q.ws + OFF_Y);
            __syncthreads();
            if (EN(7)) pg8::gemm_phase<EpiY, pg8::StaticOrder, false>(lds, g, S, E, nullptr);
            __syncthreads();
            if (EN(4) && gridDim.x == 256 && blockIdx.x >= 128 && l < 3) transpose_tiles(q, shm, l + 1);
}
        PHASE_END
        if (l < 3) { PHASE_BEGIN if (EN(8)) phase_rows(q, l); PHASE_END } else { PHASE_BEGIN if (EN(8)) phase_rows(q, l); PHASE_END_LAST }
    }
}

extern "C" void kernel_launch(void* const* d_in, const int* in_sizes, int n_in, void* d_out, int out_size, void* d_ws, size_t ws_size, hipStream_t stream) {
    constexpr size_t kDynLds = 131072 + 16;
    static int grid_blocks = 0;
    if (!grid_blocks) {
        int dev = 0, cus = 0, per_cu = 0;
        (void)hipGetDevice(&dev);
        (void)hipDeviceGetAttribute(&cus, hipDeviceAttributeMultiprocessorCount, dev);
        (void)hipFuncSetAttribute((const void*)fwd_megakernel, hipFuncAttributeMaxDynamicSharedMemorySize, (int)kDynLds);
        (void)hipOccupancyMaxActiveBlocksPerMultiprocessor(&per_cu, fwd_megakernel, 512, kDynLds);
        if (per_cu < 1) { fprintf(stderr, "occupancy query returned %d\n", per_cu); per_cu = 1; }
        if (per_cu > 1) per_cu = 1;
        grid_blocks = cus * per_cu;
        if (grid_blocks > 256) grid_blocks = 256;
    }
    if (ws_size < WS_NEED) { fprintf(stderr, "workspace too small: %zu < %zu\n", ws_size, WS_NEED); return; }
    Params p{};
    for (int i = 0; i < 18; ++i) p.in[i] = (const float*)d_in[i];
    p.out = (float*)d_out; p.ws = (unsigned char*)d_ws;
#if MK_SPLIT
    for (int ph = 0; ph < 22; ++ph) {
        int lo = ph, hi = ph + 1, us = 0;
        void* args[] = {(void*)&p, (void*)&lo, (void*)&hi, (void*)&us};
        hipLaunchCooperativeKernel((const void*)fwd_megakernel, dim3(grid_blocks), dim3(512), args, kDynLds, stream);
    }
#else
    (void)hipMemsetAsync((unsigned char*)d_ws + OFF_BAR, 0, 16384, stream);
    (void)hipMemsetAsync((unsigned char*)d_ws + OFF_MOD, 0, (size_t)4 * 3 * 6144 * 4, stream);
    int lo = 0, hi = 1000, us = 1;
    void* args[] = {(void*)&p, (void*)&lo, (void*)&hi, (void*)&us};
    hipError_t e = hipLaunchCooperativeKernel((const void*)fwd_megakernel, dim3(grid_blocks), dim3(512), args, kDynLds, stream);
    if (e != hipSuccess) fprintf(stderr, "cooperative launch failed: %s (grid %d)\n", hipGetErrorString(e), grid_blocks);
#endif
}
```

```cpp
#include <hip/hip_runtime.h>
#include <hip/hip_cooperative_groups.h>
#include <cstdio>
namespace cg = cooperative_groups;
namespace pg8 {
#define PG8_LAS __attribute__((address_space(3)))
typedef unsigned short bf16_t;
typedef short bf16x8 __attribute__((ext_vector_type(8)));
typedef float f32x4 __attribute__((ext_vector_type(4)));
typedef unsigned u32x4 __attribute__((ext_vector_type(4)));
constexpr int BM = 256, BK = 64, HALF = 128, HTB = HALF * BK * 2  , STAGE_BYTES = 8 * HTB, NXCD = 8, WGM = 8;

__host__ __device__ __forceinline__ int lds_byte(int r, int c) { const int st = (r >> 4) * 2 + (c >> 5), rr = r & 15, cc = c & 31, ob = rr * 64 + cc * 2; return st * 1024 + (ob ^ (((ob >> 9) & 1) << 5)); }
__host__ __device__ __forceinline__ void stage_rc(int b, int& R, int& C) { const int st = b / 1024, sb = b % 1024, swz = sb ^ (((sb >> 9) & 1) << 5); R = (st >> 1) * 16 + swz / 64; C = (st & 1) * 32 + (swz % 64) / 2; }
__host__ __device__ __forceinline__ int perm32(int rho) { const int n = rho >> 4, i = rho & 15; return 8 * (i >> 2) + 4 * n + (i & 3); }

struct Unit { int pm, pn; };
struct Gemm { const bf16_t* A; const bf16_t* Bt; int M, N, K; };

struct StaticOrder {
    int nM, nN, nwg, G, c;
    __host__ __device__ void init(int M, int N, int G_, int c_) { nM = M / BM; nN = N / BM; nwg = nM * nN; G = G_; c = c_; }
    __host__ __device__ bool next(int i, Unit& u) const {
        const long L = (long)i * G + c; if (L >= nwg) return false;
        int wgid = (int)L; { const int q = nwg / NXCD, r = nwg % NXCD, xcd = wgid % NXCD, off = wgid / NXCD; wgid = (xcd < r ? xcd * (q + 1) : r * (q + 1) + (xcd - r) * q) + off; }
        const int nig = WGM * nN, gid = wgid / nig, fm = gid * WGM, gsz = (nM - fm) < WGM ? (nM - fm) : WGM;
        u.pm = fm + ((wgid % nig) % gsz); u.pn = (wgid % nig) / gsz; return true;
    }
    __device__ __forceinline__ void a_ready(const Unit&) const {}
    __device__ __forceinline__ void done(const Unit&) const {}
};
typedef __bf16 bf16x2_t __attribute__((ext_vector_type(2)));
typedef float f32x2_t __attribute__((ext_vector_type(2)));
__device__ __forceinline__ unsigned cvt_pk_bf16(float lo, float hi) { const f32x2_t v = {lo, hi}; const bf16x2_t r = __builtin_convertvector(v, bf16x2_t); return __builtin_bit_cast(unsigned, r); }
template <class Epi, class Sched, bool STAMP = false>
__device__ __forceinline__ void gemm_phase(PG8_LAS unsigned char* lds, const Gemm g, const Sched& S, const Epi& E, unsigned long long* stamps) {
    int tid_ = threadIdx.x; asm volatile("" : "+v"(tid_));
    const int tid = tid_, wid = __builtin_amdgcn_readfirstlane(tid >> 6), lane = tid & 63, wr = wid >> 2, wc = wid & 3, fr = lane & 15, fq = lane >> 4;
    const int K = g.K, nt = K / BK;
    int ts_lo = 0, ts_hi = 0, nts = 0; const unsigned long long rt_entry = STAMP ? (unsigned long long)wall_clock64() : 0ull;
#define PG8_STAMP() do { if (STAMP && wid == 0 && nts < 64) { const unsigned long long _c = (unsigned long long)clock64(); \
        ts_lo = (lane == nts) ? (int)(unsigned)_c : ts_lo; ts_hi = (lane == nts) ? (int)(unsigned)(_c >> 32) : ts_hi; ++nts; } } while (0)
    PG8_STAMP();
    unsigned voffA[2], voffB[2];
#pragma unroll
    for (int i = 0; i < 2; ++i) { int R, C; stage_rc(tid * 16 + i * 8192, R, C); const int Rb = Epi::PERM ? ((R & ~31) + perm32(R & 31)) : R;
        voffA[i] = (unsigned)(R * K + C) * 2u; voffB[i] = (unsigned)(Rb * K + C) * 2u; }
    const size_t kstep = (size_t)(BK * 2);
    const size_t hstep = (size_t)HALF * K * 2;
    const size_t tstep = 2 * hstep;
    const unsigned ldsw = (unsigned)wid * 1024u;
    const int aoff = lds_byte(wr * 64 + fr, fq * 8), boff = lds_byte(wc * 32 + fr, fq * 8);
#define PG8_SA(b, h) (((b) * 2 + (h)) * HTB)
#define PG8_SB(b, h) ((4 + (b) * 2 + (h)) * HTB)
#define PG8_STAGE(bufoff, gbase, voff) do { _Pragma("unroll") for (int _i = 0; _i < 2; ++_i) \
        __builtin_amdgcn_global_load_lds((const unsigned*)((const char*)(gbase) + (voff)[_i]), (PG8_LAS unsigned*)(lds + (bufoff) + ldsw + _i * 8192), 16, 0, 0); } while (0)
#define PG8_LDA(dst, b, h) do { _Pragma("unroll") for (int m = 0; m < 4; ++m) _Pragma("unroll") for (int k = 0; k < 2; ++k) dst[m][k] = *(const PG8_LAS bf16x8*)(lds + PG8_SA(b, h) + aoff + m * 2048 + k * 1024); } while (0)
#define PG8_LDB(dst, b, h) do { _Pragma("unroll") for (int n = 0; n < 2; ++n) _Pragma("unroll") for (int k = 0; k < 2; ++k) dst[n][k] = *(const PG8_LAS bf16x8*)(lds + PG8_SB(b, h) + boff + n * 2048 + k * 1024); } while (0)
#define PG8_MMA(ai, bj, At, Bt) do { __builtin_amdgcn_s_setprio(1); _Pragma("unroll") for (int m = 0; m < 4; ++m) _Pragma("unroll") for (int n = 0; n < 2; ++n) _Pragma("unroll") for (int k = 0; k < 2; ++k) \
        acc[ai][bj][m][n] = __builtin_amdgcn_mfma_f32_16x16x32_bf16(Bt[n][k], At[m][k], acc[ai][bj][m][n], 0, 0, 0); __builtin_amdgcn_s_setprio(0); } while (0)
#define PG8_WAIT_V(n) asm volatile("s_waitcnt vmcnt(" #n ")" ::: "memory")
#define PG8_WAIT_L(n) asm volatile("s_waitcnt lgkmcnt(" #n ")" ::: "memory")
#define PG8_BAR __builtin_amdgcn_s_barrier()
#define PG8_SCHED __builtin_amdgcn_sched_barrier(0)
    Unit cur, nxt; int ui = 0;
    if (!S.next(0, cur)) return;
    f32x4 acc[2][2][4][2];
#pragma unroll
    for (int a = 0; a < 2; ++a)
#pragma unroll
        for (int b = 0; b < 2; ++b)
#pragma unroll
            for (int m = 0; m < 4; ++m)
#pragma unroll
                for (int n = 0; n < 2; ++n) acc[a][b][m][n] = (f32x4){0.f, 0.f, 0.f, 0.f};
    bf16x8 At[4][2], B0[2][2], B1[2][2];
    const char* cA = (const char*)g.A + (size_t)cur.pm * tstep; const char* cB = (const char*)g.Bt + (size_t)cur.pn * tstep;
    S.a_ready(cur);
    PG8_STAGE(PG8_SB(0, 0), cB, voffB); PG8_STAGE(PG8_SA(0, 0), cA, voffA); PG8_STAGE(PG8_SB(0, 1), cB + hstep, voffB); PG8_STAGE(PG8_SA(0, 1), cA + hstep, voffA);
    if (wr == 1) PG8_BAR;
    PG8_WAIT_V(4); PG8_BAR;
    PG8_STAGE(PG8_SB(1, 0), cB + kstep, voffB); PG8_STAGE(PG8_SA(1, 0), cA + kstep, voffA); PG8_STAGE(PG8_SB(1, 1), cB + hstep + kstep, voffB);
    PG8_WAIT_V(6); PG8_BAR;
    PG8_STAMP();
    for (;;) {
        const bool has_next = S.next(ui + 1, nxt);
        const char* nA = has_next ? (const char*)g.A + (size_t)nxt.pm * tstep : cA; const char* nB = has_next ? (const char*)g.Bt + (size_t)nxt.pn * tstep : cB;
        for (int t = 0; t < nt; t += 2) {
            const bool last = (t == nt - 2);
            const char* a1 = cA + (size_t)(t + 1) * kstep;
            const char* a2 = last ? nA : cA + (size_t)(t + 2) * kstep; const char* b2 = last ? nB : cB + (size_t)(t + 2) * kstep;
            const char* a3 = a2 + kstep; const char* b3 = b2 + kstep;
            if (last && has_next) S.a_ready(nxt);
            PG8_LDB(B0, 0, 0); PG8_SCHED; PG8_LDA(At, 0, 0); PG8_STAGE(PG8_SA(1, 1), a1 + hstep, voffA);
            PG8_WAIT_L(8); PG8_BAR; PG8_WAIT_L(0); PG8_MMA(0, 0, At, B0); PG8_BAR; PG8_SCHED;
            PG8_LDB(B1, 0, 1); PG8_STAGE(PG8_SB(0, 0), b2, voffB);
            PG8_BAR; PG8_WAIT_L(0); PG8_MMA(0, 1, At, B1); PG8_BAR;
            PG8_LDA(At, 0, 1); PG8_STAGE(PG8_SA(0, 0), a2, voffA);
            PG8_BAR; PG8_WAIT_L(0); PG8_MMA(1, 0, At, B0); PG8_BAR; PG8_SCHED;
            PG8_STAGE(PG8_SB(0, 1), b2 + hstep, voffB);
            PG8_WAIT_V(6); PG8_BAR; PG8_MMA(1, 1, At, B1); PG8_BAR;
            PG8_LDB(B0, 1, 0); PG8_SCHED; PG8_LDA(At, 1, 0); PG8_STAGE(PG8_SA(0, 1), a2 + hstep, voffA);
            PG8_WAIT_L(8); PG8_BAR; PG8_WAIT_L(0); PG8_MMA(0, 0, At, B0); PG8_BAR; PG8_SCHED;
            PG8_LDB(B1, 1, 1); PG8_STAGE(PG8_SB(1, 0), b3, voffB);
            PG8_BAR; PG8_WAIT_L(0); PG8_MMA(0, 1, At, B1); PG8_BAR;
            PG8_LDA(At, 1, 1); PG8_STAGE(PG8_SA(1, 0), a3, voffA);
            PG8_BAR; PG8_WAIT_L(0); PG8_MMA(1, 0, At, B0); PG8_BAR; PG8_SCHED;
            PG8_STAGE(PG8_SB(1, 1), b3 + hstep, voffB);
            PG8_WAIT_V(6); PG8_BAR; PG8_MMA(1, 1, At, B1); PG8_BAR;
        }
        PG8_STAMP();
        if constexpr (!Epi::AFTER_DRAIN) { E(acc, cur, wr, wc, fr, fq); S.done(cur); }
        PG8_STAMP();
        if (!has_next) break;
#pragma unroll
        for (int a = 0; a < 2; ++a)
#pragma unroll
            for (int b = 0; b < 2; ++b)
#pragma unroll
                for (int m = 0; m < 4; ++m)
#pragma unroll
                    for (int n = 0; n < 2; ++n) acc[a][b][m][n] = (f32x4){0.f, 0.f, 0.f, 0.f};
        cur = nxt; cA = nA; cB = nB; ++ui;
    }
    PG8_WAIT_V(0);
    if (wr == 0) PG8_BAR;
    PG8_BAR;
    if constexpr (Epi::AFTER_DRAIN) { E.fused(acc, cur, wr, wc, fr, fq, lds, wid, lane); S.done(cur); }
    PG8_STAMP();
    if (STAMP && wid == 0) { stamps[lane] = lane < nts ? (((unsigned long long)(unsigned)ts_hi << 32) | (unsigned)ts_lo) : 0ull;
        if (lane == 62) stamps[62] = rt_entry; if (lane == 63) stamps[63] = (unsigned long long)wall_clock64(); }
#undef PG8_STAMP
#undef PG8_SA
#undef PG8_SB
#undef PG8_STAGE
#undef PG8_LDA
#undef PG8_LDB
#undef PG8_MMA
#undef PG8_WAIT_V
#undef PG8_WAIT_L
#undef PG8_BAR
#undef PG8_SCHED
}
}


using pg8::bf16_t; using pg8::bf16x8; using pg8::f32x4; using pg8::u32x4; using pg8::cvt_pk_bf16;
typedef float f32x16 __attribute__((ext_vector_type(16)));
typedef short bf16x4 __attribute__((ext_vector_type(4)));
typedef unsigned u32x2 __attribute__((ext_vector_type(2)));
#define LAS __attribute__((address_space(3)))

constexpr int DM = 2048, MROWS = 12288, NPROMPT = 8192, INW = 5120;
constexpr float LOG2E = 1.4426950408889634f;

constexpr size_t OFF_WTIN  = 0;
constexpr size_t OFF_WTOUT = OFF_WTIN  + (size_t)4 * 5120 * 2048 * 2;
constexpr size_t OFF_MOD   = OFF_WTOUT + (size_t)4 * 2048 * 2048 * 2;
constexpr size_t OFF_H     = OFF_MOD   + (size_t)4 * 3 * 6144 * 4;
constexpr size_t OFF_PROJ  = OFF_H     + (size_t)MROWS * 2048 * 2;
constexpr size_t OFF_O     = OFF_PROJ  + (size_t)MROWS * 5120 * 2;
constexpr size_t OFF_Y     = OFF_O     + (size_t)MROWS * 2048 * 2;
constexpr size_t OFF_VT    = OFF_Y     + (size_t)MROWS * 2048 * 4;
constexpr size_t OFF_CTXK  = OFF_VT    + (size_t)MROWS * 512 * 2;
constexpr size_t OFF_CTXVT = OFF_CTXK  + (size_t)2 * 2 * 256 * 512 * 2;
constexpr size_t OFF_YTP   = OFF_CTXVT + (size_t)2 * 2 * 256 * 512 * 2;
constexpr size_t OFF_YTS   = OFF_YTP   + (size_t)32 * 512 * 512 * 2;
constexpr size_t OFF_TW256 = OFF_YTS   + (size_t)2 * 512 * 4096 * 2;
constexpr size_t OFF_TW2K  = OFF_TW256 + (size_t)256 * 512 * 2;
constexpr size_t OFF_CCS   = OFF_TW2K  + (size_t)2048 * 4096 * 2;
constexpr size_t OFF_POOLW = OFF_CCS   + (size_t)256 * 128 * 2;
constexpr size_t OFF_SGUW  = OFF_POOLW + (size_t)2 * 4 * 256 * 256 * 2;
constexpr size_t OFF_BAR   = OFF_SGUW  + (size_t)2 * 4 * 128 * 128 * 2;
constexpr size_t OFF_YH    = OFF_BAR + 16384;
constexpr size_t OFF_XB    = OFF_YH + 8192;
constexpr size_t WS_NEED   = OFF_XB + (size_t)MROWS * 2048 * 2;

struct Params { const float* in[18]; float* out; unsigned char* ws; };
enum { I_XP = 0, I_XS, I_CK, I_CV, I_C, I_CCTX, I_WADA, I_BADA, I_NPRE, I_NPOST, I_WIN, I_WOUT, I_SINK, I_POOLW, I_POOLS, I_SGUN, I_SGUW, I_SGUB };

__device__ __forceinline__ int my_tid() { int t = threadIdx.x; asm volatile("" : "+v"(t)); return t; }
__device__ __forceinline__ float bflo(unsigned w) { return __uint_as_float(w << 16); }
__device__ __forceinline__ float bfhi(unsigned w) { return __uint_as_float(w & 0xffff0000u); }
__device__ __forceinline__ float bf1(bf16_t b) { return __uint_as_float(((unsigned)b) << 16); }
__device__ __forceinline__ float silu(float x) { return x * __builtin_amdgcn_rcpf(1.f + __builtin_amdgcn_exp2f(-1.4426950408889634f * x)); }
__device__ __forceinline__ bf16_t f2bf(float f) { return (bf16_t)(cvt_pk_bf16(f, 0.f) & 0xffffu); }
__device__ __forceinline__ float wave_sum(float v) {
#pragma unroll
    for (int o = 32; o >= 1; o >>= 1) v += __shfl_xor(v, o);
    return v;
}
__device__ __forceinline__ bf16x8 ld16(const bf16_t* p) { return *(const bf16x8*)p; }
__device__ __forceinline__ bf16x8 ld8x2(const bf16_t* p0, const bf16_t* p1) {
    const bf16x4 a = *(const bf16x4*)p0, b = *(const bf16x4*)p1;
    return __builtin_shufflevector(a, b, 0, 1, 2, 3, 4, 5, 6, 7);
}
#define GAS __attribute__((address_space(1)))
__device__ __forceinline__ bf16x8 ldg16(const bf16_t* p) { return *(const GAS bf16x8*)p; }
__device__ __forceinline__ bf16x8 ldg8x2(const bf16_t* p0, const bf16_t* p1) {
    const bf16x4 a = *(const GAS bf16x4*)p0, b = *(const GAS bf16x4*)p1;
    return __builtin_shufflevector(a, b, 0, 1, 2, 3, 4, 5, 6, 7);
}
__device__ __forceinline__ f32x16 mfma32(bf16x8 a, bf16x8 b, f32x16 c) { return __builtin_amdgcn_mfma_f32_32x32x16_bf16(a, b, c, 0, 0, 0); }

__device__ __forceinline__ void transpose_tiles(const Params& p, unsigned char* smem, const int l) {
    float* tile = (float*)smem + 3 * 2048 + 8 * 3 * 256;
    volatile int* slot = (volatile int*)(tile + 128 * 129);
    const int tid = my_tid();
    unsigned* qcnt = (unsigned*)(p.ws + OFF_BAR) + 3500 + l;
    const float* win = p.in[I_WIN] + (size_t)l * 2048 * 5120; const float* wout = p.in[I_WOUT] + (size_t)l * 2048 * 2048;
    bf16_t* wtin = (bf16_t*)(p.ws + OFF_WTIN) + (size_t)l * 5120 * 2048; bf16_t* wtout = (bf16_t*)(p.ws + OFF_WTOUT) + (size_t)l * 2048 * 2048;
    __syncthreads();
    if (tid == 0) *slot = (int)atomicAdd(qcnt, 1u);
    __syncthreads();
    int cur = *slot;
    const int rr = tid >> 5, c4 = (tid & 31) * 4, nn = tid >> 2, kq0 = tid & 3;
    while (cur < 896) {
        int nxt = 0;
        if (tid == 0) nxt = (int)atomicAdd(qcnt, 1u);
        const float* src; bf16_t* dst; int N, kt, nt;
        if (cur < 640) { kt = cur / 40; nt = cur % 40; N = 5120; src = win; dst = wtin; }
        else { const int r = cur - 640; kt = r >> 4; nt = r & 15; N = 2048; src = wout; dst = wtout; }
        const int k0 = kt * 128, n0 = nt * 128;
        f32x4 v[8];
#pragma unroll
        for (int i = 0; i < 8; ++i) v[i] = __builtin_nontemporal_load((const GAS f32x4*)(src + (size_t)(k0 + rr + 16 * i) * N + n0 + c4));
#pragma unroll
        for (int i = 0; i < 8; ++i) { float* tp = tile + (rr + 16 * i) * 129 + c4; tp[0] = v[i][0]; tp[1] = v[i][1]; tp[2] = v[i][2]; tp[3] = v[i][3]; }
        __syncthreads();
#pragma unroll
        for (int jj = 0; jj < 4; ++jj) {
            const int kq = kq0 + 4 * jj;
            float t[8];
#pragma unroll
            for (int e = 0; e < 8; ++e) t[e] = tile[(kq * 8 + e) * 129 + nn];
            u32x4 w; w.x = cvt_pk_bf16(t[0], t[1]); w.y = cvt_pk_bf16(t[2], t[3]); w.z = cvt_pk_bf16(t[4], t[5]); w.w = cvt_pk_bf16(t[6], t[7]);
            *(GAS u32x4*)(dst + (size_t)(n0 + nn) * 2048 + k0 + kq * 8) = w;
        }
        if (tid == 0) *slot = nxt;
        __syncthreads();
        cur = *slot;
    }
}

__device__ __forceinline__ void phase0(const Params& p, unsigned char* smem) {
    float* sc = (float*)smem;
    float* red = sc + 3 * 2048;
    const int tid = my_tid(), wave = tid >> 6, lane = tid & 63;
    for (int i = tid; i < 3 * 2048; i += 512) {
        const int ci = i >> 11, k = i & 2047;
        const float v = ci == 0 ? p.in[I_CCTX][k] : p.in[I_C][(ci - 1) * 2048 + k];
        sc[i] = silu(v);
    }
    __syncthreads();
    float* mod = (float*)(p.ws + OFF_MOD);
    for (int item = blockIdx.x; item < 192; item += gridDim.x) {
        const int l = item / 48, rem = item % 48, n0 = (rem >> 1) * 256, kh = rem & 1;
        const float* wp = p.in[I_WADA] + ((size_t)l * 2048 + kh * 1024 + wave * 128) * 6144 + n0 + lane * 4;
        const float* s0 = sc + kh * 1024 + wave * 128;
        f32x4 a0 = {0.f, 0.f, 0.f, 0.f}, a1 = a0, a2 = a0;
#pragma unroll 8
        for (int kk = 0; kk < 128; ++kk) {
            const f32x4 wv = __builtin_nontemporal_load((const GAS f32x4*)(wp + (size_t)kk * 6144));
            a0 += wv * s0[kk]; a1 += wv * s0[2048 + kk]; a2 += wv * s0[4096 + kk];
        }
        *(f32x4*)(red + (wave * 3 + 0) * 256 + lane * 4) = a0; *(f32x4*)(red + (wave * 3 + 1) * 256 + lane * 4) = a1; *(f32x4*)(red + (wave * 3 + 2) * 256 + lane * 4) = a2;
        __syncthreads();
        for (int o = tid; o < 768; o += 512) {
            const int ci = o >> 8, col = o & 255;
            float s_ = kh == 0 ? p.in[I_BADA][l * 6144 + n0 + col] : 0.f;
#pragma unroll
            for (int w = 0; w < 8; ++w) s_ += red[(w * 3 + ci) * 256 + col];
            atomicAdd(mod + (l * 3 + ci) * 6144 + n0 + col, s_);
        }
        __syncthreads();
    }
    const int lcv = gridDim.x == 256 ? 1 : 4;
#pragma unroll 1
    for (int l = 0; l < lcv; ++l) transpose_tiles(p, smem, l);
    const int gt = blockIdx.x * 512 + tid, NT = gridDim.x * 512;
    {
        bf16_t* o = (bf16_t*)(p.ws + OFF_POOLW);
        for (int idx = gt; idx < 2 * 4 * 256 * 256; idx += NT) {
            const int lg = idx >> 16, mt = (idx >> 13) & 7, s_ = (idx >> 9) & 15, ln = (idx >> 3) & 63, jj = idx & 7;
            const int d = mt * 32 + (ln & 31), c = s_ * 16 + (ln >> 5) * 8 + jj;
            o[idx] = f2bf(p.in[I_POOLW][(lg * 256 + c) * 256 + d]);
        }
    }
    {
        bf16_t* o = (bf16_t*)(p.ws + OFF_SGUW);
        for (int idx = gt; idx < 2 * 4 * 128 * 128; idx += NT) {
            const int lh = idx >> 14, nt = (idx >> 12) & 3, s_ = (idx >> 9) & 7, ln = (idx >> 3) & 63, jj = idx & 7;
            const int pp = nt * 32 + (ln & 31), qq = s_ * 16 + (ln >> 5) * 8 + jj;
            o[idx] = f2bf(p.in[I_SGUW][(lh * 128 + pp) * 128 + qq]);
        }
    }
    {
        bf16_t* o = (bf16_t*)(p.ws + OFF_CCS);
        for (int idx = gt; idx < 256 * 128; idx += NT) {
            const int nt_ = idx >> 12, s_ = (idx >> 9) & 7, ln = (idx >> 3) & 63, jj = idx & 7;
            const int R = nt_ * 32 + (ln & 31), c = s_ * 16 + (ln >> 5) * 8 + jj, cs = R >> 7, cp = R & 127; const float x = (float)((c * cp) & 127) * (1.f / 128.f);
            const float v = cs ? __builtin_amdgcn_sinf(x) : __builtin_amdgcn_cosf(x);
            o[idx] = f2bf(v * 0.08838834764831845f);
        }
    }
    {
        bf16_t* o = (bf16_t*)(p.ws + OFF_TW256);
        for (int idx = gt; idx < 256 * 512; idx += NT) {
            const int tp = idx >> 9, k = idx & 511, t = k & 255, isS = k >> 8; const float x = (float)((t * tp) & 255) * (1.f / 256.f);
            const float v = isS ? -__builtin_amdgcn_sinf(x) : __builtin_amdgcn_cosf(x);
            o[idx] = f2bf(v * 0.0625f);
        }
    }
    {
        unsigned* o = (unsigned*)(p.ws + OFF_TW2K);
        for (int idx = gt; idx < 2048 * 1024; idx += NT) {
            const int tp = idx >> 10, k = (idx & 1023) * 2, t = k & 1023, isS = k >> 10;
            const float x0 = (float)((t * tp) & 2047) * (1.f / 2048.f), x1 = (float)(((t + 1) * tp) & 2047) * (1.f / 2048.f);
            float v0 = isS ? -__builtin_amdgcn_sinf(x0) : __builtin_amdgcn_cosf(x0);
            const float v1 = isS ? -__builtin_amdgcn_sinf(x1) : __builtin_amdgcn_cosf(x1);
            if (k == 1024) v0 = (tp & 1) ? -1.f : 1.f;
            o[idx] = cvt_pk_bf16(v0 * 0.022097086912079608f, v1 * 0.022097086912079608f);
        }
    }
    {
        bf16_t* ok = (bf16_t*)(p.ws + OFF_CTXK); bf16_t* ov = (bf16_t*)(p.ws + OFF_CTXVT);
        for (int idx = gt; idx < 2 * 2 * 256 * 512; idx += NT) {
            ok[idx] = f2bf(p.in[I_CK][idx]);
            const int t = idx & 255, dim = (idx >> 8) & 127, kvh = (idx >> 15) & 3, bj = idx >> 17;
            ov[idx] = f2bf(p.in[I_CV][((bj * 256 + t) * 4 + kvh) * 128 + dim]);
        }
    }
}

__device__ __forceinline__ void phase_rows(const Params& p, const int l, LAS unsigned char* lds) {
    const int tid = my_tid(), wave = tid >> 6, lane = tid & 63;
    const float* mod = (const float*)(p.ws + OFF_MOD);
    const bf16_t* ybuf = (const bf16_t*)(p.ws + OFF_Y);
    bf16_t* hbuf = (bf16_t*)(p.ws + OFF_H);
    LAS float* vl = (LAS float*)lds;
    {
        const int l1 = l + 1;
        for (int i = tid; i < 11 * 512; i += 512) {
            const int vsel = i >> 9, c4 = (i & 511) * 4;
            const float* src = nullptr;
            if (vsel < 3) { if (l >= 0) src = mod + (l * 3 + vsel) * 6144 + 4096; }
            else if (vsel == 3) { if (l >= 0) src = p.in[I_NPOST] + l * 2048; }
            else if (vsel < 7) { if (l < 3) src = mod + (l1 * 3 + (vsel - 4)) * 6144; }
            else if (vsel < 10) { if (l < 3) src = mod + (l1 * 3 + (vsel - 7)) * 6144 + 2048; }
            else { if (l < 3) src = p.in[I_NPRE] + l1 * 2048; }
            if (src) *(LAS f32x4*)(vl + vsel * 2048 + c4) = *(const GAS f32x4*)(src + c4);
        }
        __syncthreads();
    }
    for (int row = blockIdx.x * 8 + wave; row < MROWS; row += gridDim.x * 8) {
        const int ci = row < NPROMPT ? 0 : 1 + ((row - NPROMPT) >> 11);
        bf16_t* xb = (bf16_t*)(p.ws + OFF_XB) + (size_t)row * DM;
        f32x4 x[8];
        if (l <= 0) {
            const float* xs = row < NPROMPT ? p.in[I_XP] + (size_t)row * DM : p.in[I_XS] + (size_t)(row - NPROMPT) * DM;
#pragma unroll
            for (int i = 0; i < 8; ++i) x[i] = __builtin_nontemporal_load((const GAS f32x4*)(xs + i * 256 + lane * 4));
        } else {
#pragma unroll
            for (int i = 0; i < 8; ++i) { const u32x2 xw = __builtin_nontemporal_load((const GAS u32x2*)(xb + i * 256 + lane * 4)); x[i][0] = bflo(xw.x); x[i][1] = bfhi(xw.x); x[i][2] = bflo(xw.y); x[i][3] = bfhi(xw.y); }
        }
        if (l >= 0) {
            f32x4 y[8]; float ss = 0.f;
#pragma unroll
            for (int i = 0; i < 8; ++i) { const u32x2 yw = __builtin_nontemporal_load((const GAS u32x2*)(ybuf + (size_t)row * DM + i * 256 + lane * 4)); y[i][0] = bflo(yw.x); y[i][1] = bfhi(yw.x); y[i][2] = bflo(yw.y); y[i][3] = bfhi(yw.y); ss += y[i][0] * y[i][0] + y[i][1] * y[i][1] + y[i][2] * y[i][2] + y[i][3] * y[i][3]; }
            ss = wave_sum(ss);
            const float r = rsqrtf(ss * (1.f / 2048.f) + 1e-6f);
            const LAS float* gate = vl + ci * 2048; const LAS float* np = vl + 3 * 2048;
#pragma unroll
            for (int i = 0; i < 8; ++i) {
                const f32x4 g = *(const LAS f32x4*)(gate + i * 256 + lane * 4), w = *(const LAS f32x4*)(np + i * 256 + lane * 4);
#pragma unroll
                for (int e = 0; e < 4; ++e) x[i][e] += g[e] * (y[i][e] * r * w[e]);
                if (l == 3) *(GAS f32x4*)(p.out + (size_t)row * DM + i * 256 + lane * 4) = x[i];
                else { u32x2 xo; xo.x = cvt_pk_bf16(x[i][0], x[i][1]); xo.y = cvt_pk_bf16(x[i][2], x[i][3]); *(GAS u32x2*)(xb + i * 256 + lane * 4) = xo; }
            }
        }
        if (l < 3) {
            const int l1 = l + 1;
            float ss = 0.f;
#pragma unroll
            for (int i = 0; i < 8; ++i) ss += x[i][0] * x[i][0] + x[i][1] * x[i][1] + x[i][2] * x[i][2] + x[i][3] * x[i][3];
            ss = wave_sum(ss);
            const float r = rsqrtf(ss * (1.f / 2048.f) + 1e-6f);
            const LAS float* shift = vl + (4 + ci) * 2048; const LAS float* scale = vl + (7 + ci) * 2048; const LAS float* np = vl + 10 * 2048;
#pragma unroll
            for (int i = 0; i < 8; ++i) {
                const f32x4 sh = *(const LAS f32x4*)(shift + i * 256 + lane * 4), sl = *(const LAS f32x4*)(scale + i * 256 + lane * 4), w = *(const LAS f32x4*)(np + i * 256 + lane * 4);
                float hv[4];
#pragma unroll
                for (int e = 0; e < 4; ++e) hv[e] = (x[i][e] * r * w[e]) * (1.f + sl[e]) + sh[e];
                u32x2 o; o.x = cvt_pk_bf16(hv[0], hv[1]); o.y = cvt_pk_bf16(hv[2], hv[3]);
                *(u32x2*)(hbuf + (size_t)row * DM + i * 256 + lane * 4) = o;
            }
        }
    }
}

struct EpiProj {
    static constexpr bool PERM = true, AFTER_DRAIN = false;
    bf16_t* O; float* outk; float* outv; int even, j;
    __device__ __forceinline__ void operator()(const f32x4 (&acc)[2][2][4][2], const pg8::Unit& u, int wr, int wc, int fr, int fq) const {
        asm volatile("" : "+v"(fr), "+v"(fq));
        const int rloc0 = wr * 64 + fr, col0 = u.pn * 256 + wc * 32 + 8 * fq;
        const bool kv = even && u.pm < 32 && u.pn >= 6 && u.pn < 10;
        float* cbase = nullptr;
        if (kv) cbase = (u.pn < 8 ? outk : outv) + ((size_t)(u.pm * 2 + j) * 256) * 512 + ((u.pn & 1) * 256 + wc * 32 + 8 * fq);
#pragma unroll
        for (int ai = 0; ai < 2; ++ai)
#pragma unroll
            for (int m = 0; m < 4; ++m) {
                const int rloc = rloc0 + ai * 128 + m * 16;
                bf16_t* rowp = O + (size_t)(u.pm * 256 + rloc) * INW + col0;
#pragma unroll
                for (int bj = 0; bj < 2; ++bj) {
                    const f32x4 v0 = acc[ai][bj][m][0], v1 = acc[ai][bj][m][1];
                    u32x4 w; w.x = cvt_pk_bf16(v0[0], v0[1]); w.y = cvt_pk_bf16(v0[2], v0[3]); w.z = cvt_pk_bf16(v1[0], v1[1]); w.w = cvt_pk_bf16(v1[2], v1[3]);
                    *(u32x4*)(rowp + bj * 128) = w;
                    if (kv) { float* cp = cbase + (size_t)rloc * 512 + bj * 128; *(f32x4*)cp = v0; *(f32x4*)(cp + 4) = v1; }
                    __builtin_amdgcn_sched_barrier(0);
                }
            }
    }
};
struct EpiY {
    static constexpr bool PERM = true, AFTER_DRAIN = false;
    bf16_t* C;
    __device__ __forceinline__ void operator()(const f32x4 (&acc)[2][2][4][2], const pg8::Unit& u, int wr, int wc, int fr, int fq) const {
        asm volatile("" : "+v"(fr), "+v"(fq));
        const int row0 = u.pm * 256 + wr * 64 + fr, col0 = u.pn * 256 + wc * 32 + 8 * fq;
#pragma unroll
        for (int ai = 0; ai < 2; ++ai)
#pragma unroll
            for (int m = 0; m < 4; ++m) {
                bf16_t* rowp = C + (size_t)(row0 + ai * 128 + m * 16) * DM + col0;
#pragma unroll
                for (int bj = 0; bj < 2; ++bj) {
                    const f32x4 v0 = acc[ai][bj][m][0], v1 = acc[ai][bj][m][1];
                    u32x4 w; w.x = cvt_pk_bf16(v0[0], v0[1]); w.y = cvt_pk_bf16(v0[2], v0[3]); w.z = cvt_pk_bf16(v1[0], v1[1]); w.w = cvt_pk_bf16(v1[2], v1[3]);
                    *(u32x4*)(rowp + bj * 128) = w;
                }
            }
    }
};
struct EpiFnet {
    static constexpr bool PERM = true, AFTER_DRAIN = false;
    const bf16_t* proj; bf16_t* O; int rowbase0, T; const float* yh;
    __device__ __forceinline__ void operator()(const f32x4 (&acc)[2][2][4][2], const pg8::Unit& u, int wr, int wc, int fr, int fq) const {
        asm volatile("" : "+v"(fr), "+v"(fq));
        const int row0 = rowbase0 + (u.pn >> 1) * T + u.pm * 256 + wr * 64 + fr, col0 = (u.pn & 1) * 256 + wc * 32 + 8 * fq;
#pragma unroll
        for (int ai = 0; ai < 2; ++ai)
#pragma unroll
            for (int m = 0; m < 4; ++m) {
                const size_t row = (size_t)(row0 + ai * 128 + m * 16);
#pragma unroll
                for (int bj = 0; bj < 2; ++bj) {
                    const u32x4 g = *(const u32x4*)(proj + row * INW + 4608 + col0 + bj * 128);
                    f32x4 v0 = acc[ai][bj][m][0], v1 = acc[ai][bj][m][1];
                    if (yh) { const float sg = (fr & 1) ? -0.022097086912079608f : 0.022097086912079608f; const float* yp = yh + (u.pn >> 1) * 512 + col0 + bj * 128;
                        const f32x4 y0 = *(const GAS f32x4*)yp, y1 = *(const GAS f32x4*)(yp + 4); v0 += y0 * sg; v1 += y1 * sg; }
                    u32x4 w;
                    w.x = cvt_pk_bf16(v0[0] * silu(bflo(g.x)), v0[1] * silu(bfhi(g.x))); w.y = cvt_pk_bf16(v0[2] * silu(bflo(g.y)), v0[3] * silu(bfhi(g.y)));
                    w.z = cvt_pk_bf16(v1[0] * silu(bflo(g.z)), v1[1] * silu(bfhi(g.z))); w.w = cvt_pk_bf16(v1[2] * silu(bflo(g.w)), v1[3] * silu(bfhi(g.w)));
                    *(u32x4*)(O + row * DM + 1536 + col0 + bj * 128) = w;
                    __builtin_amdgcn_sched_barrier(0);
                }
            }
    }
};

__device__ __forceinline__ void phase_even_prep(const Params& p, const int lj, LAS unsigned char* lds) {
    const int tid = my_tid(), wave = tid >> 6, lane = tid & 63, l32 = lane & 31, h = lane >> 5;
    bf16_t* proj = (bf16_t*)(p.ws + OFF_PROJ);
    const bf16_t* ccs = (const bf16_t*)(p.ws + OFF_CCS);
    if ((int)blockIdx.x * 8 < 1024 || (int)(gridDim.x * 8 - 1) - ((int)blockIdx.x * 8 + 7) < 256) {
#pragma unroll
        for (int i = 0; i < 8; ++i) { const int idx = tid + 512 * i; *(LAS u32x4*)(lds + idx * 16) = *(const GAS u32x4*)(ccs + idx * 8); }
        __syncthreads();
    }
    for (int task = blockIdx.x * 8 + wave; task < 256 * 4; task += gridDim.x * 8) {
        const int rb = task >> 2, g = task & 3, row0 = rb * 32;
        bf16x8 af[8];
        const bf16_t* ap = proj + (size_t)(row0 + l32) * INW + 4096 + g * 128 + 8 * h;
#pragma unroll
        for (int s = 0; s < 8; ++s) af[s] = ld16(ap + 16 * s);
        bf16_t* yt; int T, tl0;
        if (row0 < NPROMPT) { T = 256; tl0 = row0 & 255; yt = (bf16_t*)(p.ws + OFF_YTP) + (size_t)(row0 >> 8) * 512 * 512; }
        else { T = 2048; tl0 = (row0 - NPROMPT) & 2047; yt = (bf16_t*)(p.ws + OFF_YTS) + (size_t)((row0 - NPROMPT) >> 11) * 512 * 4096; }
#pragma unroll 1
        for (int nt = 0; nt < 8; ++nt) {
            const int R = nt * 32 + l32;
            const LAS unsigned char* bp = lds + nt * 8192 + lane * 16;
            f32x16 acc;
#pragma unroll
            for (int r = 0; r < 16; ++r) acc[r] = 0.f;
#pragma unroll
            for (int s = 0; s < 8; ++s) acc = mfma32(af[s], *(const LAS bf16x8*)(bp + 1024 * s), acc);
            const int cs = R >> 7, cp = R & 127;
            bf16_t* dst = yt + (size_t)(g * 128 + cp) * (2 * T) + cs * T + tl0 + 4 * h;
#pragma unroll
            for (int q = 0; q < 4; ++q) {
                u32x2 w; w.x = cvt_pk_bf16(acc[4 * q], acc[4 * q + 1]); w.y = cvt_pk_bf16(acc[4 * q + 2], acc[4 * q + 3]);
                *(u32x2*)(dst + 8 * q) = w;
            }
        }
    }
    for (int task = (gridDim.x * 8 - 1) - (blockIdx.x * 8 + wave); task < 256; task += gridDim.x * 8) {
        const int g = task & 3, kb = (task >> 2) & 31, b = task >> 7;
        const int t = kb * 32 + l32, tp = (t == 0) ? 0 : 2048 - t;
        const bf16_t* xa = proj + (size_t)(NPROMPT + b * 2048 + t) * INW + 4096 + g * 128 + 8 * h;
        const bf16_t* ya = proj + (size_t)(NPROMPT + b * 2048 + tp) * INW + 4096 + g * 128 + 8 * h;
        bf16x8 ae[8], ao[8];
#pragma unroll
        for (int s = 0; s < 8; ++s) {
            const u32x4 x = *(const GAS u32x4*)(xa + 16 * s), y = *(const GAS u32x4*)(ya + 16 * s);
            u32x4 e, o;
#pragma unroll
            for (int q = 0; q < 4; ++q) {
                const unsigned xw = q == 0 ? x.x : q == 1 ? x.y : q == 2 ? x.z : x.w, yw = q == 0 ? y.x : q == 1 ? y.y : q == 2 ? y.z : y.w;
                const float x0 = bflo(xw), x1 = bfhi(xw), y0 = bflo(yw), y1 = bfhi(yw);
                const unsigned ew = (t == 0) ? xw : cvt_pk_bf16(x0 + y0, x1 + y1), ow = (t == 0) ? 0u : cvt_pk_bf16(x0 - y0, x1 - y1);
                if (q == 0) { e.x = ew; o.x = ow; } else if (q == 1) { e.y = ew; o.y = ow; } else if (q == 2) { e.z = ew; o.z = ow; } else { e.w = ew; o.w = ow; }
            }
            ae[s] = __builtin_bit_cast(bf16x8, e); ao[s] = __builtin_bit_cast(bf16x8, o);
        }
        bf16_t* yt = (bf16_t*)(p.ws + OFF_YTS) + (size_t)(lj * 2 + b) * 512 * 2048;
#pragma unroll 1
        for (int nt = 0; nt < 4; ++nt) {
            const LAS unsigned char* bp = lds + nt * 8192 + lane * 16;
            f32x16 acc;
#pragma unroll
            for (int r = 0; r < 16; ++r) acc[r] = 0.f;
#pragma unroll
            for (int s = 0; s < 8; ++s) acc = mfma32(ae[s], *(const LAS bf16x8*)(bp + 1024 * s), acc);
            bf16_t* dst = yt + (size_t)(g * 128 + nt * 32 + l32) * 2048 + kb * 32 + 4 * h;
#pragma unroll
            for (int q = 0; q < 4; ++q) { u32x2 w; w.x = cvt_pk_bf16(acc[4 * q], acc[4 * q + 1]); w.y = cvt_pk_bf16(acc[4 * q + 2], acc[4 * q + 3]); *(GAS u32x2*)(dst + 8 * q) = w; }
        }
#pragma unroll 1
        for (int nt = 0; nt < 4; ++nt) {
            const LAS unsigned char* bp = lds + (nt + 4) * 8192 + lane * 16;
            f32x16 acc;
#pragma unroll
            for (int r = 0; r < 16; ++r) acc[r] = 0.f;
#pragma unroll
            for (int s = 0; s < 8; ++s) acc = mfma32(ao[s], *(const LAS bf16x8*)(bp + 1024 * s), acc);
            bf16_t* dst = yt + (size_t)(g * 128 + nt * 32 + l32) * 2048 + 1024 + kb * 32 + 4 * h;
#pragma unroll
            for (int q = 0; q < 4; ++q) { u32x2 w; w.x = cvt_pk_bf16(acc[4 * q], acc[4 * q + 1]); w.y = cvt_pk_bf16(acc[4 * q + 2], acc[4 * q + 3]); *(GAS u32x2*)(dst + 8 * q) = w; }
        }
    }
    const int gt = blockIdx.x * 512 + tid, NT = gridDim.x * 512;
    for (int idx = gt; idx < 1024; idx += NT) {
        const int b = idx >> 9, n = idx & 511, g = n >> 7, cp = n & 127;
        const bf16_t* up = proj + (size_t)(NPROMPT + b * 2048 + 1024) * INW + 4096 + g * 128;
        float a = 0.f;
        u32x4 uv[16];
#pragma unroll
        for (int i = 0; i < 16; ++i) uv[i] = *(const GAS u32x4*)(up + 8 * i);
#pragma unroll
        for (int i = 0; i < 16; ++i)
#pragma unroll
            for (int e = 0; e < 4; ++e) {
                const unsigned w = e == 0 ? uv[i].x : e == 1 ? uv[i].y : e == 2 ? uv[i].z : uv[i].w; const int c = i * 8 + e * 2;
                a += bflo(w) * __builtin_amdgcn_cosf((float)((c * cp) & 127) * (1.f / 128.f)) + bfhi(w) * __builtin_amdgcn_cosf((float)(((c + 1) * cp) & 127) * (1.f / 128.f));
            }
        ((float*)(p.ws + OFF_YH))[lj * 1024 + idx] = a * 0.08838834764831845f;
    }
    for (int idx = gt; idx < 4096 * 16 * 2 * 4; idx += NT) {
        const int ib = idx & 3, a = (idx >> 2) & 1, head = (idx >> 3) & 15, rs = idx >> 7;
        const int t = rs & 2047; const float pos = (float)(a == 0 ? (t >> 6) : (t & 63));
        bf16_t* x1p = proj + (size_t)(NPROMPT + rs) * INW + head * 128 + a * 64 + ib * 8;
        const u32x4 x1 = *(const u32x4*)x1p, x2 = *(const u32x4*)(x1p + 32);
        u32x4 o1, o2;
#pragma unroll
        for (int e = 0; e < 4; ++e) {
            const unsigned w1 = e == 0 ? x1.x : e == 1 ? x1.y : e == 2 ? x1.z : x1.w, w2 = e == 0 ? x2.x : e == 1 ? x2.y : e == 2 ? x2.z : x2.w;
            float r1[2], r2[2];
#pragma unroll
            for (int q = 0; q < 2; ++q) {
                const int i = ib * 8 + e * 2 + q;
                const float inv = __builtin_amdgcn_exp2f(-(float)i * (13.287712379549449f / 32.f));
                const float rev = pos * inv * 0.15915494309189535f;
                const float cc = __builtin_amdgcn_cosf(rev), sn = __builtin_amdgcn_sinf(rev);
                const float a1 = q ? bfhi(w1) : bflo(w1), a2 = q ? bfhi(w2) : bflo(w2);
                r1[q] = a1 * cc - a2 * sn; r2[q] = a2 * cc + a1 * sn;
            }
            const unsigned p1 = cvt_pk_bf16(r1[0], r1[1]), p2 = cvt_pk_bf16(r2[0], r2[1]);
            if (e == 0) { o1.x = p1; o2.x = p2; } else if (e == 1) { o1.y = p1; o2.y = p2; } else if (e == 2) { o1.z = p1; o2.z = p2; } else { o1.w = p1; o2.w = p2; }
        }
        *(u32x4*)x1p = o1; *(u32x4*)(x1p + 32) = o2;
    }
    bf16_t* vt = (bf16_t*)(p.ws + OFF_VT);
    for (int idx = gt; idx < 1536 * 512; idx += NT) {
        const int cd = idx & 511, r8 = idx >> 9, row0 = r8 * 8;
        int rowbase, T;
        if (row0 < NPROMPT) { rowbase = row0 & ~255; T = 256; } else { rowbase = NPROMPT + ((row0 - NPROMPT) & ~2047); T = 2048; }
        const bf16_t* src = proj + (size_t)row0 * INW + 2048 + cd;
        unsigned short v[8];
#pragma unroll
        for (int j = 0; j < 8; ++j) v[j] = src[(size_t)j * INW];
        u32x4 w; w.x = v[0] | ((unsigned)v[1] << 16); w.y = v[2] | ((unsigned)v[3] << 16); w.z = v[4] | ((unsigned)v[5] << 16); w.w = v[6] | ((unsigned)v[7] << 16);
        *(u32x4*)(vt + (size_t)rowbase * 512 + (size_t)cd * T + (row0 - rowbase)) = w;
    }
}

constexpr int AT_KROW = 272, AT_VROW = 136, AT_KBYTES = 64 * AT_KROW, AT_BUF = AT_KBYTES + 128 * AT_VROW;
__device__ __forceinline__ void attn_item(const Params& p, const int item, const int j, LAS unsigned char* lds) {
    const int tid = my_tid(), wave = __builtin_amdgcn_readfirstlane(tid >> 6), lane = tid & 63, l32 = lane & 31, h = lane >> 5;
    int rowbase, T, qh, bs = -1, q0c = 0;
    if (item < 192) { bs = item / 96; const int rem = item % 96; qh = rem >> 3; q0c = (rem & 7) * 256; rowbase = NPROMPT + bs * 2048; T = 2048; }
    else { const int pi = item - 192; rowbase = (pi / 12) * 256; qh = pi % 12; T = 256; }
    const int kvh = qh / 3, q0 = q0c + wave * 32;
    const bf16_t* proj = (const bf16_t*)(p.ws + OFF_PROJ);
    bf16x8 qf[8];
    {
        const bf16_t* qp = proj + (size_t)(rowbase + q0 + l32) * INW + qh * 128 + 8 * h;
#pragma unroll
        for (int s = 0; s < 8; ++s) qf[s] = ldg16(qp + 16 * s);
    }
    float m = p.in[I_SINK][j * 12 + qh] * LOG2E, lsum = (h == 0) ? 1.f : 0.f;
    f32x16 oacc[4];
#pragma unroll
    for (int dt = 0; dt < 4; ++dt)
#pragma unroll
        for (int r = 0; r < 16; ++r) oacc[dt][r] = 0.f;
    int kl0 = 0, kl1 = 256, nctx = 0;
    if (bs >= 0) { kl0 = max(0, q0c - 128); kl1 = min(T, q0c + 384); nctx = 4; }
    const int nlc = (kl1 - kl0) >> 6, nch = nlc + nctx;
    const bf16_t* kg = proj + (size_t)rowbase * INW + 1536 + kvh * 128;
    const bf16_t* vg = (const bf16_t*)(p.ws + OFF_VT) + (size_t)rowbase * 512 + (size_t)(kvh * 128) * T;
    const bf16_t* ckg = (const bf16_t*)(p.ws + OFF_CTXK) + (size_t)((max(bs, 0) * 2 + j) * 256) * 512 + kvh * 128;
    const bf16_t* cvg = (const bf16_t*)(p.ws + OFF_CTXVT) + (size_t)(((max(bs, 0) * 2 + j) * 4 + kvh) * 128) * 256;
    const int krow = tid >> 4, kc16 = tid & 15, vrow = tid >> 3, vc16 = tid & 7;
    u32x4 skA[2], svA[2], skB[2], svB[2];
    auto stage_load = [&](const int ci, u32x4 (&sk)[2], u32x4 (&sv)[2]) {
        const bf16_t* kb; const bf16_t* vb; size_t kst, vst;
        if (ci < nlc) { const int ks = kl0 + 64 * ci; kb = kg + (size_t)ks * INW; kst = INW; vb = vg + ks; vst = (size_t)T; }
        else { const int ks = 64 * (ci - nlc); kb = ckg + (size_t)ks * 512; kst = 512; vb = cvg + ks; vst = 256; }
#pragma unroll
        for (int i = 0; i < 2; ++i) {
            sk[i] = *(const GAS u32x4*)(kb + (size_t)(krow + 32 * i) * kst + kc16 * 8);
            sv[i] = *(const GAS u32x4*)(vb + (size_t)(vrow + 64 * i) * vst + vc16 * 8);
        }
    };
    auto stage_store = [&](const int b, const u32x4 (&sk)[2], const u32x4 (&sv)[2]) {
        LAS unsigned char* base = lds + b * AT_BUF;
#pragma unroll
        for (int i = 0; i < 2; ++i) {
            *(LAS u32x4*)(base + (krow + 32 * i) * AT_KROW + kc16 * 16) = sk[i];
            LAS unsigned char* vd = base + AT_KBYTES + (vrow + 64 * i) * AT_VROW + vc16 * 16;
            u32x2 lo, hi; lo.x = sv[i].x; lo.y = sv[i].y; hi.x = sv[i].z; hi.y = sv[i].w;
            *(LAS u32x2*)vd = lo; *(LAS u32x2*)(vd + 8) = hi;
        }
    };
    constexpr float sc = 0.08838834764831845f * LOG2E;
    __syncthreads();
    stage_load(0, skA, svA); stage_store(0, skA, svA);
    if (nch > 1) stage_load(1, skA, svA);
    __syncthreads();
    auto chunk_step = [&](const int ci, u32x4 (&skc)[2], u32x4 (&svc)[2], u32x4 (&skn)[2], u32x4 (&svn)[2]) {
        if (ci + 2 < nch) stage_load(ci + 2, skn, svn);
        const LAS unsigned char* kbuf = lds + (ci & 1) * AT_BUF;
        const LAS unsigned char* vbuf = kbuf + AT_KBYTES;
        const bool local = ci < nlc;
        const int kc0 = kl0 + 64 * ci;
#pragma unroll 1
        for (int tt = 0; tt < 2; ++tt) {
            const int kt = kc0 + 32 * tt;
            bool masked = false;
            if (local && bs >= 0) { const int d = kt - (q0 - 128); if (d < 0 || d > 256) continue; masked = (d == 0 || d == 256); }
            bf16x8 kf[8];
            const LAS unsigned char* kp = kbuf + (tt * 32 + l32) * AT_KROW + 16 * h;
#pragma unroll
            for (int ks = 0; ks < 8; ++ks) kf[ks] = *(const LAS bf16x8*)(kp + 32 * ks);
            f32x16 s;
#pragma unroll
            for (int r = 0; r < 16; ++r) s[r] = 0.f;
#pragma unroll
            for (int ks = 0; ks < 8; ++ks) s = mfma32(kf[ks], qf[ks], s);
            bf16x8 vf[8];
            const LAS unsigned char* vp = vbuf + l32 * AT_VROW + (tt * 32 + 4 * h) * 2;
#pragma unroll
            for (int dt = 0; dt < 4; ++dt)
#pragma unroll
                for (int c = 0; c < 2; ++c) {
                    const bf16x4 a = *(const LAS bf16x4*)(vp + dt * 32 * AT_VROW + c * 32), b = *(const LAS bf16x4*)(vp + dt * 32 * AT_VROW + c * 32 + 16);
                    vf[dt * 2 + c] = __builtin_shufflevector(a, b, 0, 1, 2, 3, 4, 5, 6, 7);
                }
            float tmax = -3.0e38f;
            if (masked) {
                const int dqk = (q0 + l32) - kt - 4 * h;
#pragma unroll
                for (int r = 0; r < 16; ++r) { const int d = dqk - (8 * (r >> 2) + (r & 3)); if (d > 128 || d < -128) s[r] = -1.0e30f; tmax = fmaxf(tmax, s[r]); }
            } else {
#pragma unroll
                for (int r = 0; r < 16; ++r) tmax = fmaxf(tmax, s[r]);
            }
            { const auto rr = __builtin_amdgcn_permlane32_swap(__float_as_uint(tmax), __float_as_uint(tmax), false, false);
              tmax = fmaxf(__uint_as_float(rr[0]), __uint_as_float(rr[1])) * sc; }
            if (!__all(tmax - m <= 8.0f)) {
                const float mn = fmaxf(m, tmax), alpha = __builtin_amdgcn_exp2f(m - mn);
                m = mn; lsum *= alpha;
#pragma unroll
                for (int dt = 0; dt < 4; ++dt)
#pragma unroll
                    for (int r = 0; r < 16; ++r) oacc[dt][r] *= alpha;
            }
            float ps = 0.f;
#pragma unroll
            for (int r = 0; r < 16; ++r) { s[r] = __builtin_amdgcn_exp2f(__builtin_fmaf(s[r], sc, -m)); ps += s[r]; }
            lsum += ps;
            bf16x8 pb[2];
#pragma unroll
            for (int c = 0; c < 2; ++c) {
                u32x4 w; w.x = cvt_pk_bf16(s[8 * c + 0], s[8 * c + 1]); w.y = cvt_pk_bf16(s[8 * c + 2], s[8 * c + 3]); w.z = cvt_pk_bf16(s[8 * c + 4], s[8 * c + 5]); w.w = cvt_pk_bf16(s[8 * c + 6], s[8 * c + 7]);
                pb[c] = __builtin_bit_cast(bf16x8, w);
            }
#pragma unroll
            for (int dt = 0; dt < 4; ++dt)
#pragma unroll
                for (int c = 0; c < 2; ++c) oacc[dt] = mfma32(vf[dt * 2 + c], pb[c], oacc[dt]);
        }
        if (ci + 1 < nch) stage_store((ci + 1) & 1, skc, svc);
        __syncthreads();
    };
#pragma unroll 1
    for (int ci = 0; ci < nch; ci += 2) {
        chunk_step(ci, skA, svA, skB, svB);
        if (ci + 1 < nch) chunk_step(ci + 1, skB, svB, skA, svA);
    }
    const float lt = lsum + __shfl_xor(lsum, 32), inv = 1.f / lt;
    const size_t row = (size_t)(rowbase + q0 + l32);
    const bf16_t* gp = proj + row * INW + 2560 + qh * 128 + 4 * h;
    bf16_t* op = (bf16_t*)(p.ws + OFF_O) + row * DM + qh * 128 + 4 * h;
#pragma unroll
    for (int dt = 0; dt < 4; ++dt)
#pragma unroll
        for (int g4 = 0; g4 < 4; ++g4) {
            const u32x2 g = *(const GAS u32x2*)(gp + 32 * dt + 8 * g4);
            u32x2 w;
            w.x = cvt_pk_bf16(oacc[dt][4 * g4 + 0] * inv * silu(bflo(g.x)), oacc[dt][4 * g4 + 1] * inv * silu(bfhi(g.x)));
            w.y = cvt_pk_bf16(oacc[dt][4 * g4 + 2] * inv * silu(bflo(g.y)), oacc[dt][4 * g4 + 3] * inv * silu(bfhi(g.y)));
            *(GAS u32x2*)(op + 32 * dt + 8 * g4) = w;
        }
}

constexpr int PL_PITCH = 528;
constexpr int PL_POOLED = 80 * 528;
template <int HW>
__device__ __forceinline__ void pool_body(const Params& p, const int lj, const int g, const int row0, const int rowbase, const int T, LAS unsigned char* lds,
                                          const int tid, const int wave, const int lane, const int l32, const int h) {
    const bf16_t* proj = (const bf16_t*)(p.ws + OFF_PROJ);
    const int tl0 = row0 - rowbase;
    constexpr int NR = 64 + 2 * HW;
    bf16x8 afr[2][16];
    {
        const bf16_t* wt_ = (const bf16_t*)(p.ws + OFF_POOLW) + (size_t)((lj * 4 + g) * 8 + 2 * (wave >> 1)) * 8192 + lane * 8;
#pragma unroll
        for (int s = 0; s < 16; ++s) { afr[0][s] = ldg16(wt_ + 512 * s); afr[1][s] = ldg16(wt_ + 8192 + 512 * s); }
    }
    for (int idx = tid; idx < NR * 32; idx += 512) {
        const int r = idx >> 5, c16 = idx & 31, tt = tl0 - HW + r;
        u32x4 v; v.x = 0u; v.y = 0u; v.z = 0u; v.w = 0u;
        if (tt >= 0 && tt < T) v = *(const GAS u32x4*)(proj + (size_t)(rowbase + tt) * INW + g * 256 + c16 * 8);
        *(LAS u32x4*)(lds + r * PL_PITCH + c16 * 16) = v;
    }
    __syncthreads();
    const int ts = wave & 1, mp = wave >> 1;
    {
        const int tl = tl0 + ts * 32 + l32;
        const float rc = 1.f / (float)(min(tl + HW, T) - max(tl - HW, 0));
        const LAS unsigned char* sp = lds + (ts * 32 + l32) * PL_PITCH + 16 * h;
        LAS unsigned char* pp = lds + PL_POOLED + (ts * 32 + l32) * PL_PITCH + 16 * h;
#pragma unroll 1
        for (int s4 = 0; s4 < 4; ++s4) {
            const int s = mp * 4 + s4;
            float sum[8];
#pragma unroll
            for (int e = 0; e < 8; ++e) sum[e] = 0.f;
#pragma unroll
            for (int d = 0; d < 2 * HW; ++d) {
                const u32x4 v = *(const LAS u32x4*)(sp + d * PL_PITCH + 32 * s);
                sum[0] += bflo(v.x); sum[1] += bfhi(v.x); sum[2] += bflo(v.y); sum[3] += bfhi(v.y);
                sum[4] += bflo(v.z); sum[5] += bfhi(v.z); sum[6] += bflo(v.w); sum[7] += bfhi(v.w);
            }
            const u32x4 sv = *(const LAS u32x4*)(sp + HW * PL_PITCH + 32 * s);
            u32x4 w;
            w.x = cvt_pk_bf16(sum[0] * rc - bflo(sv.x), sum[1] * rc - bfhi(sv.x)); w.y = cvt_pk_bf16(sum[2] * rc - bflo(sv.y), sum[3] * rc - bfhi(sv.y));
            w.z = cvt_pk_bf16(sum[4] * rc - bflo(sv.z), sum[5] * rc - bfhi(sv.z)); w.w = cvt_pk_bf16(sum[6] * rc - bflo(sv.w), sum[7] * rc - bfhi(sv.w));
            *(LAS u32x4*)(pp + 32 * s) = w;
        }
    }
    __syncthreads();
    const LAS unsigned char* bp_ = lds + PL_POOLED + (ts * 32 + l32) * PL_PITCH + 16 * h;
    f32x16 acc[2];
#pragma unroll
    for (int m2 = 0; m2 < 2; ++m2)
#pragma unroll
        for (int r = 0; r < 16; ++r) acc[m2][r] = 0.f;
#pragma unroll
    for (int s = 0; s < 16; ++s) {
        const bf16x8 bfr = *(const LAS bf16x8*)(bp_ + 32 * s);
        acc[0] = mfma32(afr[0][s], bfr, acc[0]); acc[1] = mfma32(afr[1][s], bfr, acc[1]);
    }
    const int row = row0 + ts * 32 + l32;
    const float* psc = p.in[I_POOLS] + lj * 1024 + g * 256 + 4 * h;
    const bf16_t* gp = proj + (size_t)row * INW + 1024 + g * 256 + 4 * h;
    bf16_t* op = (bf16_t*)(p.ws + OFF_O) + (size_t)row * DM + g * 256 + 4 * h;
#pragma unroll
    for (int m2 = 0; m2 < 2; ++m2)
#pragma unroll
        for (int g4 = 0; g4 < 4; ++g4) {
            const int c0 = (2 * mp + m2) * 32 + 8 * g4;
            const u32x2 gg = *(const GAS u32x2*)(gp + c0);
            const f32x4 ps = *(const GAS f32x4*)(psc + c0);
            u32x2 w;
            w.x = cvt_pk_bf16(acc[m2][4 * g4 + 0] * ps[0] * silu(bflo(gg.x)), acc[m2][4 * g4 + 1] * ps[1] * silu(bfhi(gg.x)));
            w.y = cvt_pk_bf16(acc[m2][4 * g4 + 2] * ps[2] * silu(bflo(gg.y)), acc[m2][4 * g4 + 3] * ps[3] * silu(bfhi(gg.y)));
            *(GAS u32x2*)(op + c0) = w;
        }
}
__device__ __forceinline__ void pool_item(const Params& p, const int item, const int lj, LAS unsigned char* lds) {
    const int tid = my_tid(), wave = __builtin_amdgcn_readfirstlane(tid >> 6), lane = tid & 63, l32 = lane & 31, h = lane >> 5;
    const int tb = item >> 2, gs = item & 3, g = gs == 0 ? 0 : gs == 1 ? 3 : gs == 2 ? 1 : 2;
    const int row0 = tb * 64;
    int rowbase, T;
    if (row0 < NPROMPT) { rowbase = row0 & ~255; T = 256; } else { rowbase = NPROMPT + ((row0 - NPROMPT) & ~2047); T = 2048; }
    __syncthreads();
    if (g == 0) pool_body<1>(p, lj, g, row0, rowbase, T, lds, tid, wave, lane, l32, h);
    else if (g == 1) pool_body<2>(p, lj, g, row0, rowbase, T, lds, tid, wave, lane, l32, h);
    else if (g == 2) pool_body<4>(p, lj, g, row0, rowbase, T, lds, tid, wave, lane, l32, h);
    else pool_body<8>(p, lj, g, row0, rowbase, T, lds, tid, wave, lane, l32, h);
}

constexpr int SGU_PITCH = 260;
__device__ __forceinline__ void sgu_item(const Params& p, const int item, const int lj, LAS unsigned char* lds) {
    const int tid = my_tid(), wave = tid >> 6, lane = tid & 63, l32 = lane & 31, h = lane >> 5;
    const int ch = item >> 2, hd = item & 3, R0 = ch * 128;
    const bf16_t* proj = (const bf16_t*)(p.ws + OFF_PROJ);
    LAS bf16_t* vn = (LAS bf16_t*)lds;
    __syncthreads();
    bf16x8 wfr[4][8];
    {
        const bf16_t* wb_ = (const bf16_t*)(p.ws + OFF_SGUW) + (size_t)(lj * 4 + hd) * 16384 + lane * 8;
#pragma unroll
        for (int nt = 0; nt < 2; ++nt)
#pragma unroll
            for (int s = 0; s < 8; ++s) wfr[nt][s] = ldg16(wb_ + (size_t)nt * 4096 + 512 * s);
    }
    {
        const int q = tid >> 2, qt = tid & 3;
        const bf16_t* vp = proj + (size_t)(R0 + q) * INW + 3072 + hd * 256 + qt * 64;
        u32x4 v[8];
#pragma unroll
        for (int i = 0; i < 8; ++i) v[i] = *(const GAS u32x4*)(vp + 8 * i);
        float sm = 0.f;
#pragma unroll
        for (int i = 0; i < 8; ++i) sm += (bflo(v[i].x) + bfhi(v[i].x)) + (bflo(v[i].y) + bfhi(v[i].y)) + (bflo(v[i].z) + bfhi(v[i].z)) + (bflo(v[i].w) + bfhi(v[i].w));
        sm += __shfl_xor(sm, 1); sm += __shfl_xor(sm, 2);
        const float mu = sm * (1.f / 256.f);
        float sq = 0.f;
#pragma unroll
        for (int i = 0; i < 8; ++i) {
            float d;
            d = bflo(v[i].x) - mu; sq += d * d; d = bfhi(v[i].x) - mu; sq += d * d; d = bflo(v[i].y) - mu; sq += d * d; d = bfhi(v[i].y) - mu; sq += d * d;
            d = bflo(v[i].z) - mu; sq += d * d; d = bfhi(v[i].z) - mu; sq += d * d; d = bflo(v[i].w) - mu; sq += d * d; d = bfhi(v[i].w) - mu; sq += d * d;
        }
        sq += __shfl_xor(sq, 1); sq += __shfl_xor(sq, 2);
        const float rs = rsqrtf(sq * (1.f / 256.f) + 1e-6f);
        const float* gnp = p.in[I_SGUN] + lj * 1024 + hd * 256 + qt * 64;
        LAS bf16_t* dst = vn + q * SGU_PITCH + qt * 64;
#pragma unroll
        for (int i = 0; i < 8; ++i) {
            const f32x4 g0 = *(const f32x4*)(gnp + 8 * i), g1 = *(const f32x4*)(gnp + 8 * i + 4);
            u32x2 w0, w1;
            w0.x = cvt_pk_bf16((bflo(v[i].x) - mu) * rs * g0[0], (bfhi(v[i].x) - mu) * rs * g0[1]); w0.y = cvt_pk_bf16((bflo(v[i].y) - mu) * rs * g0[2], (bfhi(v[i].y) - mu) * rs * g0[3]);
            w1.x = cvt_pk_bf16((bflo(v[i].z) - mu) * rs * g1[0], (bfhi(v[i].z) - mu) * rs * g1[1]); w1.y = cvt_pk_bf16((bflo(v[i].w) - mu) * rs * g1[2], (bfhi(v[i].w) - mu) * rs * g1[3]);
            *(LAS u32x2*)(dst + 8 * i) = w0; *(LAS u32x2*)(dst + 8 * i + 4) = w1;
        }
    }
    __syncthreads();
    {
        const bf16_t* wb_ = (const bf16_t*)(p.ws + OFF_SGUW) + (size_t)(lj * 4 + hd) * 16384 + lane * 8;
#pragma unroll
        for (int nt = 2; nt < 4; ++nt)
#pragma unroll
            for (int s = 0; s < 8; ++s) wfr[nt][s] = ldg16(wb_ + (size_t)nt * 4096 + 512 * s);
    }
    bf16x8 af[8];
    {
        const int c = wave * 32 + l32;
#pragma unroll
        for (int s = 0; s < 8; ++s) {
            unsigned short e[8];
#pragma unroll
            for (int jj = 0; jj < 8; ++jj) e[jj] = vn[(16 * s + 8 * h + jj) * SGU_PITCH + c];
            u32x4 w; w.x = e[0] | ((unsigned)e[1] << 16); w.y = e[2] | ((unsigned)e[3] << 16); w.z = e[4] | ((unsigned)e[5] << 16); w.w = e[6] | ((unsigned)e[7] << 16);
            af[s] = __builtin_bit_cast(bf16x8, w);
        }
    }
    __syncthreads();
#pragma unroll
    for (int nt = 0; nt < 4; ++nt) {
        const int pp = nt * 32 + l32;
        f32x16 acc;
#pragma unroll
        for (int r = 0; r < 16; ++r) acc[r] = 0.f;
#pragma unroll
        for (int s = 0; s < 8; ++s) acc = mfma32(af[s], wfr[nt][s], acc);
        const float bias = p.in[I_SGUB][(lj * 4 + hd) * 128 + pp];
        LAS unsigned char* mp_ = lds + pp * PL_PITCH + (wave * 32 + 4 * h) * 2;
#pragma unroll
        for (int g4 = 0; g4 < 4; ++g4) {
            u32x2 w; w.x = cvt_pk_bf16(acc[4 * g4 + 0] + bias, acc[4 * g4 + 1] + bias); w.y = cvt_pk_bf16(acc[4 * g4 + 2] + bias, acc[4 * g4 + 3] + bias);
            *(LAS u32x2*)(mp_ + 16 * g4) = w;
        }
    }
    __syncthreads();
#pragma unroll 2
    for (int idx = tid; idx < 128 * 32; idx += 512) {
        const int pp = idx >> 5, c16 = idx & 31;
        const size_t row = (size_t)(R0 + pp);
        const int cb = hd * 256 + c16 * 8;
        const u32x4 mx = *(const LAS u32x4*)(lds + pp * PL_PITCH + c16 * 16);
        const u32x4 uu = *(const GAS u32x4*)(proj + row * INW + 2048 + cb), gg = *(const GAS u32x4*)(proj + row * INW + 4096 + cb);
        u32x4 w;
        w.x = cvt_pk_bf16(bflo(uu.x) * bflo(mx.x) * silu(bflo(gg.x)), bfhi(uu.x) * bfhi(mx.x) * silu(bfhi(gg.x)));
        w.y = cvt_pk_bf16(bflo(uu.y) * bflo(mx.y) * silu(bflo(gg.y)), bfhi(uu.y) * bfhi(mx.y) * silu(bfhi(gg.y)));
        w.z = cvt_pk_bf16(bflo(uu.z) * bflo(mx.z) * silu(bflo(gg.z)), bfhi(uu.z) * bfhi(mx.z) * silu(bfhi(gg.z)));
        w.w = cvt_pk_bf16(bflo(uu.w) * bflo(mx.w) * silu(bflo(gg.w)), bfhi(uu.w) * bfhi(mx.w) * silu(bfhi(gg.w)));
        *(GAS u32x4*)((bf16_t*)(p.ws + OFF_O) + row * DM + 1024 + cb) = w;
    }
}

#ifndef MK_SPLIT
#define MK_SPLIT 0
#endif

#define XB_TMO      128
#define XB_XCNT(j)  (256  + 64 * (j))
#define XB_XSUB(j)  (1280 + 64 * (j))
#define XB_XGEN(j)  (2304 + 64 * (j))
#define XB_TOP      3328
#define XB_TOPGEN   3392
#define XCD_BAR_WORDS 3456
#define XB_SPIN_CAP (1u << 18)

__device__ __forceinline__ unsigned xb_ld(unsigned* p)              { return __hip_atomic_load(p, __ATOMIC_RELAXED, __HIP_MEMORY_SCOPE_AGENT); }
__device__ __forceinline__ unsigned xb_add(unsigned* p, unsigned v) { return __hip_atomic_fetch_add(p, v, __ATOMIC_RELAXED, __HIP_MEMORY_SCOPE_AGENT); }
__device__ __forceinline__ unsigned xb_xcc_id() { return (unsigned)__builtin_amdgcn_s_getreg((3 << 11) | 20) & 0xFu; }
#define XB_SPIN(cond, bar) do { unsigned _sp = 0; while (cond) { __builtin_amdgcn_s_sleep(1); \
    if ((++_sp & 255u) == 0u) { if (xb_ld(&(bar)[XB_TMO])) break; if (_sp > XB_SPIN_CAP) { atomicAdd(&(bar)[XB_TMO], 1u); break; } } } } while (0)

struct XcdBarrier {
    unsigned* bar; unsigned x;
    volatile LAS unsigned* st;
};

__device__ __forceinline__ XcdBarrier xcd_barrier_post(unsigned* bar, volatile LAS unsigned* st) {
    XcdBarrier b; b.bar = bar; b.x = xb_xcc_id(); b.st = st;
    if (threadIdx.x == 0) (void)xb_add(&bar[XB_XCNT(b.x)], 1u);
    return b;
}
__device__ __forceinline__ void xcd_barrier_complete(unsigned* bar, unsigned x, unsigned& nloc, unsigned& nx) {
    const unsigned G = gridDim.x * gridDim.y * gridDim.z;
    unsigned sum, cnt, mine, sp = 0u;
    for (;;) {
        sum = 0u; cnt = 0u; mine = 0u;
#pragma unroll
        for (unsigned j = 0; j < 16; ++j) { const unsigned c = xb_ld(&bar[XB_XCNT(j)]); sum += c; cnt += (c > 0u) ? 1u : 0u; mine = (j == x) ? c : mine; }
        if (sum == G) break;
        __builtin_amdgcn_s_sleep(1);
        if ((++sp & 255u) == 0u) { if (xb_ld(&bar[XB_TMO])) break; if (sp > XB_SPIN_CAP) { atomicAdd(&bar[XB_TMO], 1u); break; } }
    }
    nloc = mine > 0u ? mine : 1u; nx = cnt > 0u ? cnt : 1u;
}

__device__ __forceinline__ void xcd_barrier(const XcdBarrier& b) {
    asm volatile("s_waitcnt vmcnt(0)" ::: "memory");
    __syncthreads();
    if (threadIdx.x == 0) {
        unsigned* bar = b.bar;
        __builtin_amdgcn_s_waitcnt(0);
        unsigned nloc = b.st[0], nx = b.st[1];
        if (nloc == 0u) { xcd_barrier_complete(bar, b.x, nloc, nx); b.st[0] = nloc; b.st[1] = nx; }
        const unsigned old = xb_add(&bar[XB_XSUB(b.x)], 1u);
        const unsigned gen = old / nloc;
        if (old + 1u == (gen + 1u) * nloc) {
            __builtin_amdgcn_fence(__ATOMIC_RELEASE, "agent");
            asm volatile("s_waitcnt vmcnt(0)" ::: "memory");
            const unsigned og = xb_add(&bar[XB_TOP], 1u);
            const unsigned tg = og / nx;
            if (og + 1u == (tg + 1u) * nx) xb_add(&bar[XB_TOPGEN], 1u);
            else XB_SPIN(xb_ld(&bar[XB_TOPGEN]) == tg, bar);
            __builtin_amdgcn_fence(__ATOMIC_ACQUIRE, "agent");
            xb_add(&bar[XB_XGEN(b.x)], 1u);
            asm volatile("s_waitcnt vmcnt(0)" ::: "memory");
        } else {
            XB_SPIN(xb_ld(&bar[XB_XGEN(b.x)]) == gen, bar);
            __builtin_amdgcn_fence(__ATOMIC_ACQUIRE, "agent");
            asm volatile("s_waitcnt vmcnt(0)" ::: "memory");
        }
    }
    __syncthreads();
}

#ifndef MK_ENABLE
#define MK_ENABLE 0x1ff
#endif
#define EN(x) (((MK_ENABLE) >> (x)) & 1)
#ifndef MK_DUP
#define MK_DUP 0
#endif
#define DUP(x) (1 + (((MK_DUP) >> (x)) & 1))
__global__ __launch_bounds__(512, 2) void fwd_megakernel(const Params p, const int ph_lo, const int ph_hi, const int use_sync) {
    extern __shared__ __attribute__((aligned(16))) unsigned char shm[];
    cg::grid_group grid = cg::this_grid();
    LAS unsigned char* lds = (LAS unsigned char*)shm;
    const int tid = my_tid(), wave = __builtin_amdgcn_readfirstlane(tid >> 6);
    if (use_sync == 2) grid.sync();
    volatile LAS unsigned* xst = (volatile LAS unsigned*)(lds + 131072);
    if (threadIdx.x < 4) xst[threadIdx.x] = 0u;
    __syncthreads();
    const XcdBarrier xb = xcd_barrier_post((unsigned*)(p.ws + OFF_BAR), xst);
    int ph = 0;
#define PHASE_BEGIN if (ph >= ph_lo && ph < ph_hi) { Params q = p; asm volatile("" : "+s"(q.ws), "+s"(q.out));
#define PHASE_END } ++ph; if (use_sync && ph > ph_lo && ph < ph_hi) xcd_barrier(xb);
#define PHASE_END_LAST } ++ph;
    PHASE_BEGIN for (int rep = 0; rep < DUP(3); ++rep) { if (EN(4)) phase0(q, shm); __syncthreads(); } if (MK_DUP & 1) { for (int i = 0; i < 20; ++i) xcd_barrier(xb); } PHASE_END
    PHASE_BEGIN if (EN(8)) phase_rows(q, -1, lds); PHASE_END
#pragma unroll 1
    for (int l = 0; l < 4; ++l) {
        const int lj = l >> 1;
        PHASE_BEGIN
_Pragma("unroll 1") for (int rep = 0; rep < DUP(4); ++rep) {
            pg8::Gemm g; g.A = (const bf16_t*)(q.ws + OFF_H); g.Bt = (const bf16_t*)(q.ws + OFF_WTIN) + (size_t)l * 5120 * 2048; g.M = MROWS; g.N = INW; g.K = DM;
            pg8::StaticOrder S; S.init(g.M, g.N, (int)gridDim.x, (int)blockIdx.x);
            EpiProj E; E.O = (bf16_t*)(q.ws + OFF_PROJ); E.outk = q.out + (size_t)MROWS * DM; E.outv = E.outk + (size_t)32 * 2 * 256 * 512; E.even = (l & 1) == 0; E.j = lj;
            __syncthreads();
            if (EN(6)) pg8::gemm_phase<EpiProj, pg8::StaticOrder, false>(lds, g, S, E, nullptr);
            __syncthreads();
}
        PHASE_END
        if ((l & 1) == 0) {
            PHASE_BEGIN if (EN(3)) phase_even_prep(q, lj, lds); PHASE_END
            PHASE_BEGIN
_Pragma("unroll 1") for (int rep = 0; rep < DUP(1); ++rep) {                if (blockIdx.x < 32) {
                    pg8::Gemm g; g.A = (const bf16_t*)(q.ws + OFF_TW2K); g.Bt = (const bf16_t*)(q.ws + OFF_YTS) + (size_t)lj * 1024 * 2048; g.M = 2048; g.N = 1024; g.K = 2048;
                    asm volatile("" : "+s"(g.A), "+s"(g.Bt), "+s"(g.M), "+s"(g.N), "+s"(g.K));
                    pg8::StaticOrder S; S.init(g.M, g.N, 32, (int)blockIdx.x);
                    EpiFnet E; E.proj = (const bf16_t*)(q.ws + OFF_PROJ); E.O = (bf16_t*)(q.ws + OFF_O); E.rowbase0 = NPROMPT; E.T = 2048; E.yh = (const float*)(q.ws + OFF_YH) + lj * 1024;
                    __syncthreads();
                    _Pragma("unroll 1") for (int rep2 = 0; rep2 < DUP(7); ++rep2) { if (EN(5)) pg8::gemm_phase<EpiFnet, pg8::StaticOrder, false>(lds, g, S, E, nullptr);
                    __syncthreads(); }
                } else {
                    const int nb = (int)gridDim.x - 32;
                    int fc, fG;
                    if (gridDim.x == 256) {
                        const int xq = (int)blockIdx.x & 7, kq_ = ((int)blockIdx.x >> 3) - 4;
                        if (kq_ < 24) {
#pragma unroll 1
                            for (int u = 0; u < 3; ++u) {
                                int item;
                                if (u == 0) item = (xq >> 2) * 96 + ((xq & 3) * 3 + (kq_ >> 3)) * 8 + (kq_ & 7);
                                else { const int pk = 2 * kq_ + (u - 1), gp_ = xq + 8 * (pk / 3); item = 192 + (gp_ >> 2) * 12 + (gp_ & 3) * 3 + pk % 3; }
                                if (EN(0)) attn_item(q, item, lj, lds);
                            }
                            fc = -1;
                        } else fc = xq * 4 + (kq_ - 24);
                        fG = 32;
                    } else {
                        for (int item = (int)blockIdx.x - 32; item < 576; item += nb) { if (EN(0)) attn_item(q, item, lj, lds); }
                        fc = (int)blockIdx.x - ((int)gridDim.x - 64); fG = 64;
                    }
                    __syncthreads();
                    pg8::Gemm g; g.A = (const bf16_t*)(q.ws + OFF_TW256); g.Bt = (const bf16_t*)(q.ws + OFF_YTP); g.M = 256; g.N = 16384; g.K = 512;
                    asm volatile("" : "+s"(g.A), "+s"(g.Bt), "+s"(g.M), "+s"(g.N), "+s"(g.K));
                    pg8::StaticOrder S; S.init(g.M, g.N, fG, fc);
                    EpiFnet E; E.proj = (const bf16_t*)(q.ws + OFF_PROJ); E.O = (bf16_t*)(q.ws + OFF_O); E.rowbase0 = 0; E.T = 256; E.yh = nullptr;
                    if (EN(5) && fc >= 0) pg8::gemm_phase<EpiFnet, pg8::StaticOrder, false>(lds, g, S, E, nullptr);
                    __syncthreads();
                }
}
            PHASE_END
        } else {
            PHASE_BEGIN
_Pragma("unroll 1") for (int rep = 0; rep < DUP(2); ++rep) {                for (int item = blockIdx.x; item < 384; item += gridDim.x) { if (EN(2)) sgu_item(q, item, lj, lds); }
                {
                    const int bx = (int)blockIdx.x, np = bx < 128 ? 2 : 4, first = bx < 128 ? 2 * bx : 256 + 4 * (bx - 128);
                    if (gridDim.x == 256) { for (int k = 0; k < np; ++k) { if (EN(1)) pool_item(q, first + k, lj, lds); } }
                    else { for (int k = bx; k < 768; k += (int)gridDim.x) { if (EN(1)) pool_item(q, k, lj, lds); } }
                }
                __syncthreads();
}
            PHASE_END
        }
        PHASE_BEGIN
_Pragma("unroll 1") for (int rep = 0; rep < DUP(5); ++rep) {
            pg8::Gemm g; g.A = (const bf16_t*)(q.ws + OFF_O); g.Bt = (const bf16_t*)(q.ws + OFF_WTOUT) + (size_t)l * 2048 * 2048; g.M = MROWS; g.N = DM; g.K = DM;
            pg8::StaticOrder S; S.init(g.M, g.N, (int)gridDim.x, (int)blockIdx.x);
            EpiY E; E.C = (bf16_t*)(q.ws + OFF_Y);
            __syncthreads();
            if (EN(7)) pg8::gemm_phase<EpiY, pg8::StaticOrder, false>(lds, g, S, E, nullptr);
            __syncthreads();
            if (EN(4) && gridDim.x == 256 && blockIdx.x >= 128 && l < 3) transpose_tiles(q, shm, l + 1);
}
        PHASE_END
        if (l < 3) { PHASE_BEGIN if (EN(8)) phase_rows(q, l, lds); PHASE_END } else { PHASE_BEGIN if (EN(8)) phase_rows(q, l, lds); PHASE_END_LAST }
    }
}

extern "C" void kernel_launch(void* const* d_in, const int* in_sizes, int n_in, void* d_out, int out_size, void* d_ws, size_t ws_size, hipStream_t stream) {
    constexpr size_t kDynLds = 131072 + 16;
    static int grid_blocks = 0;
    if (!grid_blocks) {
        int dev = 0, cus = 0, per_cu = 0;
        (void)hipGetDevice(&dev);
        (void)hipDeviceGetAttribute(&cus, hipDeviceAttributeMultiprocessorCount, dev);
        (void)hipFuncSetAttribute((const void*)fwd_megakernel, hipFuncAttributeMaxDynamicSharedMemorySize, (int)kDynLds);
        (void)hipOccupancyMaxActiveBlocksPerMultiprocessor(&per_cu, fwd_megakernel, 512, kDynLds);
        if (per_cu < 1) { fprintf(stderr, "occupancy query returned %d\n", per_cu); per_cu = 1; }
        if (per_cu > 1) per_cu = 1;
        grid_blocks = cus * per_cu;
        if (grid_blocks > 256) grid_blocks = 256;
    }
    if (ws_size < WS_NEED) { fprintf(stderr, "workspace too small: %zu < %zu\n", ws_size, WS_NEED); return; }
    Params p{};
    for (int i = 0; i < 18; ++i) p.in[i] = (const float*)d_in[i];
    p.out = (float*)d_out; p.ws = (unsigned char*)d_ws;
#if MK_SPLIT
    for (int ph = 0; ph < 22; ++ph) {
        int lo = ph, hi = ph + 1, us = 0;
        void* args[] = {(void*)&p, (void*)&lo, (void*)&hi, (void*)&us};
        hipLaunchCooperativeKernel((const void*)fwd_megakernel, dim3(grid_blocks), dim3(512), args, kDynLds, stream);
    }
#else
    (void)hipMemsetAsync((unsigned char*)d_ws + OFF_BAR, 0, 16384, stream);
    (void)hipMemsetAsync((unsigned char*)d_ws + OFF_MOD, 0, (size_t)4 * 3 * 6144 * 4, stream);
    int lo = 0, hi = 1000, us = 1;
    void* args[] = {(void*)&p, (void*)&lo, (void*)&hi, (void*)&us};
    hipError_t e = hipLaunchCooperativeKernel((const void*)fwd_megakernel, dim3(grid_blocks), dim3(512), args, kDynLds, stream);
    if (e != hipSuccess) fprintf(stderr, "cooperative launch failed: %s (grid %d)\n", hipGetErrorString(e), grid_blocks);
#endif
}
```

```cpp
#include <hip/hip_runtime.h>
#include <hip/hip_cooperative_groups.h>
#include <cstdio>
namespace cg = cooperative_groups;
namespace pg8 {
#define PG8_LAS __attribute__((address_space(3)))
typedef unsigned short bf16_t;
typedef short bf16x8 __attribute__((ext_vector_type(8)));
typedef float f32x4 __attribute__((ext_vector_type(4)));
typedef unsigned u32x4 __attribute__((ext_vector_type(4)));
constexpr int BM = 256, BK = 64, HALF = 128, HTB = HALF * BK * 2  , STAGE_BYTES = 8 * HTB, NXCD = 8, WGM = 8;

__host__ __device__ __forceinline__ int lds_byte(int r, int c) { const int st = (r >> 4) * 2 + (c >> 5), rr = r & 15, cc = c & 31, ob = rr * 64 + cc * 2; return st * 1024 + (ob ^ (((ob >> 9) & 1) << 5)); }
__host__ __device__ __forceinline__ void stage_rc(int b, int& R, int& C) { const int st = b / 1024, sb = b % 1024, swz = sb ^ (((sb >> 9) & 1) << 5); R = (st >> 1) * 16 + swz / 64; C = (st & 1) * 32 + (swz % 64) / 2; }
__host__ __device__ __forceinline__ int perm32(int rho) { const int n = rho >> 4, i = rho & 15; return 8 * (i >> 2) + 4 * n + (i & 3); }

struct Unit { int pm, pn; };
struct Gemm { const bf16_t* A; const bf16_t* Bt; int M, N, K; };

struct StaticOrder {
    int nM, nN, nwg, G, c;
    __host__ __device__ void init(int M, int N, int G_, int c_) { nM = M / BM; nN = N / BM; nwg = nM * nN; G = G_; c = c_; }
    __host__ __device__ bool next(int i, Unit& u) const {
        const long L = (long)i * G + c; if (L >= nwg) return false;
        int wgid = (int)L; { const int q = nwg / NXCD, r = nwg % NXCD, xcd = wgid % NXCD, off = wgid / NXCD; wgid = (xcd < r ? xcd * (q + 1) : r * (q + 1) + (xcd - r) * q) + off; }
        const int nig = WGM * nN, gid = wgid / nig, fm = gid * WGM, gsz = (nM - fm) < WGM ? (nM - fm) : WGM;
        u.pm = fm + ((wgid % nig) % gsz); u.pn = (wgid % nig) / gsz; return true;
    }
    __device__ __forceinline__ void a_ready(const Unit&) const {}
    __device__ __forceinline__ void done(const Unit&) const {}
};
typedef __bf16 bf16x2_t __attribute__((ext_vector_type(2)));
typedef float f32x2_t __attribute__((ext_vector_type(2)));
__device__ __forceinline__ unsigned cvt_pk_bf16(float lo, float hi) { const f32x2_t v = {lo, hi}; const bf16x2_t r = __builtin_convertvector(v, bf16x2_t); return __builtin_bit_cast(unsigned, r); }
template <class Epi, class Sched, bool STAMP = false>
__device__ __forceinline__ void gemm_phase(PG8_LAS unsigned char* lds, const Gemm g, const Sched& S, const Epi& E, unsigned long long* stamps) {
    int tid_ = threadIdx.x; asm volatile("" : "+v"(tid_));
    const int tid = tid_, wid = __builtin_amdgcn_readfirstlane(tid >> 6), lane = tid & 63, wr = wid >> 2, wc = wid & 3, fr = lane & 15, fq = lane >> 4;
    const int K = g.K, nt = K / BK;
    int ts_lo = 0, ts_hi = 0, nts = 0; const unsigned long long rt_entry = STAMP ? (unsigned long long)wall_clock64() : 0ull;
#define PG8_STAMP() do { if (STAMP && wid == 0 && nts < 64) { const unsigned long long _c = (unsigned long long)clock64(); \
        ts_lo = (lane == nts) ? (int)(unsigned)_c : ts_lo; ts_hi = (lane == nts) ? (int)(unsigned)(_c >> 32) : ts_hi; ++nts; } } while (0)
    PG8_STAMP();
    unsigned voffA[2], voffB[2];
#pragma unroll
    for (int i = 0; i < 2; ++i) { int R, C; stage_rc(tid * 16 + i * 8192, R, C); const int Rb = Epi::PERM ? ((R & ~31) + perm32(R & 31)) : R;
        voffA[i] = (unsigned)(R * K + C) * 2u; voffB[i] = (unsigned)(Rb * K + C) * 2u; }
    const size_t kstep = (size_t)(BK * 2);
    const size_t hstep = (size_t)HALF * K * 2;
    const size_t tstep = 2 * hstep;
    const unsigned ldsw = (unsigned)wid * 1024u;
    const int aoff = lds_byte(wr * 64 + fr, fq * 8), boff = lds_byte(wc * 32 + fr, fq * 8);
#define PG8_SA(b, h) (((b) * 2 + (h)) * HTB)
#define PG8_SB(b, h) ((4 + (b) * 2 + (h)) * HTB)
#define PG8_STAGE(bufoff, gbase, voff) do { _Pragma("unroll") for (int _i = 0; _i < 2; ++_i) \
        __builtin_amdgcn_global_load_lds((const unsigned*)((const char*)(gbase) + (voff)[_i]), (PG8_LAS unsigned*)(lds + (bufoff) + ldsw + _i * 8192), 16, 0, 0); } while (0)
#define PG8_LDA(dst, b, h) do { _Pragma("unroll") for (int m = 0; m < 4; ++m) _Pragma("unroll") for (int k = 0; k < 2; ++k) dst[m][k] = *(const PG8_LAS bf16x8*)(lds + PG8_SA(b, h) + aoff + m * 2048 + k * 1024); } while (0)
#define PG8_LDB(dst, b, h) do { _Pragma("unroll") for (int n = 0; n < 2; ++n) _Pragma("unroll") for (int k = 0; k < 2; ++k) dst[n][k] = *(const PG8_LAS bf16x8*)(lds + PG8_SB(b, h) + boff + n * 2048 + k * 1024); } while (0)
#define PG8_MMA(ai, bj, At, Bt) do { __builtin_amdgcn_s_setprio(1); _Pragma("unroll") for (int m = 0; m < 4; ++m) _Pragma("unroll") for (int n = 0; n < 2; ++n) _Pragma("unroll") for (int k = 0; k < 2; ++k) \
        acc[ai][bj][m][n] = __builtin_amdgcn_mfma_f32_16x16x32_bf16(Bt[n][k], At[m][k], acc[ai][bj][m][n], 0, 0, 0); __builtin_amdgcn_s_setprio(0); } while (0)
#define PG8_WAIT_V(n) asm volatile("s_waitcnt vmcnt(" #n ")" ::: "memory")
#define PG8_WAIT_L(n) asm volatile("s_waitcnt lgkmcnt(" #n ")" ::: "memory")
#define PG8_BAR __builtin_amdgcn_s_barrier()
#define PG8_SCHED __builtin_amdgcn_sched_barrier(0)
    Unit cur, nxt; int ui = 0;
    if (!S.next(0, cur)) return;
    f32x4 acc[2][2][4][2];
#pragma unroll
    for (int a = 0; a < 2; ++a)
#pragma unroll
        for (int b = 0; b < 2; ++b)
#pragma unroll
            for (int m = 0; m < 4; ++m)
#pragma unroll
                for (int n = 0; n < 2; ++n) acc[a][b][m][n] = (f32x4){0.f, 0.f, 0.f, 0.f};
    bf16x8 At[4][2], B0[2][2], B1[2][2];
    const char* cA = (const char*)g.A + (size_t)cur.pm * tstep; const char* cB = (const char*)g.Bt + (size_t)cur.pn * tstep;
    S.a_ready(cur);
    PG8_STAGE(PG8_SB(0, 0), cB, voffB); PG8_STAGE(PG8_SA(0, 0), cA, voffA); PG8_STAGE(PG8_SB(0, 1), cB + hstep, voffB); PG8_STAGE(PG8_SA(0, 1), cA + hstep, voffA);
    if (wr == 1) PG8_BAR;
    PG8_WAIT_V(4); PG8_BAR;
    PG8_STAGE(PG8_SB(1, 0), cB + kstep, voffB); PG8_STAGE(PG8_SA(1, 0), cA + kstep, voffA); PG8_STAGE(PG8_SB(1, 1), cB + hstep + kstep, voffB);
    PG8_WAIT_V(6); PG8_BAR;
    PG8_STAMP();
    for (;;) {
        const bool has_next = S.next(ui + 1, nxt);
        const char* nA = has_next ? (const char*)g.A + (size_t)nxt.pm * tstep : cA; const char* nB = has_next ? (const char*)g.Bt + (size_t)nxt.pn * tstep : cB;
        for (int t = 0; t < nt; t += 2) {
            const bool last = (t == nt - 2);
            const char* a1 = cA + (size_t)(t + 1) * kstep;
            const char* a2 = last ? nA : cA + (size_t)(t + 2) * kstep; const char* b2 = last ? nB : cB + (size_t)(t + 2) * kstep;
            const char* a3 = a2 + kstep; const char* b3 = b2 + kstep;
            if (last && has_next) S.a_ready(nxt);
            PG8_LDB(B0, 0, 0); PG8_SCHED; PG8_LDA(At, 0, 0); PG8_STAGE(PG8_SA(1, 1), a1 + hstep, voffA);
            PG8_WAIT_L(8); PG8_BAR; PG8_WAIT_L(0); PG8_MMA(0, 0, At, B0); PG8_BAR; PG8_SCHED;
            PG8_LDB(B1, 0, 1); PG8_STAGE(PG8_SB(0, 0), b2, voffB);
            PG8_BAR; PG8_WAIT_L(0); PG8_MMA(0, 1, At, B1); PG8_BAR;
            PG8_LDA(At, 0, 1); PG8_STAGE(PG8_SA(0, 0), a2, voffA);
            PG8_BAR; PG8_WAIT_L(0); PG8_MMA(1, 0, At, B0); PG8_BAR; PG8_SCHED;
            PG8_STAGE(PG8_SB(0, 1), b2 + hstep, voffB);
            PG8_WAIT_V(6); PG8_BAR; PG8_MMA(1, 1, At, B1); PG8_BAR;
            PG8_LDB(B0, 1, 0); PG8_SCHED; PG8_LDA(At, 1, 0); PG8_STAGE(PG8_SA(0, 1), a2 + hstep, voffA);
            PG8_WAIT_L(8); PG8_BAR; PG8_WAIT_L(0); PG8_MMA(0, 0, At, B0); PG8_BAR; PG8_SCHED;
            PG8_LDB(B1, 1, 1); PG8_STAGE(PG8_SB(1, 0), b3, voffB);
            PG8_BAR; PG8_WAIT_L(0); PG8_MMA(0, 1, At, B1); PG8_BAR;
            PG8_LDA(At, 1, 1); PG8_STAGE(PG8_SA(1, 0), a3, voffA);
            PG8_BAR; PG8_WAIT_L(0); PG8_MMA(1, 0, At, B0); PG8_BAR; PG8_SCHED;
            PG8_STAGE(PG8_SB(1, 1), b3 + hstep, voffB);
            PG8_WAIT_V(6); PG8_BAR; PG8_MMA(1, 1, At, B1); PG8_BAR;
        }
        PG8_STAMP();
        if constexpr (!Epi::AFTER_DRAIN) { E(acc, cur, wr, wc, fr, fq); S.done(cur); }
        PG8_STAMP();
        if (!has_next) break;
#pragma unroll
        for (int a = 0; a < 2; ++a)
#pragma unroll
            for (int b = 0; b < 2; ++b)
#pragma unroll
                for (int m = 0; m < 4; ++m)
#pragma unroll
                    for (int n = 0; n < 2; ++n) acc[a][b][m][n] = (f32x4){0.f, 0.f, 0.f, 0.f};
        cur = nxt; cA = nA; cB = nB; ++ui;
    }
    PG8_WAIT_V(0);
    if (wr == 0) PG8_BAR;
    PG8_BAR;
    if constexpr (Epi::AFTER_DRAIN) { E.fused(acc, cur, wr, wc, fr, fq, lds, wid, lane); S.done(cur); }
    PG8_STAMP();
    if (STAMP && wid == 0) { stamps[lane] = lane < nts ? (((unsigned long long)(unsigned)ts_hi << 32) | (unsigned)ts_lo) : 0ull;
        if (lane == 62) stamps[62] = rt_entry; if (lane == 63) stamps[63] = (unsigned long long)wall_clock64(); }
#undef PG8_STAMP
#undef PG8_SA
#undef PG8_SB
#undef PG8_STAGE
#undef PG8_LDA
#undef PG8_LDB
#undef PG8_MMA
#undef PG8_WAIT_V
#undef PG8_WAIT_L
#undef PG8_BAR
#undef PG8_SCHED
}
}


using pg8::bf16_t; using pg8::bf16x8; using pg8::f32x4; using pg8::u32x4; using pg8::cvt_pk_bf16;
typedef float f32x16 __attribute__((ext_vector_type(16)));
typedef short bf16x4 __attribute__((ext_vector_type(4)));
typedef unsigned u32x2 __attribute__((ext_vector_type(2)));
#define LAS __attribute__((address_space(3)))

constexpr int DM = 2048, MROWS = 12288, NPROMPT = 8192, INW = 5120;
constexpr float LOG2E = 1.4426950408889634f;

constexpr size_t OFF_WTIN  = 0;
constexpr size_t OFF_WTOUT = OFF_WTIN  + (size_t)4 * 5120 * 2048 * 2;
constexpr size_t OFF_MOD   = OFF_WTOUT + (size_t)4 * 2048 * 2048 * 2;
constexpr size_t OFF_H     = OFF_MOD   + (size_t)4 * 3 * 6144 * 4;
constexpr size_t OFF_PROJ  = OFF_H     + (size_t)MROWS * 2048 * 2;
constexpr size_t OFF_O     = OFF_PROJ  + (size_t)MROWS * 5120 * 2;
constexpr size_t OFF_Y     = OFF_O     + (size_t)MROWS * 2048 * 2;
constexpr size_t OFF_VT    = OFF_Y     + (size_t)MROWS * 2048 * 4;
constexpr size_t OFF_CTXK  = OFF_VT    + (size_t)MROWS * 512 * 2;
constexpr size_t OFF_CTXVT = OFF_CTXK  + (size_t)2 * 2 * 256 * 512 * 2;
constexpr size_t OFF_YTP   = OFF_CTXVT + (size_t)2 * 2 * 256 * 512 * 2;
constexpr size_t OFF_YTS   = OFF_YTP   + (size_t)32 * 512 * 512 * 2;
constexpr size_t OFF_TW256 = OFF_YTS   + (size_t)2 * 512 * 4096 * 2;
constexpr size_t OFF_TW2K  = OFF_TW256 + (size_t)256 * 512 * 2;
constexpr size_t OFF_CCS   = OFF_TW2K  + (size_t)2048 * 4096 * 2;
constexpr size_t OFF_POOLW = OFF_CCS   + (size_t)256 * 128 * 2;
constexpr size_t OFF_SGUW  = OFF_POOLW + (size_t)2 * 4 * 256 * 256 * 2;
constexpr size_t OFF_BAR   = OFF_SGUW  + (size_t)2 * 4 * 128 * 128 * 2;
constexpr size_t OFF_YH    = OFF_BAR + 16384;
constexpr size_t OFF_XB    = OFF_YH + 8192;
constexpr size_t WS_NEED   = OFF_XB + (size_t)MROWS * 2048 * 2;

struct Params { const float* in[18]; float* out; unsigned char* ws; };
enum { I_XP = 0, I_XS, I_CK, I_CV, I_C, I_CCTX, I_WADA, I_BADA, I_NPRE, I_NPOST, I_WIN, I_WOUT, I_SINK, I_POOLW, I_POOLS, I_SGUN, I_SGUW, I_SGUB };

__device__ __forceinline__ int my_tid() { int t = threadIdx.x; asm volatile("" : "+v"(t)); return t; }
__device__ __forceinline__ float bflo(unsigned w) { return __uint_as_float(w << 16); }
__device__ __forceinline__ float bfhi(unsigned w) { return __uint_as_float(w & 0xffff0000u); }
__device__ __forceinline__ float bf1(bf16_t b) { return __uint_as_float(((unsigned)b) << 16); }
__device__ __forceinline__ float silu(float x) { return x * __builtin_amdgcn_rcpf(1.f + __builtin_amdgcn_exp2f(-1.4426950408889634f * x)); }
__device__ __forceinline__ bf16_t f2bf(float f) { return (bf16_t)(cvt_pk_bf16(f, 0.f) & 0xffffu); }
__device__ __forceinline__ float wave_sum(float v) {
#pragma unroll
    for (int o = 32; o >= 1; o >>= 1) v += __shfl_xor(v, o);
    return v;
}
__device__ __forceinline__ bf16x8 ld16(const bf16_t* p) { return *(const bf16x8*)p; }
__device__ __forceinline__ bf16x8 ld8x2(const bf16_t* p0, const bf16_t* p1) {
    const bf16x4 a = *(const bf16x4*)p0, b = *(const bf16x4*)p1;
    return __builtin_shufflevector(a, b, 0, 1, 2, 3, 4, 5, 6, 7);
}
#define GAS __attribute__((address_space(1)))
__device__ __forceinline__ bf16x8 ldg16(const bf16_t* p) { return *(const GAS bf16x8*)p; }
__device__ __forceinline__ bf16x8 ldg8x2(const bf16_t* p0, const bf16_t* p1) {
    const bf16x4 a = *(const GAS bf16x4*)p0, b = *(const GAS bf16x4*)p1;
    return __builtin_shufflevector(a, b, 0, 1, 2, 3, 4, 5, 6, 7);
}
__device__ __forceinline__ f32x16 mfma32(bf16x8 a, bf16x8 b, f32x16 c) { return __builtin_amdgcn_mfma_f32_32x32x16_bf16(a, b, c, 0, 0, 0); }

__device__ __forceinline__ void transpose_tiles(const Params& p, unsigned char* smem, const int l) {
    float* tile = (float*)smem + 3 * 2048 + 8 * 3 * 256;
    volatile int* slot = (volatile int*)(tile + 128 * 129);
    const int tid = my_tid();
    unsigned* qcnt = (unsigned*)(p.ws + OFF_BAR) + 3500 + l;
    const float* win = p.in[I_WIN] + (size_t)l * 2048 * 5120; const float* wout = p.in[I_WOUT] + (size_t)l * 2048 * 2048;
    bf16_t* wtin = (bf16_t*)(p.ws + OFF_WTIN) + (size_t)l * 5120 * 2048; bf16_t* wtout = (bf16_t*)(p.ws + OFF_WTOUT) + (size_t)l * 2048 * 2048;
    __syncthreads();
    if (tid == 0) *slot = (int)atomicAdd(qcnt, 1u);
    __syncthreads();
    int cur = *slot;
    const int rr = tid >> 5, c4 = (tid & 31) * 4, nn = tid >> 2, kq0 = tid & 3;
    while (cur < 896) {
        int nxt = 0;
        if (tid == 0) nxt = (int)atomicAdd(qcnt, 1u);
        const float* src; bf16_t* dst; int N, kt, nt;
        if (cur < 640) { kt = cur / 40; nt = cur % 40; N = 5120; src = win; dst = wtin; }
        else { const int r = cur - 640; kt = r >> 4; nt = r & 15; N = 2048; src = wout; dst = wtout; }
        const int k0 = kt * 128, n0 = nt * 128;
        f32x4 v[8];
#pragma unroll
        for (int i = 0; i < 8; ++i) v[i] = __builtin_nontemporal_load((const GAS f32x4*)(src + (size_t)(k0 + rr + 16 * i) * N + n0 + c4));
#pragma unroll
        for (int i = 0; i < 8; ++i) { float* tp = tile + (rr + 16 * i) * 129 + c4; tp[0] = v[i][0]; tp[1] = v[i][1]; tp[2] = v[i][2]; tp[3] = v[i][3]; }
        __syncthreads();
#pragma unroll
        for (int jj = 0; jj < 4; ++jj) {
            const int kq = kq0 + 4 * jj;
            float t[8];
#pragma unroll
            for (int e = 0; e < 8; ++e) t[e] = tile[(kq * 8 + e) * 129 + nn];
            u32x4 w; w.x = cvt_pk_bf16(t[0], t[1]); w.y = cvt_pk_bf16(t[2], t[3]); w.z = cvt_pk_bf16(t[4], t[5]); w.w = cvt_pk_bf16(t[6], t[7]);
            *(GAS u32x4*)(dst + (size_t)(n0 + nn) * 2048 + k0 + kq * 8) = w;
        }
        if (tid == 0) *slot = nxt;
        __syncthreads();
        cur = *slot;
    }
}

__device__ __forceinline__ void phase0(const Params& p, unsigned char* smem) {
    float* sc = (float*)smem;
    float* red = sc + 3 * 2048;
    const int tid = my_tid(), wave = tid >> 6, lane = tid & 63;
    for (int i = tid; i < 3 * 2048; i += 512) {
        const int ci = i >> 11, k = i & 2047;
        const float v = ci == 0 ? p.in[I_CCTX][k] : p.in[I_C][(ci - 1) * 2048 + k];
        sc[i] = silu(v);
    }
    __syncthreads();
    float* mod = (float*)(p.ws + OFF_MOD);
    for (int item = blockIdx.x; item < 192; item += gridDim.x) {
        const int l = item / 48, rem = item % 48, n0 = (rem >> 1) * 256, kh = rem & 1;
        const float* wp = p.in[I_WADA] + ((size_t)l * 2048 + kh * 1024 + wave * 128) * 6144 + n0 + lane * 4;
        const float* s0 = sc + kh * 1024 + wave * 128;
        f32x4 a0 = {0.f, 0.f, 0.f, 0.f}, a1 = a0, a2 = a0;
#pragma unroll 8
        for (int kk = 0; kk < 128; ++kk) {
            const f32x4 wv = __builtin_nontemporal_load((const GAS f32x4*)(wp + (size_t)kk * 6144));
            a0 += wv * s0[kk]; a1 += wv * s0[2048 + kk]; a2 += wv * s0[4096 + kk];
        }
        *(f32x4*)(red + (wave * 3 + 0) * 256 + lane * 4) = a0; *(f32x4*)(red + (wave * 3 + 1) * 256 + lane * 4) = a1; *(f32x4*)(red + (wave * 3 + 2) * 256 + lane * 4) = a2;
        __syncthreads();
        for (int o = tid; o < 768; o += 512) {
            const int ci = o >> 8, col = o & 255;
            float s_ = kh == 0 ? p.in[I_BADA][l * 6144 + n0 + col] : 0.f;
#pragma unroll
            for (int w = 0; w < 8; ++w) s_ += red[(w * 3 + ci) * 256 + col];
            atomicAdd(mod + (l * 3 + ci) * 6144 + n0 + col, s_);
        }
        __syncthreads();
    }
    const int lcv = gridDim.x == 256 ? 1 : 4;
#pragma unroll 1
    for (int l = 0; l < lcv; ++l) transpose_tiles(p, smem, l);
    const int gt = blockIdx.x * 512 + tid, NT = gridDim.x * 512;
    {
        bf16_t* o = (bf16_t*)(p.ws + OFF_POOLW);
        for (int idx = gt; idx < 2 * 4 * 256 * 256; idx += NT) {
            const int lg = idx >> 16, mt = (idx >> 13) & 7, s_ = (idx >> 9) & 15, ln = (idx >> 3) & 63, jj = idx & 7;
            const int d = mt * 32 + (ln & 31), c = s_ * 16 + (ln >> 5) * 8 + jj;
            o[idx] = f2bf(p.in[I_POOLW][(lg * 256 + c) * 256 + d]);
        }
    }
    {
        bf16_t* o = (bf16_t*)(p.ws + OFF_SGUW);
        for (int idx = gt; idx < 2 * 4 * 128 * 128; idx += NT) {
            const int lh = idx >> 14, nt = (idx >> 12) & 3, s_ = (idx >> 9) & 7, ln = (idx >> 3) & 63, jj = idx & 7;
            const int pp = nt * 32 + (ln & 31), qq = s_ * 16 + (ln >> 5) * 8 + jj;
            o[idx] = f2bf(p.in[I_SGUW][(lh * 128 + pp) * 128 + qq]);
        }
    }
    {
        bf16_t* o = (bf16_t*)(p.ws + OFF_CCS);
        for (int idx = gt; idx < 256 * 128; idx += NT) {
            const int nt_ = idx >> 12, s_ = (idx >> 9) & 7, ln = (idx >> 3) & 63, jj = idx & 7;
            const int R = nt_ * 32 + (ln & 31), c = s_ * 16 + (ln >> 5) * 8 + jj, cs = R >> 7, cp = R & 127; const float x = (float)((c * cp) & 127) * (1.f / 128.f);
            const float v = cs ? __builtin_amdgcn_sinf(x) : __builtin_amdgcn_cosf(x);
            o[idx] = f2bf(v * 0.08838834764831845f);
        }
    }
    {
        bf16_t* o = (bf16_t*)(p.ws + OFF_TW256);
        for (int idx = gt; idx < 256 * 512; idx += NT) {
            const int tp = idx >> 9, k = idx & 511, t = k & 255, isS = k >> 8; const float x = (float)((t * tp) & 255) * (1.f / 256.f);
            const float v = isS ? -__builtin_amdgcn_sinf(x) : __builtin_amdgcn_cosf(x);
            o[idx] = f2bf(v * 0.0625f);
        }
    }
    {
        unsigned* o = (unsigned*)(p.ws + OFF_TW2K);
        for (int idx = gt; idx < 2048 * 1024; idx += NT) {
            const int tp = idx >> 10, k = (idx & 1023) * 2, t = k & 1023, isS = k >> 10;
            const float x0 = (float)((t * tp) & 2047) * (1.f / 2048.f), x1 = (float)(((t + 1) * tp) & 2047) * (1.f / 2048.f);
            float v0 = isS ? -__builtin_amdgcn_sinf(x0) : __builtin_amdgcn_cosf(x0);
            const float v1 = isS ? -__builtin_amdgcn_sinf(x1) : __builtin_amdgcn_cosf(x1);
            if (k == 1024) v0 = (tp & 1) ? -1.f : 1.f;
            o[idx] = cvt_pk_bf16(v0 * 0.022097086912079608f, v1 * 0.022097086912079608f);
        }
    }
    {
        bf16_t* ok = (bf16_t*)(p.ws + OFF_CTXK); bf16_t* ov = (bf16_t*)(p.ws + OFF_CTXVT);
        for (int idx = gt; idx < 2 * 2 * 256 * 512; idx += NT) {
            ok[idx] = f2bf(p.in[I_CK][idx]);
            const int t = idx & 255, dim = (idx >> 8) & 127, kvh = (idx >> 15) & 3, bj = idx >> 17;
            ov[idx] = f2bf(p.in[I_CV][((bj * 256 + t) * 4 + kvh) * 128 + dim]);
        }
    }
}

__device__ __forceinline__ void phase_rows(const Params& p, const int l, LAS unsigned char* lds) {
    const int tid = my_tid(), wave = tid >> 6, lane = tid & 63;
    const float* mod = (const float*)(p.ws + OFF_MOD);
    const bf16_t* ybuf = (const bf16_t*)(p.ws + OFF_Y);
    bf16_t* hbuf = (bf16_t*)(p.ws + OFF_H);
    LAS float* vl = (LAS float*)lds;
    {
        const int l1 = l + 1;
        for (int i = tid; i < 11 * 512; i += 512) {
            const int vsel = i >> 9, c4 = (i & 511) * 4;
            const float* src = nullptr;
            if (vsel < 3) { if (l >= 0) src = mod + (l * 3 + vsel) * 6144 + 4096; }
            else if (vsel == 3) { if (l >= 0) src = p.in[I_NPOST] + l * 2048; }
            else if (vsel < 7) { if (l < 3) src = mod + (l1 * 3 + (vsel - 4)) * 6144; }
            else if (vsel < 10) { if (l < 3) src = mod + (l1 * 3 + (vsel - 7)) * 6144 + 2048; }
            else { if (l < 3) src = p.in[I_NPRE] + l1 * 2048; }
            if (src) *(LAS f32x4*)(vl + vsel * 2048 + c4) = *(const GAS f32x4*)(src + c4);
        }
        __syncthreads();
    }
    for (int row = blockIdx.x * 8 + wave; row < MROWS; row += gridDim.x * 8) {
        const int ci = row < NPROMPT ? 0 : 1 + ((row - NPROMPT) >> 11);
        bf16_t* xb = (bf16_t*)(p.ws + OFF_XB) + (size_t)row * DM;
        f32x4 x[8];
        if (l <= 0) {
            const float* xs = row < NPROMPT ? p.in[I_XP] + (size_t)row * DM : p.in[I_XS] + (size_t)(row - NPROMPT) * DM;
#pragma unroll
            for (int i = 0; i < 8; ++i) x[i] = __builtin_nontemporal_load((const GAS f32x4*)(xs + i * 256 + lane * 4));
        } else {
#pragma unroll
            for (int i = 0; i < 8; ++i) { const u32x2 xw = __builtin_nontemporal_load((const GAS u32x2*)(xb + i * 256 + lane * 4)); x[i][0] = bflo(xw.x); x[i][1] = bfhi(xw.x); x[i][2] = bflo(xw.y); x[i][3] = bfhi(xw.y); }
        }
        if (l >= 0) {
            f32x4 y[8]; float ss = 0.f;
#pragma unroll
            for (int i = 0; i < 8; ++i) { const u32x2 yw = __builtin_nontemporal_load((const GAS u32x2*)(ybuf + (size_t)row * DM + i * 256 + lane * 4)); y[i][0] = bflo(yw.x); y[i][1] = bfhi(yw.x); y[i][2] = bflo(yw.y); y[i][3] = bfhi(yw.y); ss += y[i][0] * y[i][0] + y[i][1] * y[i][1] + y[i][2] * y[i][2] + y[i][3] * y[i][3]; }
            ss = wave_sum(ss);
            const float r = rsqrtf(ss * (1.f / 2048.f) + 1e-6f);
            const LAS float* gate = vl + ci * 2048; const LAS float* np = vl + 3 * 2048;
#pragma unroll
            for (int i = 0; i < 8; ++i) {
                const f32x4 g = *(const LAS f32x4*)(gate + i * 256 + lane * 4), w = *(const LAS f32x4*)(np + i * 256 + lane * 4);
#pragma unroll
                for (int e = 0; e < 4; ++e) x[i][e] += g[e] * (y[i][e] * r * w[e]);
                if (l == 3) *(GAS f32x4*)(p.out + (size_t)row * DM + i * 256 + lane * 4) = x[i];
                else { u32x2 xo; xo.x = cvt_pk_bf16(x[i][0], x[i][1]); xo.y = cvt_pk_bf16(x[i][2], x[i][3]); *(GAS u32x2*)(xb + i * 256 + lane * 4) = xo; }
            }
        }
        if (l < 3) {
            const int l1 = l + 1;
            float ss = 0.f;
#pragma unroll
            for (int i = 0; i < 8; ++i) ss += x[i][0] * x[i][0] + x[i][1] * x[i][1] + x[i][2] * x[i][2] + x[i][3] * x[i][3];
            ss = wave_sum(ss);
            const float r = rsqrtf(ss * (1.f / 2048.f) + 1e-6f);
            const LAS float* shift = vl + (4 + ci) * 2048; const LAS float* scale = vl + (7 + ci) * 2048; const LAS float* np = vl + 10 * 2048;
#pragma unroll
            for (int i = 0; i < 8; ++i) {
                const f32x4 sh = *(const LAS f32x4*)(shift + i * 256 + lane * 4), sl = *(const LAS f32x4*)(scale + i * 256 + lane * 4), w = *(const LAS f32x4*)(np + i * 256 + lane * 4);
                float hv[4];
#pragma unroll
                for (int e = 0; e < 4; ++e) hv[e] = (x[i][e] * r * w[e]) * (1.f + sl[e]) + sh[e];
                u32x2 o; o.x = cvt_pk_bf16(hv[0], hv[1]); o.y = cvt_pk_bf16(hv[2], hv[3]);
                *(u32x2*)(hbuf + (size_t)row * DM + i * 256 + lane * 4) = o;
            }
        }
    }
}

struct EpiProj {
    static constexpr bool PERM = true, AFTER_DRAIN = false;
    bf16_t* O; float* outk; float* outv; int even, j;
    __device__ __forceinline__ void operator()(const f32x4 (&acc)[2][2][4][2], const pg8::Unit& u, int wr, int wc, int fr, int fq) const {
        asm volatile("" : "+v"(fr), "+v"(fq));
        const int rloc0 = wr * 64 + fr, col0 = u.pn * 256 + wc * 32 + 8 * fq;
        const bool kv = even && u.pm < 32 && u.pn >= 6 && u.pn < 10;
        float* cbase = nullptr;
        if (kv) cbase = (u.pn < 8 ? outk : outv) + ((size_t)(u.pm * 2 + j) * 256) * 512 + ((u.pn & 1) * 256 + wc * 32 + 8 * fq);
#pragma unroll
        for (int ai = 0; ai < 2; ++ai)
#pragma unroll
            for (int m = 0; m < 4; ++m) {
                const int rloc = rloc0 + ai * 128 + m * 16;
                bf16_t* rowp = O + (size_t)(u.pm * 256 + rloc) * INW + col0;
#pragma unroll
                for (int bj = 0; bj < 2; ++bj) {
                    const f32x4 v0 = acc[ai][bj][m][0], v1 = acc[ai][bj][m][1];
                    u32x4 w; w.x = cvt_pk_bf16(v0[0], v0[1]); w.y = cvt_pk_bf16(v0[2], v0[3]); w.z = cvt_pk_bf16(v1[0], v1[1]); w.w = cvt_pk_bf16(v1[2], v1[3]);
                    *(u32x4*)(rowp + bj * 128) = w;
                    if (kv) { float* cp = cbase + (size_t)rloc * 512 + bj * 128; *(f32x4*)cp = v0; *(f32x4*)(cp + 4) = v1; }
                    __builtin_amdgcn_sched_barrier(0);
                }
            }
    }
};
struct EpiY {
    static constexpr bool PERM = true, AFTER_DRAIN = false;
    bf16_t* C;
    __device__ __forceinline__ void operator()(const f32x4 (&acc)[2][2][4][2], const pg8::Unit& u, int wr, int wc, int fr, int fq) const {
        asm volatile("" : "+v"(fr), "+v"(fq));
        const int row0 = u.pm * 256 + wr * 64 + fr, col0 = u.pn * 256 + wc * 32 + 8 * fq;
#pragma unroll
        for (int ai = 0; ai < 2; ++ai)
#pragma unroll
            for (int m = 0; m < 4; ++m) {
                bf16_t* rowp = C + (size_t)(row0 + ai * 128 + m * 16) * DM + col0;
#pragma unroll
                for (int bj = 0; bj < 2; ++bj) {
                    const f32x4 v0 = acc[ai][bj][m][0], v1 = acc[ai][bj][m][1];
                    u32x4 w; w.x = cvt_pk_bf16(v0[0], v0[1]); w.y = cvt_pk_bf16(v0[2], v0[3]); w.z = cvt_pk_bf16(v1[0], v1[1]); w.w = cvt_pk_bf16(v1[2], v1[3]);
                    *(u32x4*)(rowp + bj * 128) = w;
                }
            }
    }
};
struct EpiFnet {
    static constexpr bool PERM = true, AFTER_DRAIN = false;
    const bf16_t* proj; bf16_t* O; int rowbase0, T; const float* yh;
    __device__ __forceinline__ void operator()(const f32x4 (&acc)[2][2][4][2], const pg8::Unit& u, int wr, int wc, int fr, int fq) const {
        asm volatile("" : "+v"(fr), "+v"(fq));
        const int row0 = rowbase0 + (u.pn >> 1) * T + u.pm * 256 + wr * 64 + fr, col0 = (u.pn & 1) * 256 + wc * 32 + 8 * fq;
#pragma unroll
        for (int ai = 0; ai < 2; ++ai)
#pragma unroll
            for (int m = 0; m < 4; ++m) {
                const size_t row = (size_t)(row0 + ai * 128 + m * 16);
#pragma unroll
                for (int bj = 0; bj < 2; ++bj) {
                    const u32x4 g = *(const u32x4*)(proj + row * INW + 4608 + col0 + bj * 128);
                    f32x4 v0 = acc[ai][bj][m][0], v1 = acc[ai][bj][m][1];
                    if (yh) { const float sg = (fr & 1) ? -0.022097086912079608f : 0.022097086912079608f; const float* yp = yh + (u.pn >> 1) * 512 + col0 + bj * 128;
                        const f32x4 y0 = *(const GAS f32x4*)yp, y1 = *(const GAS f32x4*)(yp + 4); v0 += y0 * sg; v1 += y1 * sg; }
                    u32x4 w;
                    w.x = cvt_pk_bf16(v0[0] * silu(bflo(g.x)), v0[1] * silu(bfhi(g.x))); w.y = cvt_pk_bf16(v0[2] * silu(bflo(g.y)), v0[3] * silu(bfhi(g.y)));
                    w.z = cvt_pk_bf16(v1[0] * silu(bflo(g.z)), v1[1] * silu(bfhi(g.z))); w.w = cvt_pk_bf16(v1[2] * silu(bflo(g.w)), v1[3] * silu(bfhi(g.w)));
                    *(u32x4*)(O + row * DM + 1536 + col0 + bj * 128) = w;
                    __builtin_amdgcn_sched_barrier(0);
                }
            }
    }
};

__device__ __forceinline__ void phase_even_prep(const Params& p, const int lj, LAS unsigned char* lds) {
    const int tid = my_tid(), wave = tid >> 6, lane = tid & 63, l32 = lane & 31, h = lane >> 5;
    bf16_t* proj = (bf16_t*)(p.ws + OFF_PROJ);
    const bf16_t* ccs = (const bf16_t*)(p.ws + OFF_CCS);
    if ((int)blockIdx.x * 8 < 1024 || (int)(gridDim.x * 8 - 1) - ((int)blockIdx.x * 8 + 7) < 256) {
#pragma unroll
        for (int i = 0; i < 8; ++i) { const int idx = tid + 512 * i; *(LAS u32x4*)(lds + idx * 16) = *(const GAS u32x4*)(ccs + idx * 8); }
        __syncthreads();
    }
    for (int task = blockIdx.x * 8 + wave; task < 256 * 4; task += gridDim.x * 8) {
        const int rb = task >> 2, g = task & 3, row0 = rb * 32;
        bf16x8 af[8];
        const bf16_t* ap = proj + (size_t)(row0 + l32) * INW + 4096 + g * 128 + 8 * h;
#pragma unroll
        for (int s = 0; s < 8; ++s) af[s] = ld16(ap + 16 * s);
        bf16_t* yt; int T, tl0;
        if (row0 < NPROMPT) { T = 256; tl0 = row0 & 255; yt = (bf16_t*)(p.ws + OFF_YTP) + (size_t)(row0 >> 8) * 512 * 512; }
        else { T = 2048; tl0 = (row0 - NPROMPT) & 2047; yt = (bf16_t*)(p.ws + OFF_YTS) + (size_t)((row0 - NPROMPT) >> 11) * 512 * 4096; }
#pragma unroll 1
        for (int nt = 0; nt < 8; ++nt) {
            const int R = nt * 32 + l32;
            const LAS unsigned char* bp = lds + nt * 8192 + lane * 16;
            f32x16 acc;
#pragma unroll
            for (int r = 0; r < 16; ++r) acc[r] = 0.f;
#pragma unroll
            for (int s = 0; s < 8; ++s) acc = mfma32(af[s], *(const LAS bf16x8*)(bp + 1024 * s), acc);
            const int cs = R >> 7, cp = R & 127;
            bf16_t* dst = yt + (size_t)(g * 128 + cp) * (2 * T) + cs * T + tl0 + 4 * h;
#pragma unroll
            for (int q = 0; q < 4; ++q) {
                u32x2 w; w.x = cvt_pk_bf16(acc[4 * q], acc[4 * q + 1]); w.y = cvt_pk_bf16(acc[4 * q + 2], acc[4 * q + 3]);
                *(u32x2*)(dst + 8 * q) = w;
            }
        }
    }
    for (int task = (gridDim.x * 8 - 1) - (blockIdx.x * 8 + wave); task < 256; task += gridDim.x * 8) {
        const int g = task & 3, kb = (task >> 2) & 31, b = task >> 7;
        const int t = kb * 32 + l32, tp = (t == 0) ? 0 : 2048 - t;
        const bf16_t* xa = proj + (size_t)(NPROMPT + b * 2048 + t) * INW + 4096 + g * 128 + 8 * h;
        const bf16_t* ya = proj + (size_t)(NPROMPT + b * 2048 + tp) * INW + 4096 + g * 128 + 8 * h;
        bf16x8 ae[8], ao[8];
#pragma unroll
        for (int s = 0; s < 8; ++s) {
            const u32x4 x = *(const GAS u32x4*)(xa + 16 * s), y = *(const GAS u32x4*)(ya + 16 * s);
            u32x4 e, o;
#pragma unroll
            for (int q = 0; q < 4; ++q) {
                const unsigned xw = q == 0 ? x.x : q == 1 ? x.y : q == 2 ? x.z : x.w, yw = q == 0 ? y.x : q == 1 ? y.y : q == 2 ? y.z : y.w;
                const float x0 = bflo(xw), x1 = bfhi(xw), y0 = bflo(yw), y1 = bfhi(yw);
                const unsigned ew = (t == 0) ? xw : cvt_pk_bf16(x0 + y0, x1 + y1), ow = (t == 0) ? 0u : cvt_pk_bf16(x0 - y0, x1 - y1);
                if (q == 0) { e.x = ew; o.x = ow; } else if (q == 1) { e.y = ew; o.y = ow; } else if (q == 2) { e.z = ew; o.z = ow; } else { e.w = ew; o.w = ow; }
            }
            ae[s] = __builtin_bit_cast(bf16x8, e); ao[s] = __builtin_bit_cast(bf16x8, o);
        }
        bf16_t* yt = (bf16_t*)(p.ws + OFF_YTS) + (size_t)(lj * 2 + b) * 512 * 2048;
#pragma unroll 1
        for (int nt = 0; nt < 4; ++nt) {
            const LAS unsigned char* bp = lds + nt * 8192 + lane * 16;
            f32x16 acc;
#pragma unroll
            for (int r = 0; r < 16; ++r) acc[r] = 0.f;
#pragma unroll
            for (int s = 0; s < 8; ++s) acc = mfma32(ae[s], *(const LAS bf16x8*)(bp + 1024 * s), acc);
            bf16_t* dst = yt + (size_t)(g * 128 + nt * 32 + l32) * 2048 + kb * 32 + 4 * h;
#pragma unroll
            for (int q = 0; q < 4; ++q) { u32x2 w; w.x = cvt_pk_bf16(acc[4 * q], acc[4 * q + 1]); w.y = cvt_pk_bf16(acc[4 * q + 2], acc[4 * q + 3]); *(GAS u32x2*)(dst + 8 * q) = w; }
        }
#pragma unroll 1
        for (int nt = 0; nt < 4; ++nt) {
            const LAS unsigned char* bp = lds + (nt + 4) * 8192 + lane * 16;
            f32x16 acc;
#pragma unroll
            for (int r = 0; r < 16; ++r) acc[r] = 0.f;
#pragma unroll
            for (int s = 0; s < 8; ++s) acc = mfma32(ao[s], *(const LAS bf16x8*)(bp + 1024 * s), acc);
            bf16_t* dst = yt + (size_t)(g * 128 + nt * 32 + l32) * 2048 + 1024 + kb * 32 + 4 * h;
#pragma unroll
            for (int q = 0; q < 4; ++q) { u32x2 w; w.x = cvt_pk_bf16(acc[4 * q], acc[4 * q + 1]); w.y = cvt_pk_bf16(acc[4 * q + 2], acc[4 * q + 3]); *(GAS u32x2*)(dst + 8 * q) = w; }
        }
    }
    const int gt = blockIdx.x * 512 + tid, NT = gridDim.x * 512;
    for (int idx = gt; idx < 1024; idx += NT) {
        const int b = idx >> 9, n = idx & 511, g = n >> 7, cp = n & 127;
        const bf16_t* up = proj + (size_t)(NPROMPT + b * 2048 + 1024) * INW + 4096 + g * 128;
        float a = 0.f;
        u32x4 uv[16];
#pragma unroll
        for (int i = 0; i < 16; ++i) uv[i] = *(const GAS u32x4*)(up + 8 * i);
#pragma unroll
        for (int i = 0; i < 16; ++i)
#pragma unroll
            for (int e = 0; e < 4; ++e) {
                const unsigned w = e == 0 ? uv[i].x : e == 1 ? uv[i].y : e == 2 ? uv[i].z : uv[i].w; const int c = i * 8 + e * 2;
                a += bflo(w) * __builtin_amdgcn_cosf((float)((c * cp) & 127) * (1.f / 128.f)) + bfhi(w) * __builtin_amdgcn_cosf((float)(((c + 1) * cp) & 127) * (1.f / 128.f));
            }
        ((float*)(p.ws + OFF_YH))[lj * 1024 + idx] = a * 0.08838834764831845f;
    }
    for (int idx = gt; idx < 4096 * 16 * 2 * 4; idx += NT) {
        const int ib = idx & 3, a = (idx >> 2) & 1, head = (idx >> 3) & 15, rs = idx >> 7;
        const int t = rs & 2047; const float pos = (float)(a == 0 ? (t >> 6) : (t & 63));
        bf16_t* x1p = proj + (size_t)(NPROMPT + rs) * INW + head * 128 + a * 64 + ib * 8;
        const u32x4 x1 = *(const u32x4*)x1p, x2 = *(const u32x4*)(x1p + 32);
        u32x4 o1, o2;
#pragma unroll
        for (int e = 0; e < 4; ++e) {
            const unsigned w1 = e == 0 ? x1.x : e == 1 ? x1.y : e == 2 ? x1.z : x1.w, w2 = e == 0 ? x2.x : e == 1 ? x2.y : e == 2 ? x2.z : x2.w;
            float r1[2], r2[2];
#pragma unroll
            for (int q = 0; q < 2; ++q) {
                const int i = ib * 8 + e * 2 + q;
                const float inv = __builtin_amdgcn_exp2f(-(float)i * (13.287712379549449f / 32.f));
                const float rev = pos * inv * 0.15915494309189535f;
                const float cc = __builtin_amdgcn_cosf(rev), sn = __builtin_amdgcn_sinf(rev);
                const float a1 = q ? bfhi(w1) : bflo(w1), a2 = q ? bfhi(w2) : bflo(w2);
                r1[q] = a1 * cc - a2 * sn; r2[q] = a2 * cc + a1 * sn;
            }
            const unsigned p1 = cvt_pk_bf16(r1[0], r1[1]), p2 = cvt_pk_bf16(r2[0], r2[1]);
            if (e == 0) { o1.x = p1; o2.x = p2; } else if (e == 1) { o1.y = p1; o2.y = p2; } else if (e == 2) { o1.z = p1; o2.z = p2; } else { o1.w = p1; o2.w = p2; }
        }
        *(u32x4*)x1p = o1; *(u32x4*)(x1p + 32) = o2;
    }
    bf16_t* vt = (bf16_t*)(p.ws + OFF_VT);
    for (int idx = gt; idx < 1536 * 512; idx += NT) {
        const int cd = idx & 511, r8 = idx >> 9, row0 = r8 * 8;
        int rowbase, T;
        if (row0 < NPROMPT) { rowbase = row0 & ~255; T = 256; } else { rowbase = NPROMPT + ((row0 - NPROMPT) & ~2047); T = 2048; }
        const bf16_t* src = proj + (size_t)row0 * INW + 2048 + cd;
        unsigned short v[8];
#pragma unroll
        for (int j = 0; j < 8; ++j) v[j] = src[(size_t)j * INW];
        u32x4 w; w.x = v[0] | ((unsigned)v[1] << 16); w.y = v[2] | ((unsigned)v[3] << 16); w.z = v[4] | ((unsigned)v[5] << 16); w.w = v[6] | ((unsigned)v[7] << 16);
        *(u32x4*)(vt + (size_t)rowbase * 512 + (size_t)cd * T + (row0 - rowbase)) = w;
    }
}

constexpr int AT_KROW = 272, AT_VROW = 136, AT_KBYTES = 64 * AT_KROW, AT_BUF = AT_KBYTES + 128 * AT_VROW;
__device__ __forceinline__ void attn_item(const Params& p, const int item, const int j, LAS unsigned char* lds) {
    const int tid = my_tid(), wave = __builtin_amdgcn_readfirstlane(tid >> 6), lane = tid & 63, l32 = lane & 31, h = lane >> 5;
    int rowbase, T, qh, bs = -1, q0c = 0;
    if (item < 192) { bs = item / 96; const int rem = item % 96; qh = rem >> 3; q0c = (rem & 7) * 256; rowbase = NPROMPT + bs * 2048; T = 2048; }
    else { const int pi = item - 192; rowbase = (pi / 12) * 256; qh = pi % 12; T = 256; }
    const int kvh = qh / 3, q0 = q0c + wave * 32;
    const bf16_t* proj = (const bf16_t*)(p.ws + OFF_PROJ);
    bf16x8 qf[8];
    {
        const bf16_t* qp = proj + (size_t)(rowbase + q0 + l32) * INW + qh * 128 + 8 * h;
#pragma unroll
        for (int s = 0; s < 8; ++s) qf[s] = ldg16(qp + 16 * s);
    }
    float m = p.in[I_SINK][j * 12 + qh] * LOG2E, lsum = (h == 0) ? 1.f : 0.f;
    f32x16 oacc[4];
#pragma unroll
    for (int dt = 0; dt < 4; ++dt)
#pragma unroll
        for (int r = 0; r < 16; ++r) oacc[dt][r] = 0.f;
    int kl0 = 0, kl1 = 256, nctx = 0;
    if (bs >= 0) { kl0 = max(0, q0c - 128); kl1 = min(T, q0c + 384); nctx = 4; }
    const int nlc = (kl1 - kl0) >> 6, nch = nlc + nctx;
    const bf16_t* kg = proj + (size_t)rowbase * INW + 1536 + kvh * 128;
    const bf16_t* vg = (const bf16_t*)(p.ws + OFF_VT) + (size_t)rowbase * 512 + (size_t)(kvh * 128) * T;
    const bf16_t* ckg = (const bf16_t*)(p.ws + OFF_CTXK) + (size_t)((max(bs, 0) * 2 + j) * 256) * 512 + kvh * 128;
    const bf16_t* cvg = (const bf16_t*)(p.ws + OFF_CTXVT) + (size_t)(((max(bs, 0) * 2 + j) * 4 + kvh) * 128) * 256;
    const int krow = tid >> 4, kc16 = tid & 15, vrow = tid >> 3, vc16 = tid & 7;
    u32x4 skA[2], svA[2], skB[2], svB[2];
    auto stage_load = [&](const int ci, u32x4 (&sk)[2], u32x4 (&sv)[2]) {
        const bf16_t* kb; const bf16_t* vb; size_t kst, vst;
        if (ci < nlc) { const int ks = kl0 + 64 * ci; kb = kg + (size_t)ks * INW; kst = INW; vb = vg + ks; vst = (size_t)T; }
        else { const int ks = 64 * (ci - nlc); kb = ckg + (size_t)ks * 512; kst = 512; vb = cvg + ks; vst = 256; }
#pragma unroll
        for (int i = 0; i < 2; ++i) {
            sk[i] = *(const GAS u32x4*)(kb + (size_t)(krow + 32 * i) * kst + kc16 * 8);
            sv[i] = *(const GAS u32x4*)(vb + (size_t)(vrow + 64 * i) * vst + vc16 * 8);
        }
    };
    auto stage_store = [&](const int b, const u32x4 (&sk)[2], const u32x4 (&sv)[2]) {
        LAS unsigned char* base = lds + b * AT_BUF;
#pragma unroll
        for (int i = 0; i < 2; ++i) {
            *(LAS u32x4*)(base + (krow + 32 * i) * AT_KROW + kc16 * 16) = sk[i];
            LAS unsigned char* vd = base + AT_KBYTES + (vrow + 64 * i) * AT_VROW + vc16 * 16;
            u32x2 lo, hi; lo.x = sv[i].x; lo.y = sv[i].y; hi.x = sv[i].z; hi.y = sv[i].w;
            *(LAS u32x2*)vd = lo; *(LAS u32x2*)(vd + 8) = hi;
        }
    };
    constexpr float sc = 0.08838834764831845f * LOG2E;
    __syncthreads();
    stage_load(0, skA, svA); stage_store(0, skA, svA);
    if (nch > 1) stage_load(1, skA, svA);
    __syncthreads();
    auto chunk_step = [&](const int ci, u32x4 (&skc)[2], u32x4 (&svc)[2], u32x4 (&skn)[2], u32x4 (&svn)[2]) {
        if (ci + 2 < nch) stage_load(ci + 2, skn, svn);
        const LAS unsigned char* kbuf = lds + (ci & 1) * AT_BUF;
        const LAS unsigned char* vbuf = kbuf + AT_KBYTES;
        const bool local = ci < nlc;
        const int kc0 = kl0 + 64 * ci;
#pragma unroll 1
        for (int tt = 0; tt < 2; ++tt) {
            const int kt = kc0 + 32 * tt;
            bool masked = false;
            if (local && bs >= 0) { const int d = kt - (q0 - 128); if (d < 0 || d > 256) continue; masked = (d == 0 || d == 256); }
            bf16x8 kf[8];
            const LAS unsigned char* kp = kbuf + (tt * 32 + l32) * AT_KROW + 16 * h;
#pragma unroll
            for (int ks = 0; ks < 8; ++ks) kf[ks] = *(const LAS bf16x8*)(kp + 32 * ks);
            f32x16 s;
#pragma unroll
            for (int r = 0; r < 16; ++r) s[r] = 0.f;
#pragma unroll
            for (int ks = 0; ks < 8; ++ks) s = mfma32(kf[ks], qf[ks], s);
            bf16x8 vf[8];
            const LAS unsigned char* vp = vbuf + l32 * AT_VROW + (tt * 32 + 4 * h) * 2;
#pragma unroll
            for (int dt = 0; dt < 4; ++dt)
#pragma unroll
                for (int c = 0; c < 2; ++c) {
                    const bf16x4 a = *(const LAS bf16x4*)(vp + dt * 32 * AT_VROW + c * 32), b = *(const LAS bf16x4*)(vp + dt * 32 * AT_VROW + c * 32 + 16);
                    vf[dt * 2 + c] = __builtin_shufflevector(a, b, 0, 1, 2, 3, 4, 5, 6, 7);
                }
            float tmax = -3.0e38f;
            if (masked) {
                const int dqk = (q0 + l32) - kt - 4 * h;
#pragma unroll
                for (int r = 0; r < 16; ++r) { const int d = dqk - (8 * (r >> 2) + (r & 3)); if (d > 128 || d < -128) s[r] = -1.0e30f; tmax = fmaxf(tmax, s[r]); }
            } else {
#pragma unroll
                for (int r = 0; r < 16; ++r) tmax = fmaxf(tmax, s[r]);
            }
            { const auto rr = __builtin_amdgcn_permlane32_swap(__float_as_uint(tmax), __float_as_uint(tmax), false, false);
              tmax = fmaxf(__uint_as_float(rr[0]), __uint_as_float(rr[1])) * sc; }
            if (!__all(tmax - m <= 8.0f)) {
                const float mn = fmaxf(m, tmax), alpha = __builtin_amdgcn_exp2f(m - mn);
                m = mn; lsum *= alpha;
#pragma unroll
                for (int dt = 0; dt < 4; ++dt)
#pragma unroll
                    for (int r = 0; r < 16; ++r) oacc[dt][r] *= alpha;
            }
            float ps = 0.f;
#pragma unroll
            for (int r = 0; r < 16; ++r) { s[r] = __builtin_amdgcn_exp2f(__builtin_fmaf(s[r], sc, -m)); ps += s[r]; }
            lsum += ps;
            bf16x8 pb[2];
#pragma unroll
            for (int c = 0; c < 2; ++c) {
                u32x4 w; w.x = cvt_pk_bf16(s[8 * c + 0], s[8 * c + 1]); w.y = cvt_pk_bf16(s[8 * c + 2], s[8 * c + 3]); w.z = cvt_pk_bf16(s[8 * c + 4], s[8 * c + 5]); w.w = cvt_pk_bf16(s[8 * c + 6], s[8 * c + 7]);
                pb[c] = __builtin_bit_cast(bf16x8, w);
            }
#pragma unroll
            for (int dt = 0; dt < 4; ++dt)
#pragma unroll
                for (int c = 0; c < 2; ++c) oacc[dt] = mfma32(vf[dt * 2 + c], pb[c], oacc[dt]);
        }
        if (ci + 1 < nch) stage_store((ci + 1) & 1, skc, svc);
        __syncthreads();
    };
#pragma unroll 1
    for (int ci = 0; ci < nch; ci += 2) {
        chunk_step(ci, skA, svA, skB, svB);
        if (ci + 1 < nch) chunk_step(ci + 1, skB, svB, skA, svA);
    }
    const float lt = lsum + __shfl_xor(lsum, 32), inv = 1.f / lt;
    const size_t row = (size_t)(rowbase + q0 + l32);
    const bf16_t* gp = proj + row * INW + 2560 + qh * 128 + 4 * h;
    bf16_t* op = (bf16_t*)(p.ws + OFF_O) + row * DM + qh * 128 + 4 * h;
#pragma unroll
    for (int dt = 0; dt < 4; ++dt)
#pragma unroll
        for (int g4 = 0; g4 < 4; ++g4) {
            const u32x2 g = *(const GAS u32x2*)(gp + 32 * dt + 8 * g4);
            u32x2 w;
            w.x = cvt_pk_bf16(oacc[dt][4 * g4 + 0] * inv * silu(bflo(g.x)), oacc[dt][4 * g4 + 1] * inv * silu(bfhi(g.x)));
            w.y = cvt_pk_bf16(oacc[dt][4 * g4 + 2] * inv * silu(bflo(g.y)), oacc[dt][4 * g4 + 3] * inv * silu(bfhi(g.y)));
            *(GAS u32x2*)(op + 32 * dt + 8 * g4) = w;
        }
}

constexpr int PL_PITCH = 528;
constexpr int PL_POOLED = 80 * 528;
template <int HW>
__device__ __forceinline__ void pool_body(const Params& p, const int lj, const int g, const int row0, const int rowbase, const int T, LAS unsigned char* lds,
                                          const int tid, const int wave, const int lane, const int l32, const int h) {
    const bf16_t* proj = (const bf16_t*)(p.ws + OFF_PROJ);
    const int tl0 = row0 - rowbase;
    constexpr int NR = 64 + 2 * HW;
    bf16x8 afr[2][16];
    {
        const bf16_t* wt_ = (const bf16_t*)(p.ws + OFF_POOLW) + (size_t)((lj * 4 + g) * 8 + 2 * (wave >> 1)) * 8192 + lane * 8;
#pragma unroll
        for (int s = 0; s < 16; ++s) { afr[0][s] = ldg16(wt_ + 512 * s); afr[1][s] = ldg16(wt_ + 8192 + 512 * s); }
    }
    for (int idx = tid; idx < NR * 32; idx += 512) {
        const int r = idx >> 5, c16 = idx & 31, tt = tl0 - HW + r;
        u32x4 v; v.x = 0u; v.y = 0u; v.z = 0u; v.w = 0u;
        if (tt >= 0 && tt < T) v = *(const GAS u32x4*)(proj + (size_t)(rowbase + tt) * INW + g * 256 + c16 * 8);
        *(LAS u32x4*)(lds + r * PL_PITCH + c16 * 16) = v;
    }
    __syncthreads();
    const int ts = wave & 1, mp = wave >> 1;
    {
        const int tl = tl0 + ts * 32 + l32;
        const float rc = 1.f / (float)(min(tl + HW, T) - max(tl - HW, 0));
        const LAS unsigned char* sp = lds + (ts * 32 + l32) * PL_PITCH + 16 * h;
        LAS unsigned char* pp = lds + PL_POOLED + (ts * 32 + l32) * PL_PITCH + 16 * h;
#pragma unroll 1
        for (int s4 = 0; s4 < 4; ++s4) {
            const int s = mp * 4 + s4;
            float sum[8];
#pragma unroll
            for (int e = 0; e < 8; ++e) sum[e] = 0.f;
#pragma unroll
            for (int d = 0; d < 2 * HW; ++d) {
                const u32x4 v = *(const LAS u32x4*)(sp + d * PL_PITCH + 32 * s);
                sum[0] += bflo(v.x); sum[1] += bfhi(v.x); sum[2] += bflo(v.y); sum[3] += bfhi(v.y);
                sum[4] += bflo(v.z); sum[5] += bfhi(v.z); sum[6] += bflo(v.w); sum[7] += bfhi(v.w);
            }
            const u32x4 sv = *(const LAS u32x4*)(sp + HW * PL_PITCH + 32 * s);
            u32x4 w;
            w.x = cvt_pk_bf16(sum[0] * rc - bflo(sv.x), sum[1] * rc - bfhi(sv.x)); w.y = cvt_pk_bf16(sum[2] * rc - bflo(sv.y), sum[3] * rc - bfhi(sv.y));
            w.z = cvt_pk_bf16(sum[4] * rc - bflo(sv.z), sum[5] * rc - bfhi(sv.z)); w.w = cvt_pk_bf16(sum[6] * rc - bflo(sv.w), sum[7] * rc - bfhi(sv.w));
            *(LAS u32x4*)(pp + 32 * s) = w;
        }
    }
    __syncthreads();
    const LAS unsigned char* bp_ = lds + PL_POOLED + (ts * 32 + l32) * PL_PITCH + 16 * h;
    f32x16 acc[2];
#pragma unroll
    for (int m2 = 0; m2 < 2; ++m2)
#pragma unroll
        for (int r = 0; r < 16; ++r) acc[m2][r] = 0.f;
#pragma unroll
    for (int s = 0; s < 16; ++s) {
        const bf16x8 bfr = *(const LAS bf16x8*)(bp_ + 32 * s);
        acc[0] = mfma32(afr[0][s], bfr, acc[0]); acc[1] = mfma32(afr[1][s], bfr, acc[1]);
    }
    const int row = row0 + ts * 32 + l32;
    const float* psc = p.in[I_POOLS] + lj * 1024 + g * 256 + 4 * h;
    const bf16_t* gp = proj + (size_t)row * INW + 1024 + g * 256 + 4 * h;
    bf16_t* op = (bf16_t*)(p.ws + OFF_O) + (size_t)row * DM + g * 256 + 4 * h;
#pragma unroll
    for (int m2 = 0; m2 < 2; ++m2)
#pragma unroll
        for (int g4 = 0; g4 < 4; ++g4) {
            const int c0 = (2 * mp + m2) * 32 + 8 * g4;
            const u32x2 gg = *(const GAS u32x2*)(gp + c0);
            const f32x4 ps = *(const GAS f32x4*)(psc + c0);
            u32x2 w;
            w.x = cvt_pk_bf16(acc[m2][4 * g4 + 0] * ps[0] * silu(bflo(gg.x)), acc[m2][4 * g4 + 1] * ps[1] * silu(bfhi(gg.x)));
            w.y = cvt_pk_bf16(acc[m2][4 * g4 + 2] * ps[2] * silu(bflo(gg.y)), acc[m2][4 * g4 + 3] * ps[3] * silu(bfhi(gg.y)));
            *(GAS u32x2*)(op + c0) = w;
        }
}
__device__ __forceinline__ void pool_item(const Params& p, const int item, const int lj, LAS unsigned char* lds) {
    const int tid = my_tid(), wave = __builtin_amdgcn_readfirstlane(tid >> 6), lane = tid & 63, l32 = lane & 31, h = lane >> 5;
    const int tb = item >> 2, gs = item & 3, g = gs == 0 ? 0 : gs == 1 ? 3 : gs == 2 ? 1 : 2;
    const int row0 = tb * 64;
    int rowbase, T;
    if (row0 < NPROMPT) { rowbase = row0 & ~255; T = 256; } else { rowbase = NPROMPT + ((row0 - NPROMPT) & ~2047); T = 2048; }
    __syncthreads();
    if (g == 0) pool_body<1>(p, lj, g, row0, rowbase, T, lds, tid, wave, lane, l32, h);
    else if (g == 1) pool_body<2>(p, lj, g, row0, rowbase, T, lds, tid, wave, lane, l32, h);
    else if (g == 2) pool_body<4>(p, lj, g, row0, rowbase, T, lds, tid, wave, lane, l32, h);
    else pool_body<8>(p, lj, g, row0, rowbase, T, lds, tid, wave, lane, l32, h);
}

constexpr int SGU_PITCH = 260;
__device__ __forceinline__ void sgu_item(const Params& p, const int item, const int lj, LAS unsigned char* lds) {
    const int tid = my_tid(), wave = tid >> 6, lane = tid & 63, l32 = lane & 31, h = lane >> 5;
    const int ch = item >> 2, hd = item & 3, R0 = ch * 128;
    const bf16_t* proj = (const bf16_t*)(p.ws + OFF_PROJ);
    LAS bf16_t* vn = (LAS bf16_t*)lds;
    __syncthreads();
    if (tid < 64) *(LAS f32x4*)(lds + 69632 + tid * 16) = *(const GAS f32x4*)(p.in[I_SGUN] + lj * 1024 + hd * 256 + tid * 4);
    bf16x8 wfr[4][8];
    {
        const bf16_t* wb_ = (const bf16_t*)(p.ws + OFF_SGUW) + (size_t)(lj * 4 + hd) * 16384 + lane * 8;
#pragma unroll
        for (int nt = 0; nt < 2; ++nt)
#pragma unroll
            for (int s = 0; s < 8; ++s) wfr[nt][s] = ldg16(wb_ + (size_t)nt * 4096 + 512 * s);
    }
    {
        const int q = tid >> 2, qt = tid & 3;
        const bf16_t* vp = proj + (size_t)(R0 + q) * INW + 3072 + hd * 256 + qt * 64;
        u32x4 v[8];
#pragma unroll
        for (int i = 0; i < 8; ++i) v[i] = *(const GAS u32x4*)(vp + 8 * i);
        float sm = 0.f;
#pragma unroll
        for (int i = 0; i < 8; ++i) sm += (bflo(v[i].x) + bfhi(v[i].x)) + (bflo(v[i].y) + bfhi(v[i].y)) + (bflo(v[i].z) + bfhi(v[i].z)) + (bflo(v[i].w) + bfhi(v[i].w));
        sm += __shfl_xor(sm, 1); sm += __shfl_xor(sm, 2);
        const float mu = sm * (1.f / 256.f);
        float sq = 0.f;
#pragma unroll
        for (int i = 0; i < 8; ++i) {
            float d;
            d = bflo(v[i].x) - mu; sq += d * d; d = bfhi(v[i].x) - mu; sq += d * d; d = bflo(v[i].y) - mu; sq += d * d; d = bfhi(v[i].y) - mu; sq += d * d;
            d = bflo(v[i].z) - mu; sq += d * d; d = bfhi(v[i].z) - mu; sq += d * d; d = bflo(v[i].w) - mu; sq += d * d; d = bfhi(v[i].w) - mu; sq += d * d;
        }
        sq += __shfl_xor(sq, 1); sq += __shfl_xor(sq, 2);
        const float rs = rsqrtf(sq * (1.f / 256.f) + 1e-6f);
        __syncthreads();
        const LAS float* gnp = (const LAS float*)(lds + 69632) + qt * 64;
        LAS bf16_t* dst = vn + q * SGU_PITCH + qt * 64;
#pragma unroll
        for (int i = 0; i < 8; ++i) {
            const f32x4 g0 = *(const LAS f32x4*)(gnp + 8 * i), g1 = *(const LAS f32x4*)(gnp + 8 * i + 4);
            u32x2 w0, w1;
            w0.x = cvt_pk_bf16((bflo(v[i].x) - mu) * rs * g0[0], (bfhi(v[i].x) - mu) * rs * g0[1]); w0.y = cvt_pk_bf16((bflo(v[i].y) - mu) * rs * g0[2], (bfhi(v[i].y) - mu) * rs * g0[3]);
            w1.x = cvt_pk_bf16((bflo(v[i].z) - mu) * rs * g1[0], (bfhi(v[i].z) - mu) * rs * g1[1]); w1.y = cvt_pk_bf16((bflo(v[i].w) - mu) * rs * g1[2], (bfhi(v[i].w) - mu) * rs * g1[3]);
            *(LAS u32x2*)(dst + 8 * i) = w0; *(LAS u32x2*)(dst + 8 * i + 4) = w1;
        }
    }
    __syncthreads();
    {
        const bf16_t* wb_ = (const bf16_t*)(p.ws + OFF_SGUW) + (size_t)(lj * 4 + hd) * 16384 + lane * 8;
#pragma unroll
        for (int nt = 2; nt < 4; ++nt)
#pragma unroll
            for (int s = 0; s < 8; ++s) wfr[nt][s] = ldg16(wb_ + (size_t)nt * 4096 + 512 * s);
    }
    bf16x8 af[8];
    {
        const int c = wave * 32 + l32;
#pragma unroll
        for (int s = 0; s < 8; ++s) {
            unsigned short e[8];
#pragma unroll
            for (int jj = 0; jj < 8; ++jj) e[jj] = vn[(16 * s + 8 * h + jj) * SGU_PITCH + c];
            u32x4 w; w.x = e[0] | ((unsigned)e[1] << 16); w.y = e[2] | ((unsigned)e[3] << 16); w.z = e[4] | ((unsigned)e[5] << 16); w.w = e[6] | ((unsigned)e[7] << 16);
            af[s] = __builtin_bit_cast(bf16x8, w);
        }
    }
    __syncthreads();
#pragma unroll
    for (int nt = 0; nt < 4; ++nt) {
        const int pp = nt * 32 + l32;
        f32x16 acc;
#pragma unroll
        for (int r = 0; r < 16; ++r) acc[r] = 0.f;
#pragma unroll
        for (int s = 0; s < 8; ++s) acc = mfma32(af[s], wfr[nt][s], acc);
        const float bias = p.in[I_SGUB][(lj * 4 + hd) * 128 + pp];
        LAS unsigned char* mp_ = lds + pp * PL_PITCH + (wave * 32 + 4 * h) * 2;
#pragma unroll
        for (int g4 = 0; g4 < 4; ++g4) {
            u32x2 w; w.x = cvt_pk_bf16(acc[4 * g4 + 0] + bias, acc[4 * g4 + 1] + bias); w.y = cvt_pk_bf16(acc[4 * g4 + 2] + bias, acc[4 * g4 + 3] + bias);
            *(LAS u32x2*)(mp_ + 16 * g4) = w;
        }
    }
    __syncthreads();
#pragma unroll 2
    for (int idx = tid; idx < 128 * 32; idx += 512) {
        const int pp = idx >> 5, c16 = idx & 31;
        const size_t row = (size_t)(R0 + pp);
        const int cb = hd * 256 + c16 * 8;
        const u32x4 mx = *(const LAS u32x4*)(lds + pp * PL_PITCH + c16 * 16);
        const u32x4 uu = *(const GAS u32x4*)(proj + row * INW + 2048 + cb), gg = *(const GAS u32x4*)(proj + row * INW + 4096 + cb);
        u32x4 w;
        w.x = cvt_pk_bf16(bflo(uu.x) * bflo(mx.x) * silu(bflo(gg.x)), bfhi(uu.x) * bfhi(mx.x) * silu(bfhi(gg.x)));
        w.y = cvt_pk_bf16(bflo(uu.y) * bflo(mx.y) * silu(bflo(gg.y)), bfhi(uu.y) * bfhi(mx.y) * silu(bfhi(gg.y)));
        w.z = cvt_pk_bf16(bflo(uu.z) * bflo(mx.z) * silu(bflo(gg.z)), bfhi(uu.z) * bfhi(mx.z) * silu(bfhi(gg.z)));
        w.w = cvt_pk_bf16(bflo(uu.w) * bflo(mx.w) * silu(bflo(gg.w)), bfhi(uu.w) * bfhi(mx.w) * silu(bfhi(gg.w)));
        *(GAS u32x4*)((bf16_t*)(p.ws + OFF_O) + row * DM + 1024 + cb) = w;
    }
}

#ifndef MK_SPLIT
#define MK_SPLIT 0
#endif

#define XB_TMO      128
#define XB_XCNT(j)  (256  + 64 * (j))
#define XB_XSUB(j)  (1280 + 64 * (j))
#define XB_XGEN(j)  (2304 + 64 * (j))
#define XB_TOP      3328
#define XB_TOPGEN   3392
#define XCD_BAR_WORDS 3456
#define XB_SPIN_CAP (1u << 18)

__device__ __forceinline__ unsigned xb_ld(unsigned* p)              { return __hip_atomic_load(p, __ATOMIC_RELAXED, __HIP_MEMORY_SCOPE_AGENT); }
__device__ __forceinline__ unsigned xb_add(unsigned* p, unsigned v) { return __hip_atomic_fetch_add(p, v, __ATOMIC_RELAXED, __HIP_MEMORY_SCOPE_AGENT); }
__device__ __forceinline__ unsigned xb_xcc_id() { return (unsigned)__builtin_amdgcn_s_getreg((3 << 11) | 20) & 0xFu; }
#define XB_SPIN(cond, bar) do { unsigned _sp = 0; while (cond) { __builtin_amdgcn_s_sleep(1); \
    if ((++_sp & 255u) == 0u) { if (xb_ld(&(bar)[XB_TMO])) break; if (_sp > XB_SPIN_CAP) { atomicAdd(&(bar)[XB_TMO], 1u); break; } } } } while (0)

struct XcdBarrier {
    unsigned* bar; unsigned x;
    volatile LAS unsigned* st;
};

__device__ __forceinline__ XcdBarrier xcd_barrier_post(unsigned* bar, volatile LAS unsigned* st) {
    XcdBarrier b; b.bar = bar; b.x = xb_xcc_id(); b.st = st;
    if (threadIdx.x == 0) (void)xb_add(&bar[XB_XCNT(b.x)], 1u);
    return b;
}
__device__ __forceinline__ void xcd_barrier_complete(unsigned* bar, unsigned x, unsigned& nloc, unsigned& nx) {
    const unsigned G = gridDim.x * gridDim.y * gridDim.z;
    unsigned sum, cnt, mine, sp = 0u;
    for (;;) {
        sum = 0u; cnt = 0u; mine = 0u;
#pragma unroll
        for (unsigned j = 0; j < 16; ++j) { const unsigned c = xb_ld(&bar[XB_XCNT(j)]); sum += c; cnt += (c > 0u) ? 1u : 0u; mine = (j == x) ? c : mine; }
        if (sum == G) break;
        __builtin_amdgcn_s_sleep(1);
        if ((++sp & 255u) == 0u) { if (xb_ld(&bar[XB_TMO])) break; if (sp > XB_SPIN_CAP) { atomicAdd(&bar[XB_TMO], 1u); break; } }
    }
    nloc = mine > 0u ? mine : 1u; nx = cnt > 0u ? cnt : 1u;
}

__device__ __forceinline__ void xcd_barrier(const XcdBarrier& b) {
    asm volatile("s_waitcnt vmcnt(0)" ::: "memory");
    __syncthreads();
    if (threadIdx.x == 0) {
        unsigned* bar = b.bar;
        __builtin_amdgcn_s_waitcnt(0);
        unsigned nloc = b.st[0], nx = b.st[1];
        if (nloc == 0u) { xcd_barrier_complete(bar, b.x, nloc, nx); b.st[0] = nloc; b.st[1] = nx; }
        const unsigned old = xb_add(&bar[XB_XSUB(b.x)], 1u);
        const unsigned gen = old / nloc;
        if (old + 1u == (gen + 1u) * nloc) {
            __builtin_amdgcn_fence(__ATOMIC_RELEASE, "agent");
            asm volatile("s_waitcnt vmcnt(0)" ::: "memory");
            const unsigned og = xb_add(&bar[XB_TOP], 1u);
            const unsigned tg = og / nx;
            if (og + 1u == (tg + 1u) * nx) xb_add(&bar[XB_TOPGEN], 1u);
            else XB_SPIN(xb_ld(&bar[XB_TOPGEN]) == tg, bar);
            __builtin_amdgcn_fence(__ATOMIC_ACQUIRE, "agent");
            xb_add(&bar[XB_XGEN(b.x)], 1u);
            asm volatile("s_waitcnt vmcnt(0)" ::: "memory");
        } else {
            XB_SPIN(xb_ld(&bar[XB_XGEN(b.x)]) == gen, bar);
            __builtin_amdgcn_fence(__ATOMIC_ACQUIRE, "agent");
            asm volatile("s_waitcnt vmcnt(0)" ::: "memory");
        }
    }
    __syncthreads();
}

#ifndef MK_ENABLE
#define MK_ENABLE 0x1ff
#endif
#define EN(x) (((MK_ENABLE) >> (x)) & 1)
#ifndef MK_DUP
#define MK_DUP 0
#endif
#define DUP(x) (1 + (((MK_DUP) >> (x)) & 1))
__global__ __launch_bounds__(512, 2) void fwd_megakernel(const Params p, const int ph_lo, const int ph_hi, const int use_sync) {
    extern __shared__ __attribute__((aligned(16))) unsigned char shm[];
    cg::grid_group grid = cg::this_grid();
    LAS unsigned char* lds = (LAS unsigned char*)shm;
    const int tid = my_tid(), wave = __builtin_amdgcn_readfirstlane(tid >> 6);
    if (use_sync == 2) grid.sync();
    volatile LAS unsigned* xst = (volatile LAS unsigned*)(lds + 131072);
    if (threadIdx.x < 4) xst[threadIdx.x] = 0u;
    __syncthreads();
    const XcdBarrier xb = xcd_barrier_post((unsigned*)(p.ws + OFF_BAR), xst);
    int ph = 0;
#define PHASE_BEGIN if (ph >= ph_lo && ph < ph_hi) { Params q = p; asm volatile("" : "+s"(q.ws), "+s"(q.out));
#define PHASE_END } ++ph; if (use_sync && ph > ph_lo && ph < ph_hi) xcd_barrier(xb);
#define PHASE_END_LAST } ++ph;
    PHASE_BEGIN for (int rep = 0; rep < DUP(3); ++rep) { if (EN(4)) phase0(q, shm); __syncthreads(); } if (MK_DUP & 1) { for (int i = 0; i < 20; ++i) xcd_barrier(xb); } PHASE_END
    PHASE_BEGIN if (EN(8)) phase_rows(q, -1, lds); PHASE_END
#pragma unroll 1
    for (int l = 0; l < 4; ++l) {
        const int lj = l >> 1;
        PHASE_BEGIN
_Pragma("unroll 1") for (int rep = 0; rep < DUP(4); ++rep) {
            pg8::Gemm g; g.A = (const bf16_t*)(q.ws + OFF_H); g.Bt = (const bf16_t*)(q.ws + OFF_WTIN) + (size_t)l * 5120 * 2048; g.M = MROWS; g.N = INW; g.K = DM;
            pg8::StaticOrder S; S.init(g.M, g.N, (int)gridDim.x, (int)blockIdx.x);
            EpiProj E; E.O = (bf16_t*)(q.ws + OFF_PROJ); E.outk = q.out + (size_t)MROWS * DM; E.outv = E.outk + (size_t)32 * 2 * 256 * 512; E.even = (l & 1) == 0; E.j = lj;
            __syncthreads();
            if (EN(6)) pg8::gemm_phase<EpiProj, pg8::StaticOrder, false>(lds, g, S, E, nullptr);
            __syncthreads();
}
        PHASE_END
        if ((l & 1) == 0) {
            PHASE_BEGIN if (EN(3)) phase_even_prep(q, lj, lds); PHASE_END
            PHASE_BEGIN
_Pragma("unroll 1") for (int rep = 0; rep < DUP(1); ++rep) {                if (blockIdx.x < 32) {
                    pg8::Gemm g; g.A = (const bf16_t*)(q.ws + OFF_TW2K); g.Bt = (const bf16_t*)(q.ws + OFF_YTS) + (size_t)lj * 1024 * 2048; g.M = 2048; g.N = 1024; g.K = 2048;
                    asm volatile("" : "+s"(g.A), "+s"(g.Bt), "+s"(g.M), "+s"(g.N), "+s"(g.K));
                    pg8::StaticOrder S; S.init(g.M, g.N, 32, (int)blockIdx.x);
                    EpiFnet E; E.proj = (const bf16_t*)(q.ws + OFF_PROJ); E.O = (bf16_t*)(q.ws + OFF_O); E.rowbase0 = NPROMPT; E.T = 2048; E.yh = (const float*)(q.ws + OFF_YH) + lj * 1024;
                    __syncthreads();
                    _Pragma("unroll 1") for (int rep2 = 0; rep2 < DUP(7); ++rep2) { if (EN(5)) pg8::gemm_phase<EpiFnet, pg8::StaticOrder, false>(lds, g, S, E, nullptr);
                    __syncthreads(); }
                } else {
                    const int nb = (int)gridDim.x - 32;
                    int fc, fG;
                    if (gridDim.x == 256) {
                        const int xq = (int)blockIdx.x & 7, kq_ = ((int)blockIdx.x >> 3) - 4;
                        if (kq_ < 24) {
#pragma unroll 1
                            for (int u = 0; u < 3; ++u) {
                                int item;
                                if (u == 0) item = (xq >> 2) * 96 + ((xq & 3) * 3 + (kq_ >> 3)) * 8 + (kq_ & 7);
                                else { const int pk = 2 * kq_ + (u - 1), gp_ = xq + 8 * (pk / 3); item = 192 + (gp_ >> 2) * 12 + (gp_ & 3) * 3 + pk % 3; }
                                if (EN(0)) attn_item(q, item, lj, lds);
                            }
                            fc = -1;
                        } else fc = xq * 4 + (kq_ - 24);
                        fG = 32;
                    } else {
                        for (int item = (int)blockIdx.x - 32; item < 576; item += nb) { if (EN(0)) attn_item(q, item, lj, lds); }
                        fc = (int)blockIdx.x - ((int)gridDim.x - 64); fG = 64;
                    }
                    __syncthreads();
                    pg8::Gemm g; g.A = (const bf16_t*)(q.ws + OFF_TW256); g.Bt = (const bf16_t*)(q.ws + OFF_YTP); g.M = 256; g.N = 16384; g.K = 512;
                    asm volatile("" : "+s"(g.A), "+s"(g.Bt), "+s"(g.M), "+s"(g.N), "+s"(g.K));
                    pg8::StaticOrder S; S.init(g.M, g.N, fG, fc);
                    EpiFnet E; E.proj = (const bf16_t*)(q.ws + OFF_PROJ); E.O = (bf16_t*)(q.ws + OFF_O); E.rowbase0 = 0; E.T = 256; E.yh = nullptr;
                    if (EN(5) && fc >= 0) pg8::gemm_phase<EpiFnet, pg8::StaticOrder, false>(lds, g, S, E, nullptr);
                    __syncthreads();
                }
}
            PHASE_END
        } else {
            PHASE_BEGIN
_Pragma("unroll 1") for (int rep = 0; rep < DUP(2); ++rep) {                for (int item = blockIdx.x; item < 384; item += gridDim.x) { if (EN(2)) sgu_item(q, item, lj, lds); }
                {
                    const int bx = (int)blockIdx.x, np = bx < 128 ? 2 : 4, first = bx < 128 ? 2 * bx : 256 + 4 * (bx - 128);
                    if (gridDim.x == 256) { for (int k = 0; k < np; ++k) { if (EN(1)) pool_item(q, first + k, lj, lds); } }
                    else { for (int k = bx; k < 768; k += (int)gridDim.x) { if (EN(1)) pool_item(q, k, lj, lds); } }
                }
                __syncthreads();
}
            PHASE_END
        }
        PHASE_BEGIN
_Pragma("unroll 1") for (int rep = 0; rep < DUP(5); ++rep) {
            pg8::Gemm g; g.A = (const bf16_t*)(q.ws + OFF_O); g.Bt = (const bf16_t*)(q.ws + OFF_WTOUT) + (size_t)l * 2048 * 2048; g.M = MROWS; g.N = DM; g.K = DM;
            pg8::StaticOrder S; S.init(g.M, g.N, (int)gridDim.x, (int)blockIdx.x);
            EpiY E; E.C = (bf16_t*)(q.ws + OFF_Y);
            __syncthreads();
            if (EN(7)) pg8::gemm_phase<EpiY, pg8::StaticOrder, false>(lds, g, S, E, nullptr);
            __syncthreads();
            if (EN(4) && gridDim.x == 256 && blockIdx.x >= 128 && l < 3) transpose_tiles(q, shm, l + 1);
}
        PHASE_END
        if (l < 3) { PHASE_BEGIN if (EN(8)) phase_rows(q, l, lds); PHASE_END } else { PHASE_BEGIN if (EN(8)) phase_rows(q, l, lds); PHASE_END_LAST }
    }
}

extern "C" void kernel_launch(void* const* d_in, const int* in_sizes, int n_in, void* d_out, int out_size, void* d_ws, size_t ws_size, hipStream_t stream) {
    constexpr size_t kDynLds = 131072 + 16;
    static int grid_blocks = 0;
    if (!grid_blocks) {
        int dev = 0, cus = 0, per_cu = 0;
        (void)hipGetDevice(&dev);
        (void)hipDeviceGetAttribute(&cus, hipDeviceAttributeMultiprocessorCount, dev);
        (void)hipFuncSetAttribute((const void*)fwd_megakernel, hipFuncAttributeMaxDynamicSharedMemorySize, (int)kDynLds);
        (void)hipOccupancyMaxActiveBlocksPerMultiprocessor(&per_cu, fwd_megakernel, 512, kDynLds);
        if (per_cu < 1) { fprintf(stderr, "occupancy query returned %d\n", per_cu); per_cu = 1; }
        if (per_cu > 1) per_cu = 1;
        grid_blocks = cus * per_cu;
        if (grid_blocks > 256) grid_blocks = 256;
    }
    if (ws_size < WS_NEED) { fprintf(stderr, "workspace too small: %zu < %zu\n", ws_size, WS_NEED); return; }
    Params p{};
    for (int i = 0; i < 18; ++i) p.in[i] = (const float*)d_in[i];
    p.out = (float*)d_out; p.ws = (unsigned char*)d_ws;
#if MK_SPLIT
    for (int ph = 0; ph < 22; ++ph) {
        int lo = ph, hi = ph + 1, us = 0;
        void* args[] = {(void*)&p, (void*)&lo, (void*)&hi, (void*)&us};
        hipLaunchCooperativeKernel((const void*)fwd_megakernel, dim3(grid_blocks), dim3(512), args, kDynLds, stream);
    }
#else
    (void)hipMemsetAsync((unsigned char*)d_ws + OFF_BAR, 0, 16384, stream);
    (void)hipMemsetAsync((unsigned char*)d_ws + OFF_MOD, 0, (size_t)4 * 3 * 6144 * 4, stream);
    int lo = 0, hi = 1000, us = 1;
    void* args[] = {(void*)&p, (void*)&lo, (void*)&hi, (void*)&us};
    hipError_t e = hipLaunchCooperativeKernel((const void*)fwd_megakernel, dim3(grid_blocks), dim3(512), args, kDynLds, stream);
    if (e != hipSuccess) fprintf(stderr, "cooperative launch failed: %s (grid %d)\n", hipGetErrorString(e), grid_blocks);
#endif
}
```

```cpp
#include <hip/hip_runtime.h>
#include <hip/hip_cooperative_groups.h>
#include <cstdio>
namespace cg = cooperative_groups;
namespace pg8 {
#define PG8_LAS __attribute__((address_space(3)))
typedef unsigned short bf16_t;
typedef short bf16x8 __attribute__((ext_vector_type(8)));
typedef float f32x4 __attribute__((ext_vector_type(4)));
typedef unsigned u32x4 __attribute__((ext_vector_type(4)));
constexpr int BM = 256, BK = 64, HALF = 128, HTB = HALF * BK * 2  , STAGE_BYTES = 8 * HTB, NXCD = 8, WGM = 8;

__host__ __device__ __forceinline__ int lds_byte(int r, int c) { const int st = (r >> 4) * 2 + (c >> 5), rr = r & 15, cc = c & 31, ob = rr * 64 + cc * 2; return st * 1024 + (ob ^ (((ob >> 9) & 1) << 5)); }
__host__ __device__ __forceinline__ void stage_rc(int b, int& R, int& C) { const int st = b / 1024, sb = b % 1024, swz = sb ^ (((sb >> 9) & 1) << 5); R = (st >> 1) * 16 + swz / 64; C = (st & 1) * 32 + (swz % 64) / 2; }
__host__ __device__ __forceinline__ int perm32(int rho) { const int n = rho >> 4, i = rho & 15; return 8 * (i >> 2) + 4 * n + (i & 3); }

struct Unit { int pm, pn; };
struct Gemm { const bf16_t* A; const bf16_t* Bt; int M, N, K; };

struct StaticOrder {
    int nM, nN, nwg, G, c;
    __host__ __device__ void init(int M, int N, int G_, int c_) { nM = M / BM; nN = N / BM; nwg = nM * nN; G = G_; c = c_; }
    __host__ __device__ bool next(int i, Unit& u) const {
        const long L = (long)i * G + c; if (L >= nwg) return false;
        int wgid = (int)L; { const int q = nwg / NXCD, r = nwg % NXCD, xcd = wgid % NXCD, off = wgid / NXCD; wgid = (xcd < r ? xcd * (q + 1) : r * (q + 1) + (xcd - r) * q) + off; }
        const int nig = WGM * nN, gid = wgid / nig, fm = gid * WGM, gsz = (nM - fm) < WGM ? (nM - fm) : WGM;
        u.pm = fm + ((wgid % nig) % gsz); u.pn = (wgid % nig) / gsz; return true;
    }
    __device__ __forceinline__ void a_ready(const Unit&) const {}
    __device__ __forceinline__ void done(const Unit&) const {}
};
typedef __bf16 bf16x2_t __attribute__((ext_vector_type(2)));
typedef float f32x2_t __attribute__((ext_vector_type(2)));
__device__ __forceinline__ unsigned cvt_pk_bf16(float lo, float hi) { const f32x2_t v = {lo, hi}; const bf16x2_t r = __builtin_convertvector(v, bf16x2_t); return __builtin_bit_cast(unsigned, r); }
template <class Epi, class Sched, bool STAMP = false>
__device__ __forceinline__ void gemm_phase(PG8_LAS unsigned char* lds, const Gemm g, const Sched& S, const Epi& E, unsigned long long* stamps) {
    int tid_ = threadIdx.x; asm volatile("" : "+v"(tid_));
    const int tid = tid_, wid = __builtin_amdgcn_readfirstlane(tid >> 6), lane = tid & 63, wr = wid >> 2, wc = wid & 3, fr = lane & 15, fq = lane >> 4;
    const int K = g.K, nt = K / BK;
    int ts_lo = 0, ts_hi = 0, nts = 0; const unsigned long long rt_entry = STAMP ? (unsigned long long)wall_clock64() : 0ull;
#define PG8_STAMP() do { if (STAMP && wid == 0 && nts < 64) { const unsigned long long _c = (unsigned long long)clock64(); \
        ts_lo = (lane == nts) ? (int)(unsigned)_c : ts_lo; ts_hi = (lane == nts) ? (int)(unsigned)(_c >> 32) : ts_hi; ++nts; } } while (0)
    PG8_STAMP();
    unsigned voffA[2], voffB[2];
#pragma unroll
    for (int i = 0; i < 2; ++i) { int R, C; stage_rc(tid * 16 + i * 8192, R, C); const int Rb = Epi::PERM ? ((R & ~31) + perm32(R & 31)) : R;
        voffA[i] = (unsigned)(R * K + C) * 2u; voffB[i] = (unsigned)(Rb * K + C) * 2u; }
    const size_t kstep = (size_t)(BK * 2);
    const size_t hstep = (size_t)HALF * K * 2;
    const size_t tstep = 2 * hstep;
    const unsigned ldsw = (unsigned)wid * 1024u;
    const int aoff = lds_byte(wr * 64 + fr, fq * 8), boff = lds_byte(wc * 32 + fr, fq * 8);
#define PG8_SA(b, h) (((b) * 2 + (h)) * HTB)
#define PG8_SB(b, h) ((4 + (b) * 2 + (h)) * HTB)
#define PG8_STAGE(bufoff, gbase, voff) do { _Pragma("unroll") for (int _i = 0; _i < 2; ++_i) \
        __builtin_amdgcn_global_load_lds((const unsigned*)((const char*)(gbase) + (voff)[_i]), (PG8_LAS unsigned*)(lds + (bufoff) + ldsw + _i * 8192), 16, 0, 0); } while (0)
#define PG8_LDA(dst, b, h) do { _Pragma("unroll") for (int m = 0; m < 4; ++m) _Pragma("unroll") for (int k = 0; k < 2; ++k) dst[m][k] = *(const PG8_LAS bf16x8*)(lds + PG8_SA(b, h) + aoff + m * 2048 + k * 1024); } while (0)
#define PG8_LDB(dst, b, h) do { _Pragma("unroll") for (int n = 0; n < 2; ++n) _Pragma("unroll") for (int k = 0; k < 2; ++k) dst[n][k] = *(const PG8_LAS bf16x8*)(lds + PG8_SB(b, h) + boff + n * 2048 + k * 1024); } while (0)
#define PG8_MMA(ai, bj, At, Bt) do { __builtin_amdgcn_s_setprio(1); _Pragma("unroll") for (int m = 0; m < 4; ++m) _Pragma("unroll") for (int n = 0; n < 2; ++n) _Pragma("unroll") for (int k = 0; k < 2; ++k) \
        acc[ai][bj][m][n] = __builtin_amdgcn_mfma_f32_16x16x32_bf16(Bt[n][k], At[m][k], acc[ai][bj][m][n], 0, 0, 0); __builtin_amdgcn_s_setprio(0); } while (0)
#define PG8_WAIT_V(n) asm volatile("s_waitcnt vmcnt(" #n ")" ::: "memory")
#define PG8_WAIT_L(n) asm volatile("s_waitcnt lgkmcnt(" #n ")" ::: "memory")
#define PG8_BAR __builtin_amdgcn_s_barrier()
#define PG8_SCHED __builtin_amdgcn_sched_barrier(0)
    Unit cur, nxt; int ui = 0;
    if (!S.next(0, cur)) return;
    f32x4 acc[2][2][4][2];
#pragma unroll
    for (int a = 0; a < 2; ++a)
#pragma unroll
        for (int b = 0; b < 2; ++b)
#pragma unroll
            for (int m = 0; m < 4; ++m)
#pragma unroll
                for (int n = 0; n < 2; ++n) acc[a][b][m][n] = (f32x4){0.f, 0.f, 0.f, 0.f};
    bf16x8 At[4][2], B0[2][2], B1[2][2];
    const char* cA = (const char*)g.A + (size_t)cur.pm * tstep; const char* cB = (const char*)g.Bt + (size_t)cur.pn * tstep;
    S.a_ready(cur);
    PG8_STAGE(PG8_SB(0, 0), cB, voffB); PG8_STAGE(PG8_SA(0, 0), cA, voffA); PG8_STAGE(PG8_SB(0, 1), cB + hstep, voffB); PG8_STAGE(PG8_SA(0, 1), cA + hstep, voffA);
    if (wr == 1) PG8_BAR;
    PG8_WAIT_V(4); PG8_BAR;
    PG8_STAGE(PG8_SB(1, 0), cB + kstep, voffB); PG8_STAGE(PG8_SA(1, 0), cA + kstep, voffA); PG8_STAGE(PG8_SB(1, 1), cB + hstep + kstep, voffB);
    PG8_WAIT_V(6); PG8_BAR;
    PG8_STAMP();
    for (;;) {
        const bool has_next = S.next(ui + 1, nxt);
        const char* nA = has_next ? (const char*)g.A + (size_t)nxt.pm * tstep : cA; const char* nB = has_next ? (const char*)g.Bt + (size_t)nxt.pn * tstep : cB;
        for (int t = 0; t < nt; t += 2) {
            const bool last = (t == nt - 2);
            const char* a1 = cA + (size_t)(t + 1) * kstep;
            const char* a2 = last ? nA : cA + (size_t)(t + 2) * kstep; const char* b2 = last ? nB : cB + (size_t)(t + 2) * kstep;
            const char* a3 = a2 + kstep; const char* b3 = b2 + kstep;
            if (last && has_next) S.a_ready(nxt);
            PG8_LDB(B0, 0, 0); PG8_SCHED; PG8_LDA(At, 0, 0); PG8_STAGE(PG8_SA(1, 1), a1 + hstep, voffA);
            PG8_WAIT_L(8); PG8_BAR; PG8_WAIT_L(0); PG8_MMA(0, 0, At, B0); PG8_BAR; PG8_SCHED;
            PG8_LDB(B1, 0, 1); PG8_STAGE(PG8_SB(0, 0), b2, voffB);
            PG8_BAR; PG8_WAIT_L(0); PG8_MMA(0, 1, At, B1); PG8_BAR;
            PG8_LDA(At, 0, 1); PG8_STAGE(PG8_SA(0, 0), a2, voffA);
            PG8_BAR; PG8_WAIT_L(0); PG8_MMA(1, 0, At, B0); PG8_BAR; PG8_SCHED;
            PG8_STAGE(PG8_SB(0, 1), b2 + hstep, voffB);
            PG8_WAIT_V(6); PG8_BAR; PG8_MMA(1, 1, At, B1); PG8_BAR;
            PG8_LDB(B0, 1, 0); PG8_SCHED; PG8_LDA(At, 1, 0); PG8_STAGE(PG8_SA(0, 1), a2 + hstep, voffA);
            PG8_WAIT_L(8); PG8_BAR; PG8_WAIT_L(0); PG8_MMA(0, 0, At, B0); PG8_BAR; PG8_SCHED;
            PG8_LDB(B1, 1, 1); PG8_STAGE(PG8_SB(1, 0), b3, voffB);
            PG8_BAR; PG8_WAIT_L(0); PG8_MMA(0, 1, At, B1); PG8_BAR;
            PG8_LDA(At, 1, 1); PG8_STAGE(PG8_SA(1, 0), a3, voffA);
            PG8_BAR; PG8_WAIT_L(0); PG8_MMA(1, 0, At, B0); PG8_BAR; PG8_SCHED;
            PG8_STAGE(PG8_SB(1, 1), b3 + hstep, voffB);
            PG8_WAIT_V(6); PG8_BAR; PG8_MMA(1, 1, At, B1); PG8_BAR;
        }
        PG8_STAMP();
        if constexpr (!Epi::AFTER_DRAIN) { E(acc, cur, wr, wc, fr, fq); S.done(cur); }
        PG8_STAMP();
        if (!has_next) break;
#pragma unroll
        for (int a = 0; a < 2; ++a)
#pragma unroll
            for (int b = 0; b < 2; ++b)
#pragma unroll
                for (int m = 0; m < 4; ++m)
#pragma unroll
                    for (int n = 0; n < 2; ++n) acc[a][b][m][n] = (f32x4){0.f, 0.f, 0.f, 0.f};
        cur = nxt; cA = nA; cB = nB; ++ui;
    }
    PG8_WAIT_V(0);
    if (wr == 0) PG8_BAR;
    PG8_BAR;
    if constexpr (Epi::AFTER_DRAIN) { E.fused(acc, cur, wr, wc, fr, fq, lds, wid, lane); S.done(cur); }
    PG8_STAMP();
    if (STAMP && wid == 0) { stamps[lane] = lane < nts ? (((unsigned long long)(unsigned)ts_hi << 32) | (unsigned)ts_lo) : 0ull;
        if (lane == 62) stamps[62] = rt_entry; if (lane == 63) stamps[63] = (unsigned long long)wall_clock64(); }
#undef PG8_STAMP
#undef PG8_SA
#undef PG8_SB
#undef PG8_STAGE
#undef PG8_LDA
#undef PG8_LDB
#undef PG8_MMA
#undef PG8_WAIT_V
#undef PG8_WAIT_L
#undef PG8_BAR
#undef PG8_SCHED
}
}


using pg8::bf16_t; using pg8::bf16x8; using pg8::f32x4; using pg8::u32x4; using pg8::cvt_pk_bf16;
typedef float f32x16 __attribute__((ext_vector_type(16)));
typedef short bf16x4 __attribute__((ext_vector_type(4)));
typedef unsigned u32x2 __attribute__((ext_vector_type(2)));
#define LAS __attribute__((address_space(3)))

constexpr int DM = 2048, MROWS = 12288, NPROMPT = 8192, INW = 5120;
constexpr float LOG2E = 1.4426950408889634f;

constexpr size_t OFF_WTIN  = 0;
constexpr size_t OFF_WTOUT = OFF_WTIN  + (size_t)4 * 5120 * 2048 * 2;
constexpr size_t OFF_MOD   = OFF_WTOUT + (size_t)4 * 2048 * 2048 * 2;
constexpr size_t OFF_H     = OFF_MOD   + (size_t)4 * 3 * 6144 * 4;
constexpr size_t OFF_PROJ  = OFF_H     + (size_t)MROWS * 2048 * 2;
constexpr size_t OFF_O     = OFF_PROJ  + (size_t)MROWS * 5120 * 2;
constexpr size_t OFF_Y     = OFF_O     + (size_t)MROWS * 2048 * 2;
constexpr size_t OFF_VT    = OFF_Y     + (size_t)MROWS * 2048 * 4;
constexpr size_t OFF_CTXK  = OFF_VT    + (size_t)MROWS * 512 * 2;
constexpr size_t OFF_CTXVT = OFF_CTXK  + (size_t)2 * 2 * 256 * 512 * 2;
constexpr size_t OFF_YTP   = OFF_CTXVT + (size_t)2 * 2 * 256 * 512 * 2;
constexpr size_t OFF_YTS   = OFF_YTP   + (size_t)32 * 512 * 512 * 2;
constexpr size_t OFF_TW256 = OFF_YTS   + (size_t)2 * 512 * 4096 * 2;
constexpr size_t OFF_TW2K  = OFF_TW256 + (size_t)256 * 512 * 2;
constexpr size_t OFF_CCS   = OFF_TW2K  + (size_t)2048 * 4096 * 2;
constexpr size_t OFF_POOLW = OFF_CCS   + (size_t)256 * 128 * 2;
constexpr size_t OFF_SGUW  = OFF_POOLW + (size_t)2 * 4 * 256 * 256 * 2;
constexpr size_t OFF_BAR   = OFF_SGUW  + (size_t)2 * 4 * 128 * 128 * 2;
constexpr size_t OFF_YH    = OFF_BAR + 16384;
constexpr size_t OFF_XB    = OFF_YH + 8192;
constexpr size_t WS_NEED   = OFF_XB + (size_t)MROWS * 2048 * 2;

struct Params { const float* in[18]; float* out; unsigned char* ws; };
enum { I_XP = 0, I_XS, I_CK, I_CV, I_C, I_CCTX, I_WADA, I_BADA, I_NPRE, I_NPOST, I_WIN, I_WOUT, I_SINK, I_POOLW, I_POOLS, I_SGUN, I_SGUW, I_SGUB };

__device__ __forceinline__ int my_tid() { int t = threadIdx.x; asm volatile("" : "+v"(t)); return t; }
__device__ __forceinline__ float bflo(unsigned w) { return __uint_as_float(w << 16); }
__device__ __forceinline__ float bfhi(unsigned w) { return __uint_as_float(w & 0xffff0000u); }
__device__ __forceinline__ float bf1(bf16_t b) { return __uint_as_float(((unsigned)b) << 16); }
__device__ __forceinline__ float silu(float x) { return x * __builtin_amdgcn_rcpf(1.f + __builtin_amdgcn_exp2f(-1.4426950408889634f * x)); }
__device__ __forceinline__ bf16_t f2bf(float f) { return (bf16_t)(cvt_pk_bf16(f, 0.f) & 0xffffu); }
__device__ __forceinline__ float wave_sum(float v) {
#pragma unroll
    for (int o = 32; o >= 1; o >>= 1) v += __shfl_xor(v, o);
    return v;
}
__device__ __forceinline__ bf16x8 ld16(const bf16_t* p) { return *(const bf16x8*)p; }
__device__ __forceinline__ bf16x8 ld8x2(const bf16_t* p0, const bf16_t* p1) {
    const bf16x4 a = *(const bf16x4*)p0, b = *(const bf16x4*)p1;
    return __builtin_shufflevector(a, b, 0, 1, 2, 3, 4, 5, 6, 7);
}
#define GAS __attribute__((address_space(1)))
__device__ __forceinline__ bf16x8 ldg16(const bf16_t* p) { return *(const GAS bf16x8*)p; }
__device__ __forceinline__ bf16x8 ldg8x2(const bf16_t* p0, const bf16_t* p1) {
    const bf16x4 a = *(const GAS bf16x4*)p0, b = *(const GAS bf16x4*)p1;
    return __builtin_shufflevector(a, b, 0, 1, 2, 3, 4, 5, 6, 7);
}
__device__ __forceinline__ f32x16 mfma32(bf16x8 a, bf16x8 b, f32x16 c) { return __builtin_amdgcn_mfma_f32_32x32x16_bf16(a, b, c, 0, 0, 0); }

__device__ __forceinline__ void transpose_tiles(const Params& p, unsigned char* smem, const int l) {
    float* tile = (float*)smem + 3 * 2048 + 8 * 3 * 256;
    volatile int* slot = (volatile int*)(tile + 128 * 129);
    const int tid = my_tid();
    unsigned* qcnt = (unsigned*)(p.ws + OFF_BAR) + 3500 + l;
    const float* win = p.in[I_WIN] + (size_t)l * 2048 * 5120; const float* wout = p.in[I_WOUT] + (size_t)l * 2048 * 2048;
    bf16_t* wtin = (bf16_t*)(p.ws + OFF_WTIN) + (size_t)l * 5120 * 2048; bf16_t* wtout = (bf16_t*)(p.ws + OFF_WTOUT) + (size_t)l * 2048 * 2048;
    __syncthreads();
    if (tid == 0) *slot = (int)atomicAdd(qcnt, 1u);
    __syncthreads();
    int cur = *slot;
    const int rr = tid >> 5, c4 = (tid & 31) * 4, nn = tid >> 2, kq0 = tid & 3;
    while (cur < 896) {
        int nxt = 0;
        if (tid == 0) nxt = (int)atomicAdd(qcnt, 1u);
        const float* src; bf16_t* dst; int N, kt, nt;
        if (cur < 640) { kt = cur / 40; nt = cur % 40; N = 5120; src = win; dst = wtin; }
        else { const int r = cur - 640; kt = r >> 4; nt = r & 15; N = 2048; src = wout; dst = wtout; }
        const int k0 = kt * 128, n0 = nt * 128;
        f32x4 v[8];
#pragma unroll
        for (int i = 0; i < 8; ++i) v[i] = __builtin_nontemporal_load((const GAS f32x4*)(src + (size_t)(k0 + rr + 16 * i) * N + n0 + c4));
#pragma unroll
        for (int i = 0; i < 8; ++i) { float* tp = tile + (rr + 16 * i) * 129 + c4; tp[0] = v[i][0]; tp[1] = v[i][1]; tp[2] = v[i][2]; tp[3] = v[i][3]; }
        __syncthreads();
#pragma unroll
        for (int jj = 0; jj < 4; ++jj) {
            const int kq = kq0 + 4 * jj;
            float t[8];
#pragma unroll
            for (int e = 0; e < 8; ++e) t[e] = tile[(kq * 8 + e) * 129 + nn];
            u32x4 w; w.x = cvt_pk_bf16(t[0], t[1]); w.y = cvt_pk_bf16(t[2], t[3]); w.z = cvt_pk_bf16(t[4], t[5]); w.w = cvt_pk_bf16(t[6], t[7]);
            *(GAS u32x4*)(dst + (size_t)(n0 + nn) * 2048 + k0 + kq * 8) = w;
        }
        if (tid == 0) *slot = nxt;
        __syncthreads();
        cur = *slot;
    }
}

__device__ __forceinline__ void phase0(const Params& p, unsigned char* smem) {
    float* sc = (float*)smem;
    float* red = sc + 3 * 2048;
    const int tid = my_tid(), wave = tid >> 6, lane = tid & 63;
    for (int i = tid; i < 3 * 2048; i += 512) {
        const int ci = i >> 11, k = i & 2047;
        const float v = ci == 0 ? p.in[I_CCTX][k] : p.in[I_C][(ci - 1) * 2048 + k];
        sc[i] = silu(v);
    }
    __syncthreads();
    float* mod = (float*)(p.ws + OFF_MOD);
    for (int item = blockIdx.x; item < 192; item += gridDim.x) {
        const int l = item / 48, rem = item % 48, n0 = (rem >> 1) * 256, kh = rem & 1;
        const float* wp = p.in[I_WADA] + ((size_t)l * 2048 + kh * 1024 + wave * 128) * 6144 + n0 + lane * 4;
        const float* s0 = sc + kh * 1024 + wave * 128;
        f32x4 a0 = {0.f, 0.f, 0.f, 0.f}, a1 = a0, a2 = a0;
#pragma unroll 8
        for (int kk = 0; kk < 128; ++kk) {
            const f32x4 wv = __builtin_nontemporal_load((const GAS f32x4*)(wp + (size_t)kk * 6144));
            a0 += wv * s0[kk]; a1 += wv * s0[2048 + kk]; a2 += wv * s0[4096 + kk];
        }
        *(f32x4*)(red + (wave * 3 + 0) * 256 + lane * 4) = a0; *(f32x4*)(red + (wave * 3 + 1) * 256 + lane * 4) = a1; *(f32x4*)(red + (wave * 3 + 2) * 256 + lane * 4) = a2;
        __syncthreads();
        for (int o = tid; o < 768; o += 512) {
            const int ci = o >> 8, col = o & 255;
            float s_ = kh == 0 ? p.in[I_BADA][l * 6144 + n0 + col] : 0.f;
#pragma unroll
            for (int w = 0; w < 8; ++w) s_ += red[(w * 3 + ci) * 256 + col];
            atomicAdd(mod + (l * 3 + ci) * 6144 + n0 + col, s_);
        }
        __syncthreads();
    }
    const int lcv = gridDim.x == 256 ? 1 : 4;
#pragma unroll 1
    for (int l = 0; l < lcv; ++l) transpose_tiles(p, smem, l);
    const int gt = blockIdx.x * 512 + tid, NT = gridDim.x * 512;
    {
        bf16_t* o = (bf16_t*)(p.ws + OFF_POOLW);
        for (int idx = gt; idx < 2 * 4 * 256 * 256; idx += NT) {
            const int lg = idx >> 16, mt = (idx >> 13) & 7, s_ = (idx >> 9) & 15, ln = (idx >> 3) & 63, jj = idx & 7;
            const int d = mt * 32 + (ln & 31), c = s_ * 16 + (ln >> 5) * 8 + jj;
            o[idx] = f2bf(p.in[I_POOLW][(lg * 256 + c) * 256 + d]);
        }
    }
    {
        bf16_t* o = (bf16_t*)(p.ws + OFF_SGUW);
        for (int idx = gt; idx < 2 * 4 * 128 * 128; idx += NT) {
            const int lh = idx >> 14, nt = (idx >> 12) & 3, s_ = (idx >> 9) & 7, ln = (idx >> 3) & 63, jj = idx & 7;
            const int pp = nt * 32 + (ln & 31), qq = s_ * 16 + (ln >> 5) * 8 + jj;
            o[idx] = f2bf(p.in[I_SGUW][(lh * 128 + pp) * 128 + qq]);
        }
    }
    {
        bf16_t* o = (bf16_t*)(p.ws + OFF_CCS);
        for (int idx = gt; idx < 256 * 128; idx += NT) {
            const int nt_ = idx >> 12, s_ = (idx >> 9) & 7, ln = (idx >> 3) & 63, jj = idx & 7;
            const int R = nt_ * 32 + (ln & 31), c = s_ * 16 + (ln >> 5) * 8 + jj, cs = R >> 7, cp = R & 127; const float x = (float)((c * cp) & 127) * (1.f / 128.f);
            const float v = cs ? __builtin_amdgcn_sinf(x) : __builtin_amdgcn_cosf(x);
            o[idx] = f2bf(v * 0.08838834764831845f);
        }
    }
    {
        bf16_t* o = (bf16_t*)(p.ws + OFF_TW256);
        for (int idx = gt; idx < 256 * 512; idx += NT) {
            const int tp = idx >> 9, k = idx & 511, t = k & 255, isS = k >> 8; const float x = (float)((t * tp) & 255) * (1.f / 256.f);
            const float v = isS ? -__builtin_amdgcn_sinf(x) : __builtin_amdgcn_cosf(x);
            o[idx] = f2bf(v * 0.0625f);
        }
    }
    {
        unsigned* o = (unsigned*)(p.ws + OFF_TW2K);
        for (int idx = gt; idx < 2048 * 1024; idx += NT) {
            const int tp = idx >> 10, k = (idx & 1023) * 2, t = k & 1023, isS = k >> 10;
            const float x0 = (float)((t * tp) & 2047) * (1.f / 2048.f), x1 = (float)(((t + 1) * tp) & 2047) * (1.f / 2048.f);
            float v0 = isS ? -__builtin_amdgcn_sinf(x0) : __builtin_amdgcn_cosf(x0);
            const float v1 = isS ? -__builtin_amdgcn_sinf(x1) : __builtin_amdgcn_cosf(x1);
            if (k == 1024) v0 = (tp & 1) ? -1.f : 1.f;
            o[idx] = cvt_pk_bf16(v0 * 0.022097086912079608f, v1 * 0.022097086912079608f);
        }
    }
    {
        bf16_t* ok = (bf16_t*)(p.ws + OFF_CTXK); bf16_t* ov = (bf16_t*)(p.ws + OFF_CTXVT);
        for (int idx = gt; idx < 2 * 2 * 256 * 512; idx += NT) {
            ok[idx] = f2bf(p.in[I_CK][idx]);
            const int t = idx & 255, dim = (idx >> 8) & 127, kvh = (idx >> 15) & 3, bj = idx >> 17;
            ov[idx] = f2bf(p.in[I_CV][((bj * 256 + t) * 4 + kvh) * 128 + dim]);
        }
    }
}

__device__ __forceinline__ void phase_rows(const Params& p, const int l, LAS unsigned char* lds) {
    const int tid = my_tid(), wave = tid >> 6, lane = tid & 63;
    const float* mod = (const float*)(p.ws + OFF_MOD);
    const bf16_t* ybuf = (const bf16_t*)(p.ws + OFF_Y);
    bf16_t* hbuf = (bf16_t*)(p.ws + OFF_H);
    LAS float* vl = (LAS float*)lds;
    {
        const int l1 = l + 1;
        for (int i = tid; i < 11 * 512; i += 512) {
            const int vsel = i >> 9, c4 = (i & 511) * 4;
            const float* src = nullptr;
            if (vsel < 3) { if (l >= 0) src = mod + (l * 3 + vsel) * 6144 + 4096; }
            else if (vsel == 3) { if (l >= 0) src = p.in[I_NPOST] + l * 2048; }
            else if (vsel < 7) { if (l < 3) src = mod + (l1 * 3 + (vsel - 4)) * 6144; }
            else if (vsel < 10) { if (l < 3) src = mod + (l1 * 3 + (vsel - 7)) * 6144 + 2048; }
            else { if (l < 3) src = p.in[I_NPRE] + l1 * 2048; }
            if (src) *(LAS f32x4*)(vl + vsel * 2048 + c4) = *(const GAS f32x4*)(src + c4);
        }
        __syncthreads();
    }
    for (int row = blockIdx.x * 8 + wave; row < MROWS; row += gridDim.x * 8) {
        const int ci = row < NPROMPT ? 0 : 1 + ((row - NPROMPT) >> 11);
        bf16_t* xb = (bf16_t*)(p.ws + OFF_XB) + (size_t)row * DM;
        f32x4 x[8];
        if (l <= 0) {
            const float* xs = row < NPROMPT ? p.in[I_XP] + (size_t)row * DM : p.in[I_XS] + (size_t)(row - NPROMPT) * DM;
#pragma unroll
            for (int i = 0; i < 8; ++i) x[i] = __builtin_nontemporal_load((const GAS f32x4*)(xs + i * 256 + lane * 4));
        } else {
#pragma unroll
            for (int i = 0; i < 8; ++i) { const u32x2 xw = __builtin_nontemporal_load((const GAS u32x2*)(xb + i * 256 + lane * 4)); x[i][0] = bflo(xw.x); x[i][1] = bfhi(xw.x); x[i][2] = bflo(xw.y); x[i][3] = bfhi(xw.y); }
        }
        if (l >= 0) {
            f32x4 y[8]; float ss = 0.f;
#pragma unroll
            for (int i = 0; i < 8; ++i) { const u32x2 yw = __builtin_nontemporal_load((const GAS u32x2*)(ybuf + (size_t)row * DM + i * 256 + lane * 4)); y[i][0] = bflo(yw.x); y[i][1] = bfhi(yw.x); y[i][2] = bflo(yw.y); y[i][3] = bfhi(yw.y); ss += y[i][0] * y[i][0] + y[i][1] * y[i][1] + y[i][2] * y[i][2] + y[i][3] * y[i][3]; }
            ss = wave_sum(ss);
            const float r = rsqrtf(ss * (1.f / 2048.f) + 1e-6f);
            const LAS float* gate = vl + ci * 2048; const LAS float* np = vl + 3 * 2048;
#pragma unroll
            for (int i = 0; i < 8; ++i) {
                const f32x4 g = *(const LAS f32x4*)(gate + i * 256 + lane * 4), w = *(const LAS f32x4*)(np + i * 256 + lane * 4);
#pragma unroll
                for (int e = 0; e < 4; ++e) x[i][e] += g[e] * (y[i][e] * r * w[e]);
                if (l == 3) *(GAS f32x4*)(p.out + (size_t)row * DM + i * 256 + lane * 4) = x[i];
                else { u32x2 xo; xo.x = cvt_pk_bf16(x[i][0], x[i][1]); xo.y = cvt_pk_bf16(x[i][2], x[i][3]); *(GAS u32x2*)(xb + i * 256 + lane * 4) = xo; }
            }
        }
        if (l < 3) {
            const int l1 = l + 1;
            float ss = 0.f;
#pragma unroll
            for (int i = 0; i < 8; ++i) ss += x[i][0] * x[i][0] + x[i][1] * x[i][1] + x[i][2] * x[i][2] + x[i][3] * x[i][3];
            ss = wave_sum(ss);
            const float r = rsqrtf(ss * (1.f / 2048.f) + 1e-6f);
            const LAS float* shift = vl + (4 + ci) * 2048; const LAS float* scale = vl + (7 + ci) * 2048; const LAS float* np = vl + 10 * 2048;
#pragma unroll
            for (int i = 0; i < 8; ++i) {
                const f32x4 sh = *(const LAS f32x4*)(shift + i * 256 + lane * 4), sl = *(const LAS f32x4*)(scale + i * 256 + lane * 4), w = *(const LAS f32x4*)(np + i * 256 + lane * 4);
                float hv[4];
#pragma unroll
                for (int e = 0; e < 4; ++e) hv[e] = (x[i][e] * r * w[e]) * (1.f + sl[e]) + sh[e];
                u32x2 o; o.x = cvt_pk_bf16(hv[0], hv[1]); o.y = cvt_pk_bf16(hv[2], hv[3]);
                *(u32x2*)(hbuf + (size_t)row * DM + i * 256 + lane * 4) = o;
            }
        }
    }
}

struct EpiProj {
    static constexpr bool PERM = true, AFTER_DRAIN = false;
    bf16_t* O; float* outk; float* outv; int even, j;
    __device__ __forceinline__ void operator()(const f32x4 (&acc)[2][2][4][2], const pg8::Unit& u, int wr, int wc, int fr, int fq) const {
        asm volatile("" : "+v"(fr), "+v"(fq));
        const int rloc0 = wr * 64 + fr, col0 = u.pn * 256 + wc * 32 + 8 * fq;
        const bool kv = even && u.pm < 32 && u.pn >= 6 && u.pn < 10;
        float* cbase = nullptr;
        if (kv) cbase = (u.pn < 8 ? outk : outv) + ((size_t)(u.pm * 2 + j) * 256) * 512 + ((u.pn & 1) * 256 + wc * 32 + 8 * fq);
#pragma unroll
        for (int ai = 0; ai < 2; ++ai)
#pragma unroll
            for (int m = 0; m < 4; ++m) {
                const int rloc = rloc0 + ai * 128 + m * 16;
                bf16_t* rowp = O + (size_t)(u.pm * 256 + rloc) * INW + col0;
#pragma unroll
                for (int bj = 0; bj < 2; ++bj) {
                    const f32x4 v0 = acc[ai][bj][m][0], v1 = acc[ai][bj][m][1];
                    u32x4 w; w.x = cvt_pk_bf16(v0[0], v0[1]); w.y = cvt_pk_bf16(v0[2], v0[3]); w.z = cvt_pk_bf16(v1[0], v1[1]); w.w = cvt_pk_bf16(v1[2], v1[3]);
                    *(u32x4*)(rowp + bj * 128) = w;
                    if (kv) { float* cp = cbase + (size_t)rloc * 512 + bj * 128; *(f32x4*)cp = v0; *(f32x4*)(cp + 4) = v1; }
                    __builtin_amdgcn_sched_barrier(0);
                }
            }
    }
};
struct EpiY {
    static constexpr bool PERM = true, AFTER_DRAIN = false;
    bf16_t* C;
    __device__ __forceinline__ void operator()(const f32x4 (&acc)[2][2][4][2], const pg8::Unit& u, int wr, int wc, int fr, int fq) const {
        asm volatile("" : "+v"(fr), "+v"(fq));
        const int row0 = u.pm * 256 + wr * 64 + fr, col0 = u.pn * 256 + wc * 32 + 8 * fq;
#pragma unroll
        for (int ai = 0; ai < 2; ++ai)
#pragma unroll
            for (int m = 0; m < 4; ++m) {
                bf16_t* rowp = C + (size_t)(row0 + ai * 128 + m * 16) * DM + col0;
#pragma unroll
                for (int bj = 0; bj < 2; ++bj) {
                    const f32x4 v0 = acc[ai][bj][m][0], v1 = acc[ai][bj][m][1];
                    u32x4 w; w.x = cvt_pk_bf16(v0[0], v0[1]); w.y = cvt_pk_bf16(v0[2], v0[3]); w.z = cvt_pk_bf16(v1[0], v1[1]); w.w = cvt_pk_bf16(v1[2], v1[3]);
                    *(u32x4*)(rowp + bj * 128) = w;
                }
            }
    }
};
struct EpiFnet {
    static constexpr bool PERM = true, AFTER_DRAIN = false;
    const bf16_t* proj; bf16_t* O; int rowbase0, T; const float* yh;
    __device__ __forceinline__ void operator()(const f32x4 (&acc)[2][2][4][2], const pg8::Unit& u, int wr, int wc, int fr, int fq) const {
        asm volatile("" : "+v"(fr), "+v"(fq));
        const int row0 = rowbase0 + (u.pn >> 1) * T + u.pm * 256 + wr * 64 + fr, col0 = (u.pn & 1) * 256 + wc * 32 + 8 * fq;
#pragma unroll
        for (int ai = 0; ai < 2; ++ai)
#pragma unroll
            for (int m = 0; m < 4; ++m) {
                const size_t row = (size_t)(row0 + ai * 128 + m * 16);
#pragma unroll
                for (int bj = 0; bj < 2; ++bj) {
                    const u32x4 g = *(const u32x4*)(proj + row * INW + 4608 + col0 + bj * 128);
                    f32x4 v0 = acc[ai][bj][m][0], v1 = acc[ai][bj][m][1];
                    if (yh) { const float sg = (fr & 1) ? -0.022097086912079608f : 0.022097086912079608f; const float* yp = yh + (u.pn >> 1) * 512 + col0 + bj * 128;
                        const f32x4 y0 = *(const GAS f32x4*)yp, y1 = *(const GAS f32x4*)(yp + 4); v0 += y0 * sg; v1 += y1 * sg; }
                    u32x4 w;
                    w.x = cvt_pk_bf16(v0[0] * silu(bflo(g.x)), v0[1] * silu(bfhi(g.x))); w.y = cvt_pk_bf16(v0[2] * silu(bflo(g.y)), v0[3] * silu(bfhi(g.y)));
                    w.z = cvt_pk_bf16(v1[0] * silu(bflo(g.z)), v1[1] * silu(bfhi(g.z))); w.w = cvt_pk_bf16(v1[2] * silu(bflo(g.w)), v1[3] * silu(bfhi(g.w)));
                    *(u32x4*)(O + row * DM + 1536 + col0 + bj * 128) = w;
                    __builtin_amdgcn_sched_barrier(0);
                }
            }
    }
};

__device__ __forceinline__ void phase_even_prep(const Params& p, const int lj, LAS unsigned char* lds) {
    const int tid = my_tid(), wave = tid >> 6, lane = tid & 63, l32 = lane & 31, h = lane >> 5;
    bf16_t* proj = (bf16_t*)(p.ws + OFF_PROJ);
    const bf16_t* ccs = (const bf16_t*)(p.ws + OFF_CCS);
    if ((int)blockIdx.x * 8 < 1024 || (int)(gridDim.x * 8 - 1) - ((int)blockIdx.x * 8 + 7) < 256) {
#pragma unroll
        for (int i = 0; i < 8; ++i) { const int idx = tid + 512 * i; *(LAS u32x4*)(lds + idx * 16) = *(const GAS u32x4*)(ccs + idx * 8); }
        __syncthreads();
    }
    for (int task = blockIdx.x * 8 + wave; task < 256 * 4; task += gridDim.x * 8) {
        const int rb = task >> 2, g = task & 3, row0 = rb * 32;
        bf16x8 af[8];
        const bf16_t* ap = proj + (size_t)(row0 + l32) * INW + 4096 + g * 128 + 8 * h;
#pragma unroll
        for (int s = 0; s < 8; ++s) af[s] = ld16(ap + 16 * s);
        bf16_t* yt; int T, tl0;
        if (row0 < NPROMPT) { T = 256; tl0 = row0 & 255; yt = (bf16_t*)(p.ws + OFF_YTP) + (size_t)(row0 >> 8) * 512 * 512; }
        else { T = 2048; tl0 = (row0 - NPROMPT) & 2047; yt = (bf16_t*)(p.ws + OFF_YTS) + (size_t)((row0 - NPROMPT) >> 11) * 512 * 4096; }
#pragma unroll 1
        for (int nt = 0; nt < 8; ++nt) {
            const int R = nt * 32 + l32;
            const LAS unsigned char* bp = lds + nt * 8192 + lane * 16;
            f32x16 acc;
#pragma unroll
            for (int r = 0; r < 16; ++r) acc[r] = 0.f;
#pragma unroll
            for (int s = 0; s < 8; ++s) acc = mfma32(af[s], *(const LAS bf16x8*)(bp + 1024 * s), acc);
            const int cs = R >> 7, cp = R & 127;
            bf16_t* dst = yt + (size_t)(g * 128 + cp) * (2 * T) + cs * T + tl0 + 4 * h;
#pragma unroll
            for (int q = 0; q < 4; ++q) {
                u32x2 w; w.x = cvt_pk_bf16(acc[4 * q], acc[4 * q + 1]); w.y = cvt_pk_bf16(acc[4 * q + 2], acc[4 * q + 3]);
                *(u32x2*)(dst + 8 * q) = w;
            }
        }
    }
    for (int task = (gridDim.x * 8 - 1) - (blockIdx.x * 8 + wave); task < 256; task += gridDim.x * 8) {
        const int g = task & 3, kb = (task >> 2) & 31, b = task >> 7;
        const int t = kb * 32 + l32, tp = (t == 0) ? 0 : 2048 - t;
        const bf16_t* xa = proj + (size_t)(NPROMPT + b * 2048 + t) * INW + 4096 + g * 128 + 8 * h;
        const bf16_t* ya = proj + (size_t)(NPROMPT + b * 2048 + tp) * INW + 4096 + g * 128 + 8 * h;
        bf16x8 ae[8], ao[8];
#pragma unroll
        for (int s = 0; s < 8; ++s) {
            const u32x4 x = *(const GAS u32x4*)(xa + 16 * s), y = *(const GAS u32x4*)(ya + 16 * s);
            u32x4 e, o;
#pragma unroll
            for (int q = 0; q < 4; ++q) {
                const unsigned xw = q == 0 ? x.x : q == 1 ? x.y : q == 2 ? x.z : x.w, yw = q == 0 ? y.x : q == 1 ? y.y : q == 2 ? y.z : y.w;
                const float x0 = bflo(xw), x1 = bfhi(xw), y0 = bflo(yw), y1 = bfhi(yw);
                const unsigned ew = (t == 0) ? xw : cvt_pk_bf16(x0 + y0, x1 + y1), ow = (t == 0) ? 0u : cvt_pk_bf16(x0 - y0, x1 - y1);
                if (q == 0) { e.x = ew; o.x = ow; } else if (q == 1) { e.y = ew; o.y = ow; } else if (q == 2) { e.z = ew; o.z = ow; } else { e.w = ew; o.w = ow; }
            }
            ae[s] = __builtin_bit_cast(bf16x8, e); ao[s] = __builtin_bit_cast(bf16x8, o);
        }
        bf16_t* yt = (bf16_t*)(p.ws + OFF_YTS) + (size_t)(lj * 2 + b) * 512 * 2048;
#pragma unroll 1
        for (int nt = 0; nt < 4; ++nt) {
            const LAS unsigned char* bp = lds + nt * 8192 + lane * 16;
            f32x16 acc;
#pragma unroll
            for (int r = 0; r < 16; ++r) acc[r] = 0.f;
#pragma unroll
            for (int s = 0; s < 8; ++s) acc = mfma32(ae[s], *(const LAS bf16x8*)(bp + 1024 * s), acc);
            bf16_t* dst = yt + (size_t)(g * 128 + nt * 32 + l32) * 2048 + kb * 32 + 4 * h;
#pragma unroll
            for (int q = 0; q < 4; ++q) { u32x2 w; w.x = cvt_pk_bf16(acc[4 * q], acc[4 * q + 1]); w.y = cvt_pk_bf16(acc[4 * q + 2], acc[4 * q + 3]); *(GAS u32x2*)(dst + 8 * q) = w; }
        }
#pragma unroll 1
        for (int nt = 0; nt < 4; ++nt) {
            const LAS unsigned char* bp = lds + (nt + 4) * 8192 + lane * 16;
            f32x16 acc;
#pragma unroll
            for (int r = 0; r < 16; ++r) acc[r] = 0.f;
#pragma unroll
            for (int s = 0; s < 8; ++s) acc = mfma32(ao[s], *(const LAS bf16x8*)(bp + 1024 * s), acc);
            bf16_t* dst = yt + (size_t)(g * 128 + nt * 32 + l32) * 2048 + 1024 + kb * 32 + 4 * h;
#pragma unroll
            for (int q = 0; q < 4; ++q) { u32x2 w; w.x = cvt_pk_bf16(acc[4 * q], acc[4 * q + 1]); w.y = cvt_pk_bf16(acc[4 * q + 2], acc[4 * q + 3]); *(GAS u32x2*)(dst + 8 * q) = w; }
        }
    }
    const int gt = blockIdx.x * 512 + tid, NT = gridDim.x * 512;
    for (int idx = gt; idx < 1024; idx += NT) {
        const int b = idx >> 9, n = idx & 511, g = n >> 7, cp = n & 127;
        const bf16_t* up = proj + (size_t)(NPROMPT + b * 2048 + 1024) * INW + 4096 + g * 128;
        float a = 0.f;
        u32x4 uv[16];
#pragma unroll
        for (int i = 0; i < 16; ++i) uv[i] = *(const GAS u32x4*)(up + 8 * i);
#pragma unroll
        for (int i = 0; i < 16; ++i)
#pragma unroll
            for (int e = 0; e < 4; ++e) {
                const unsigned w = e == 0 ? uv[i].x : e == 1 ? uv[i].y : e == 2 ? uv[i].z : uv[i].w; const int c = i * 8 + e * 2;
                a += bflo(w) * __builtin_amdgcn_cosf((float)((c * cp) & 127) * (1.f / 128.f)) + bfhi(w) * __builtin_amdgcn_cosf((float)(((c + 1) * cp) & 127) * (1.f / 128.f));
            }
        ((float*)(p.ws + OFF_YH))[lj * 1024 + idx] = a * 0.08838834764831845f;
    }
    for (int idx = gt; idx < 4096 * 16 * 2 * 4; idx += NT) {
        const int ib = idx & 3, a = (idx >> 2) & 1, head = (idx >> 3) & 15, rs = idx >> 7;
        const int t = rs & 2047; const float pos = (float)(a == 0 ? (t >> 6) : (t & 63));
        bf16_t* x1p = proj + (size_t)(NPROMPT + rs) * INW + head * 128 + a * 64 + ib * 8;
        const u32x4 x1 = *(const u32x4*)x1p, x2 = *(const u32x4*)(x1p + 32);
        u32x4 o1, o2;
#pragma unroll
        for (int e = 0; e < 4; ++e) {
            const unsigned w1 = e == 0 ? x1.x : e == 1 ? x1.y : e == 2 ? x1.z : x1.w, w2 = e == 0 ? x2.x : e == 1 ? x2.y : e == 2 ? x2.z : x2.w;
            float r1[2], r2[2];
#pragma unroll
            for (int q = 0; q < 2; ++q) {
                const int i = ib * 8 + e * 2 + q;
                const float inv = __builtin_amdgcn_exp2f(-(float)i * (13.287712379549449f / 32.f));
                const float rev = pos * inv * 0.15915494309189535f;
                const float cc = __builtin_amdgcn_cosf(rev), sn = __builtin_amdgcn_sinf(rev);
                const float a1 = q ? bfhi(w1) : bflo(w1), a2 = q ? bfhi(w2) : bflo(w2);
                r1[q] = a1 * cc - a2 * sn; r2[q] = a2 * cc + a1 * sn;
            }
            const unsigned p1 = cvt_pk_bf16(r1[0], r1[1]), p2 = cvt_pk_bf16(r2[0], r2[1]);
            if (e == 0) { o1.x = p1; o2.x = p2; } else if (e == 1) { o1.y = p1; o2.y = p2; } else if (e == 2) { o1.z = p1; o2.z = p2; } else { o1.w = p1; o2.w = p2; }
        }
        *(u32x4*)x1p = o1; *(u32x4*)(x1p + 32) = o2;
    }
    bf16_t* vt = (bf16_t*)(p.ws + OFF_VT);
    for (int idx = gt; idx < 1536 * 512; idx += NT) {
        const int cd = idx & 511, r8 = idx >> 9, row0 = r8 * 8;
        int rowbase, T;
        if (row0 < NPROMPT) { rowbase = row0 & ~255; T = 256; } else { rowbase = NPROMPT + ((row0 - NPROMPT) & ~2047); T = 2048; }
        const bf16_t* src = proj + (size_t)row0 * INW + 2048 + cd;
        unsigned short v[8];
#pragma unroll
        for (int j = 0; j < 8; ++j) v[j] = src[(size_t)j * INW];
        u32x4 w; w.x = v[0] | ((unsigned)v[1] << 16); w.y = v[2] | ((unsigned)v[3] << 16); w.z = v[4] | ((unsigned)v[5] << 16); w.w = v[6] | ((unsigned)v[7] << 16);
        *(u32x4*)(vt + (size_t)rowbase * 512 + (size_t)cd * T + (row0 - rowbase)) = w;
    }
}

constexpr int AT_KROW = 272, AT_VROW = 136, AT_KBYTES = 64 * AT_KROW, AT_BUF = AT_KBYTES + 128 * AT_VROW;
__device__ __forceinline__ void attn_item(const Params& p, const int item, const int j, LAS unsigned char* lds) {
    const int tid = my_tid(), wave = __builtin_amdgcn_readfirstlane(tid >> 6), lane = tid & 63, l32 = lane & 31, h = lane >> 5;
    int rowbase, T, qh, bs = -1, q0c = 0;
    if (item < 192) { bs = item / 96; const int rem = item % 96; qh = rem >> 3; q0c = (rem & 7) * 256; rowbase = NPROMPT + bs * 2048; T = 2048; }
    else { const int pi = item - 192; rowbase = (pi / 12) * 256; qh = pi % 12; T = 256; }
    const int kvh = qh / 3, q0 = q0c + wave * 32;
    const bf16_t* proj = (const bf16_t*)(p.ws + OFF_PROJ);
    bf16x8 qf[8];
    {
        const bf16_t* qp = proj + (size_t)(rowbase + q0 + l32) * INW + qh * 128 + 8 * h;
#pragma unroll
        for (int s = 0; s < 8; ++s) qf[s] = ldg16(qp + 16 * s);
    }
    float m = p.in[I_SINK][j * 12 + qh] * LOG2E, lsum = (h == 0) ? 1.f : 0.f;
    f32x16 oacc[4];
#pragma unroll
    for (int dt = 0; dt < 4; ++dt)
#pragma unroll
        for (int r = 0; r < 16; ++r) oacc[dt][r] = 0.f;
    int kl0 = 0, kl1 = 256, nctx = 0;
    if (bs >= 0) { kl0 = max(0, q0c - 128); kl1 = min(T, q0c + 384); nctx = 4; }
    const int nlc = (kl1 - kl0) >> 6, nch = nlc + nctx;
    const bf16_t* kg = proj + (size_t)rowbase * INW + 1536 + kvh * 128;
    const bf16_t* vg = (const bf16_t*)(p.ws + OFF_VT) + (size_t)rowbase * 512 + (size_t)(kvh * 128) * T;
    const bf16_t* ckg = (const bf16_t*)(p.ws + OFF_CTXK) + (size_t)((max(bs, 0) * 2 + j) * 256) * 512 + kvh * 128;
    const bf16_t* cvg = (const bf16_t*)(p.ws + OFF_CTXVT) + (size_t)(((max(bs, 0) * 2 + j) * 4 + kvh) * 128) * 256;
    const int krow = tid >> 4, kc16 = tid & 15, vrow = tid >> 3, vc16 = tid & 7;
    u32x4 skA[2], svA[2], skB[2], svB[2];
    auto stage_load = [&](const int ci, u32x4 (&sk)[2], u32x4 (&sv)[2]) {
        const bf16_t* kb; const bf16_t* vb; size_t kst, vst;
        if (ci < nlc) { const int ks = kl0 + 64 * ci; kb = kg + (size_t)ks * INW; kst = INW; vb = vg + ks; vst = (size_t)T; }
        else { const int ks = 64 * (ci - nlc); kb = ckg + (size_t)ks * 512; kst = 512; vb = cvg + ks; vst = 256; }
#pragma unroll
        for (int i = 0; i < 2; ++i) {
            sk[i] = *(const GAS u32x4*)(kb + (size_t)(krow + 32 * i) * kst + kc16 * 8);
            sv[i] = *(const GAS u32x4*)(vb + (size_t)(vrow + 64 * i) * vst + vc16 * 8);
        }
    };
    auto stage_store = [&](const int b, const u32x4 (&sk)[2], const u32x4 (&sv)[2]) {
        LAS unsigned char* base = lds + b * AT_BUF;
#pragma unroll
        for (int i = 0; i < 2; ++i) {
            *(LAS u32x4*)(base + (krow + 32 * i) * AT_KROW + kc16 * 16) = sk[i];
            LAS unsigned char* vd = base + AT_KBYTES + (vrow + 64 * i) * AT_VROW + vc16 * 16;
            u32x2 lo, hi; lo.x = sv[i].x; lo.y = sv[i].y; hi.x = sv[i].z; hi.y = sv[i].w;
            *(LAS u32x2*)vd = lo; *(LAS u32x2*)(vd + 8) = hi;
        }
    };
    constexpr float sc = 0.08838834764831845f * LOG2E;
    __syncthreads();
    stage_load(0, skA, svA); stage_store(0, skA, svA);
    if (nch > 1) stage_load(1, skA, svA);
    __syncthreads();
    auto chunk_step = [&](const int ci, u32x4 (&skc)[2], u32x4 (&svc)[2], u32x4 (&skn)[2], u32x4 (&svn)[2]) {
        if (ci + 2 < nch) stage_load(ci + 2, skn, svn);
        const LAS unsigned char* kbuf = lds + (ci & 1) * AT_BUF;
        const LAS unsigned char* vbuf = kbuf + AT_KBYTES;
        const bool local = ci < nlc;
        const int kc0 = kl0 + 64 * ci;
#pragma unroll 1
        for (int tt = 0; tt < 2; ++tt) {
            const int kt = kc0 + 32 * tt;
            bool masked = false;
            if (local && bs >= 0) { const int d = kt - (q0 - 128); if (d < 0 || d > 256) continue; masked = (d == 0 || d == 256); }
            bf16x8 kf[8];
            const LAS unsigned char* kp = kbuf + (tt * 32 + l32) * AT_KROW + 16 * h;
#pragma unroll
            for (int ks = 0; ks < 8; ++ks) kf[ks] = *(const LAS bf16x8*)(kp + 32 * ks);
            f32x16 s;
#pragma unroll
            for (int r = 0; r < 16; ++r) s[r] = 0.f;
#pragma unroll
            for (int ks = 0; ks < 8; ++ks) s = mfma32(kf[ks], qf[ks], s);
            bf16x8 vf[8];
            const LAS unsigned char* vp = vbuf + l32 * AT_VROW + (tt * 32 + 4 * h) * 2;
#pragma unroll
            for (int dt = 0; dt < 4; ++dt)
#pragma unroll
                for (int c = 0; c < 2; ++c) {
                    const bf16x4 a = *(const LAS bf16x4*)(vp + dt * 32 * AT_VROW + c * 32), b = *(const LAS bf16x4*)(vp + dt * 32 * AT_VROW + c * 32 + 16);
                    vf[dt * 2 + c] = __builtin_shufflevector(a, b, 0, 1, 2, 3, 4, 5, 6, 7);
                }
            float tmax = -3.0e38f;
            if (masked) {
                const int dqk = (q0 + l32) - kt - 4 * h;
#pragma unroll
                for (int r = 0; r < 16; ++r) { const int d = dqk - (8 * (r >> 2) + (r & 3)); if (d > 128 || d < -128) s[r] = -1.0e30f; tmax = fmaxf(tmax, s[r]); }
            } else {
#pragma unroll
                for (int r = 0; r < 16; ++r) tmax = fmaxf(tmax, s[r]);
            }
            { const auto rr = __builtin_amdgcn_permlane32_swap(__float_as_uint(tmax), __float_as_uint(tmax), false, false);
              tmax = fmaxf(__uint_as_float(rr[0]), __uint_as_float(rr[1])) * sc; }
            if (!__all(tmax - m <= 8.0f)) {
                const float mn = fmaxf(m, tmax), alpha = __builtin_amdgcn_exp2f(m - mn);
                m = mn; lsum *= alpha;
#pragma unroll
                for (int dt = 0; dt < 4; ++dt)
#pragma unroll
                    for (int r = 0; r < 16; ++r) oacc[dt][r] *= alpha;
            }
            float ps = 0.f;
#pragma unroll
            for (int r = 0; r < 16; ++r) { s[r] = __builtin_amdgcn_exp2f(__builtin_fmaf(s[r], sc, -m)); ps += s[r]; }
            lsum += ps;
            bf16x8 pb[2];
#pragma unroll
            for (int c = 0; c < 2; ++c) {
                u32x4 w; w.x = cvt_pk_bf16(s[8 * c + 0], s[8 * c + 1]); w.y = cvt_pk_bf16(s[8 * c + 2], s[8 * c + 3]); w.z = cvt_pk_bf16(s[8 * c + 4], s[8 * c + 5]); w.w = cvt_pk_bf16(s[8 * c + 6], s[8 * c + 7]);
                pb[c] = __builtin_bit_cast(bf16x8, w);
            }
#pragma unroll
            for (int dt = 0; dt < 4; ++dt)
#pragma unroll
                for (int c = 0; c < 2; ++c) oacc[dt] = mfma32(vf[dt * 2 + c], pb[c], oacc[dt]);
        }
        if (ci + 1 < nch) stage_store((ci + 1) & 1, skc, svc);
        __syncthreads();
    };
#pragma unroll 1
    for (int ci = 0; ci < nch; ci += 2) {
        chunk_step(ci, skA, svA, skB, svB);
        if (ci + 1 < nch) chunk_step(ci + 1, skB, svB, skA, svA);
    }
    const float lt = lsum + __shfl_xor(lsum, 32), inv = 1.f / lt;
    const size_t row = (size_t)(rowbase + q0 + l32);
    const bf16_t* gp = proj + row * INW + 2560 + qh * 128 + 4 * h;
    bf16_t* op = (bf16_t*)(p.ws + OFF_O) + row * DM + qh * 128 + 4 * h;
#pragma unroll
    for (int dt = 0; dt < 4; ++dt)
#pragma unroll
        for (int g4 = 0; g4 < 4; ++g4) {
            const u32x2 g = *(const GAS u32x2*)(gp + 32 * dt + 8 * g4);
            u32x2 w;
            w.x = cvt_pk_bf16(oacc[dt][4 * g4 + 0] * inv * silu(bflo(g.x)), oacc[dt][4 * g4 + 1] * inv * silu(bfhi(g.x)));
            w.y = cvt_pk_bf16(oacc[dt][4 * g4 + 2] * inv * silu(bflo(g.y)), oacc[dt][4 * g4 + 3] * inv * silu(bfhi(g.y)));
            *(GAS u32x2*)(op + 32 * dt + 8 * g4) = w;
        }
}

constexpr int PL_PITCH = 528;
constexpr int PL_POOLED = 80 * 528;
template <int HW>
__device__ __forceinline__ void pool_body(const Params& p, const int lj, const int g, const int row0, const int rowbase, const int T, LAS unsigned char* lds,
                                          const int tid, const int wave, const int lane, const int l32, const int h) {
    const bf16_t* proj = (const bf16_t*)(p.ws + OFF_PROJ);
    const int tl0 = row0 - rowbase;
    constexpr int NR = 64 + 2 * HW;
    bf16x8 afr[2][16];
    {
        const bf16_t* wt_ = (const bf16_t*)(p.ws + OFF_POOLW) + (size_t)((lj * 4 + g) * 8 + 2 * (wave >> 1)) * 8192 + lane * 8;
#pragma unroll
        for (int s = 0; s < 16; ++s) { afr[0][s] = ldg16(wt_ + 512 * s); afr[1][s] = ldg16(wt_ + 8192 + 512 * s); }
    }
    if (tid < 64) *(LAS f32x4*)(lds + 77824 + tid * 16) = *(const GAS f32x4*)(p.in[I_POOLS] + lj * 1024 + g * 256 + tid * 4);
    for (int idx = tid; idx < NR * 32; idx += 512) {
        const int r = idx >> 5, c16 = idx & 31, tt = tl0 - HW + r;
        u32x4 v; v.x = 0u; v.y = 0u; v.z = 0u; v.w = 0u;
        if (tt >= 0 && tt < T) v = *(const GAS u32x4*)(proj + (size_t)(rowbase + tt) * INW + g * 256 + c16 * 8);
        *(LAS u32x4*)(lds + r * PL_PITCH + c16 * 16) = v;
    }
    __syncthreads();
    const int ts = wave & 1, mp = wave >> 1;
    {
        const int tl = tl0 + ts * 32 + l32;
        const float rc = 1.f / (float)(min(tl + HW, T) - max(tl - HW, 0));
        const LAS unsigned char* sp = lds + (ts * 32 + l32) * PL_PITCH + 16 * h;
        LAS unsigned char* pp = lds + PL_POOLED + (ts * 32 + l32) * PL_PITCH + 16 * h;
#pragma unroll 1
        for (int s4 = 0; s4 < 4; ++s4) {
            const int s = mp * 4 + s4;
            float sum[8];
#pragma unroll
            for (int e = 0; e < 8; ++e) sum[e] = 0.f;
#pragma unroll
            for (int d = 0; d < 2 * HW; ++d) {
                const u32x4 v = *(const LAS u32x4*)(sp + d * PL_PITCH + 32 * s);
                sum[0] += bflo(v.x); sum[1] += bfhi(v.x); sum[2] += bflo(v.y); sum[3] += bfhi(v.y);
                sum[4] += bflo(v.z); sum[5] += bfhi(v.z); sum[6] += bflo(v.w); sum[7] += bfhi(v.w);
            }
            const u32x4 sv = *(const LAS u32x4*)(sp + HW * PL_PITCH + 32 * s);
            u32x4 w;
            w.x = cvt_pk_bf16(sum[0] * rc - bflo(sv.x), sum[1] * rc - bfhi(sv.x)); w.y = cvt_pk_bf16(sum[2] * rc - bflo(sv.y), sum[3] * rc - bfhi(sv.y));
            w.z = cvt_pk_bf16(sum[4] * rc - bflo(sv.z), sum[5] * rc - bfhi(sv.z)); w.w = cvt_pk_bf16(sum[6] * rc - bflo(sv.w), sum[7] * rc - bfhi(sv.w));
            *(LAS u32x4*)(pp + 32 * s) = w;
        }
    }
    __syncthreads();
    const LAS unsigned char* bp_ = lds + PL_POOLED + (ts * 32 + l32) * PL_PITCH + 16 * h;
    f32x16 acc[2];
#pragma unroll
    for (int m2 = 0; m2 < 2; ++m2)
#pragma unroll
        for (int r = 0; r < 16; ++r) acc[m2][r] = 0.f;
#pragma unroll
    for (int s = 0; s < 16; ++s) {
        const bf16x8 bfr = *(const LAS bf16x8*)(bp_ + 32 * s);
        acc[0] = mfma32(afr[0][s], bfr, acc[0]); acc[1] = mfma32(afr[1][s], bfr, acc[1]);
    }
    const int row = row0 + ts * 32 + l32;
    const LAS float* psc = (const LAS float*)(lds + 77824) + 4 * h;
    const bf16_t* gp = proj + (size_t)row * INW + 1024 + g * 256 + 4 * h;
    bf16_t* op = (bf16_t*)(p.ws + OFF_O) + (size_t)row * DM + g * 256 + 4 * h;
#pragma unroll
    for (int m2 = 0; m2 < 2; ++m2)
#pragma unroll
        for (int g4 = 0; g4 < 4; ++g4) {
            const int c0 = (2 * mp + m2) * 32 + 8 * g4;
            const u32x2 gg = *(const GAS u32x2*)(gp + c0);
            const f32x4 ps = *(const LAS f32x4*)(psc + c0);
            u32x2 w;
            w.x = cvt_pk_bf16(acc[m2][4 * g4 + 0] * ps[0] * silu(bflo(gg.x)), acc[m2][4 * g4 + 1] * ps[1] * silu(bfhi(gg.x)));
            w.y = cvt_pk_bf16(acc[m2][4 * g4 + 2] * ps[2] * silu(bflo(gg.y)), acc[m2][4 * g4 + 3] * ps[3] * silu(bfhi(gg.y)));
            *(GAS u32x2*)(op + c0) = w;
        }
}
__device__ __forceinline__ void pool_item(const Params& p, const int item, const int lj, LAS unsigned char* lds) {
    const int tid = my_tid(), wave = __builtin_amdgcn_readfirstlane(tid >> 6), lane = tid & 63, l32 = lane & 31, h = lane >> 5;
    const int tb = item >> 2, gs = item & 3, g = gs == 0 ? 0 : gs == 1 ? 3 : gs == 2 ? 1 : 2;
    const int row0 = tb * 64;
    int rowbase, T;
    if (row0 < NPROMPT) { rowbase = row0 & ~255; T = 256; } else { rowbase = NPROMPT + ((row0 - NPROMPT) & ~2047); T = 2048; }
    __syncthreads();
    if (g == 0) pool_body<1>(p, lj, g, row0, rowbase, T, lds, tid, wave, lane, l32, h);
    else if (g == 1) pool_body<2>(p, lj, g, row0, rowbase, T, lds, tid, wave, lane, l32, h);
    else if (g == 2) pool_body<4>(p, lj, g, row0, rowbase, T, lds, tid, wave, lane, l32, h);
    else pool_body<8>(p, lj, g, row0, rowbase, T, lds, tid, wave, lane, l32, h);
}

constexpr int SGU_PITCH = 260;
__device__ __forceinline__ void sgu_item(const Params& p, const int item, const int lj, LAS unsigned char* lds) {
    const int tid = my_tid(), wave = tid >> 6, lane = tid & 63, l32 = lane & 31, h = lane >> 5;
    const int ch = item >> 2, hd = item & 3, R0 = ch * 128;
    const bf16_t* proj = (const bf16_t*)(p.ws + OFF_PROJ);
    LAS bf16_t* vn = (LAS bf16_t*)lds;
    __syncthreads();
    if (tid < 64) *(LAS f32x4*)(lds + 69632 + tid * 16) = *(const GAS f32x4*)(p.in[I_SGUN] + lj * 1024 + hd * 256 + tid * 4);
    bf16x8 wfr[4][8];
    {
        const bf16_t* wb_ = (const bf16_t*)(p.ws + OFF_SGUW) + (size_t)(lj * 4 + hd) * 16384 + lane * 8;
#pragma unroll
        for (int nt = 0; nt < 2; ++nt)
#pragma unroll
            for (int s = 0; s < 8; ++s) wfr[nt][s] = ldg16(wb_ + (size_t)nt * 4096 + 512 * s);
    }
    {
        const int q = tid >> 2, qt = tid & 3;
        const bf16_t* vp = proj + (size_t)(R0 + q) * INW + 3072 + hd * 256 + qt * 64;
        u32x4 v[8];
#pragma unroll
        for (int i = 0; i < 8; ++i) v[i] = *(const GAS u32x4*)(vp + 8 * i);
        float sm = 0.f;
#pragma unroll
        for (int i = 0; i < 8; ++i) sm += (bflo(v[i].x) + bfhi(v[i].x)) + (bflo(v[i].y) + bfhi(v[i].y)) + (bflo(v[i].z) + bfhi(v[i].z)) + (bflo(v[i].w) + bfhi(v[i].w));
        sm += __shfl_xor(sm, 1); sm += __shfl_xor(sm, 2);
        const float mu = sm * (1.f / 256.f);
        float sq = 0.f;
#pragma unroll
        for (int i = 0; i < 8; ++i) {
            float d;
            d = bflo(v[i].x) - mu; sq += d * d; d = bfhi(v[i].x) - mu; sq += d * d; d = bflo(v[i].y) - mu; sq += d * d; d = bfhi(v[i].y) - mu; sq += d * d;
            d = bflo(v[i].z) - mu; sq += d * d; d = bfhi(v[i].z) - mu; sq += d * d; d = bflo(v[i].w) - mu; sq += d * d; d = bfhi(v[i].w) - mu; sq += d * d;
        }
        sq += __shfl_xor(sq, 1); sq += __shfl_xor(sq, 2);
        const float rs = rsqrtf(sq * (1.f / 256.f) + 1e-6f);
        __syncthreads();
        const LAS float* gnp = (const LAS float*)(lds + 69632) + qt * 64;
        LAS bf16_t* dst = vn + q * SGU_PITCH + qt * 64;
#pragma unroll
        for (int i = 0; i < 8; ++i) {
            const f32x4 g0 = *(const LAS f32x4*)(gnp + 8 * i), g1 = *(const LAS f32x4*)(gnp + 8 * i + 4);
            u32x2 w0, w1;
            w0.x = cvt_pk_bf16((bflo(v[i].x) - mu) * rs * g0[0], (bfhi(v[i].x) - mu) * rs * g0[1]); w0.y = cvt_pk_bf16((bflo(v[i].y) - mu) * rs * g0[2], (bfhi(v[i].y) - mu) * rs * g0[3]);
            w1.x = cvt_pk_bf16((bflo(v[i].z) - mu) * rs * g1[0], (bfhi(v[i].z) - mu) * rs * g1[1]); w1.y = cvt_pk_bf16((bflo(v[i].w) - mu) * rs * g1[2], (bfhi(v[i].w) - mu) * rs * g1[3]);
            *(LAS u32x2*)(dst + 8 * i) = w0; *(LAS u32x2*)(dst + 8 * i + 4) = w1;
        }
    }
    __syncthreads();
    {
        const bf16_t* wb_ = (const bf16_t*)(p.ws + OFF_SGUW) + (size_t)(lj * 4 + hd) * 16384 + lane * 8;
#pragma unroll
        for (int nt = 2; nt < 4; ++nt)
#pragma unroll
            for (int s = 0; s < 8; ++s) wfr[nt][s] = ldg16(wb_ + (size_t)nt * 4096 + 512 * s);
    }
    bf16x8 af[8];
    {
        const int c = wave * 32 + l32;
#pragma unroll
        for (int s = 0; s < 8; ++s) {
            unsigned short e[8];
#pragma unroll
            for (int jj = 0; jj < 8; ++jj) e[jj] = vn[(16 * s + 8 * h + jj) * SGU_PITCH + c];
            u32x4 w; w.x = e[0] | ((unsigned)e[1] << 16); w.y = e[2] | ((unsigned)e[3] << 16); w.z = e[4] | ((unsigned)e[5] << 16); w.w = e[6] | ((unsigned)e[7] << 16);
            af[s] = __builtin_bit_cast(bf16x8, w);
        }
    }
    __syncthreads();
#pragma unroll
    for (int nt = 0; nt < 4; ++nt) {
        const int pp = nt * 32 + l32;
        f32x16 acc;
#pragma unroll
        for (int r = 0; r < 16; ++r) acc[r] = 0.f;
#pragma unroll
        for (int s = 0; s < 8; ++s) acc = mfma32(af[s], wfr[nt][s], acc);
        const float bias = p.in[I_SGUB][(lj * 4 + hd) * 128 + pp];
        LAS unsigned char* mp_ = lds + pp * PL_PITCH + (wave * 32 + 4 * h) * 2;
#pragma unroll
        for (int g4 = 0; g4 < 4; ++g4) {
            u32x2 w; w.x = cvt_pk_bf16(acc[4 * g4 + 0] + bias, acc[4 * g4 + 1] + bias); w.y = cvt_pk_bf16(acc[4 * g4 + 2] + bias, acc[4 * g4 + 3] + bias);
            *(LAS u32x2*)(mp_ + 16 * g4) = w;
        }
    }
    __syncthreads();
#pragma unroll 2
    for (int idx = tid; idx < 128 * 32; idx += 512) {
        const int pp = idx >> 5, c16 = idx & 31;
        const size_t row = (size_t)(R0 + pp);
        const int cb = hd * 256 + c16 * 8;
        const u32x4 mx = *(const LAS u32x4*)(lds + pp * PL_PITCH + c16 * 16);
        const u32x4 uu = *(const GAS u32x4*)(proj + row * INW + 2048 + cb), gg = *(const GAS u32x4*)(proj + row * INW + 4096 + cb);
        u32x4 w;
        w.x = cvt_pk_bf16(bflo(uu.x) * bflo(mx.x) * silu(bflo(gg.x)), bfhi(uu.x) * bfhi(mx.x) * silu(bfhi(gg.x)));
        w.y = cvt_pk_bf16(bflo(uu.y) * bflo(mx.y) * silu(bflo(gg.y)), bfhi(uu.y) * bfhi(mx.y) * silu(bfhi(gg.y)));
        w.z = cvt_pk_bf16(bflo(uu.z) * bflo(mx.z) * silu(bflo(gg.z)), bfhi(uu.z) * bfhi(mx.z) * silu(bfhi(gg.z)));
        w.w = cvt_pk_bf16(bflo(uu.w) * bflo(mx.w) * silu(bflo(gg.w)), bfhi(uu.w) * bfhi(mx.w) * silu(bfhi(gg.w)));
        *(GAS u32x4*)((bf16_t*)(p.ws + OFF_O) + row * DM + 1024 + cb) = w;
    }
}

#ifndef MK_SPLIT
#define MK_SPLIT 0
#endif

#define XB_TMO      128
#define XB_XCNT(j)  (256  + 64 * (j))
#define XB_XSUB(j)  (1280 + 64 * (j))
#define XB_XGEN(j)  (2304 + 64 * (j))
#define XB_TOP      3328
#define XB_TOPGEN   3392
#define XCD_BAR_WORDS 3456
#define XB_SPIN_CAP (1u << 18)

__device__ __forceinline__ unsigned xb_ld(unsigned* p)              { return __hip_atomic_load(p, __ATOMIC_RELAXED, __HIP_MEMORY_SCOPE_AGENT); }
__device__ __forceinline__ unsigned xb_add(unsigned* p, unsigned v) { return __hip_atomic_fetch_add(p, v, __ATOMIC_RELAXED, __HIP_MEMORY_SCOPE_AGENT); }
__device__ __forceinline__ unsigned xb_xcc_id() { return (unsigned)__builtin_amdgcn_s_getreg((3 << 11) | 20) & 0xFu; }
#define XB_SPIN(cond, bar) do { unsigned _sp = 0; while (cond) { __builtin_amdgcn_s_sleep(1); \
    if ((++_sp & 255u) == 0u) { if (xb_ld(&(bar)[XB_TMO])) break; if (_sp > XB_SPIN_CAP) { atomicAdd(&(bar)[XB_TMO], 1u); break; } } } } while (0)

struct XcdBarrier {
    unsigned* bar; unsigned x;
    volatile LAS unsigned* st;
};

__device__ __forceinline__ XcdBarrier xcd_barrier_post(unsigned* bar, volatile LAS unsigned* st) {
    XcdBarrier b; b.bar = bar; b.x = xb_xcc_id(); b.st = st;
    if (threadIdx.x == 0) (void)xb_add(&bar[XB_XCNT(b.x)], 1u);
    return b;
}
__device__ __forceinline__ void xcd_barrier_complete(unsigned* bar, unsigned x, unsigned& nloc, unsigned& nx) {
    const unsigned G = gridDim.x * gridDim.y * gridDim.z;
    unsigned sum, cnt, mine, sp = 0u;
    for (;;) {
        sum = 0u; cnt = 0u; mine = 0u;
#pragma unroll
        for (unsigned j = 0; j < 16; ++j) { const unsigned c = xb_ld(&bar[XB_XCNT(j)]); sum += c; cnt += (c > 0u) ? 1u : 0u; mine = (j == x) ? c : mine; }
        if (sum == G) break;
        __builtin_amdgcn_s_sleep(1);
        if ((++sp & 255u) == 0u) { if (xb_ld(&bar[XB_TMO])) break; if (sp > XB_SPIN_CAP) { atomicAdd(&bar[XB_TMO], 1u); break; } }
    }
    nloc = mine > 0u ? mine : 1u; nx = cnt > 0u ? cnt : 1u;
}

__device__ __forceinline__ void xcd_barrier(const XcdBarrier& b) {
    asm volatile("s_waitcnt vmcnt(0)" ::: "memory");
    __syncthreads();
    if (threadIdx.x == 0) {
        unsigned* bar = b.bar;
        __builtin_amdgcn_s_waitcnt(0);
        unsigned nloc = b.st[0], nx = b.st[1];
        if (nloc == 0u) { xcd_barrier_complete(bar, b.x, nloc, nx); b.st[0] = nloc; b.st[1] = nx; }
        const unsigned old = xb_add(&bar[XB_XSUB(b.x)], 1u);
        const unsigned gen = old / nloc;
        if (old + 1u == (gen + 1u) * nloc) {
            __builtin_amdgcn_fence(__ATOMIC_RELEASE, "agent");
            asm volatile("s_waitcnt vmcnt(0)" ::: "memory");
            const unsigned og = xb_add(&bar[XB_TOP], 1u);
            const unsigned tg = og / nx;
            if (og + 1u == (tg + 1u) * nx) xb_add(&bar[XB_TOPGEN], 1u);
            else XB_SPIN(xb_ld(&bar[XB_TOPGEN]) == tg, bar);
            __builtin_amdgcn_fence(__ATOMIC_ACQUIRE, "agent");
            xb_add(&bar[XB_XGEN(b.x)], 1u);
            asm volatile("s_waitcnt vmcnt(0)" ::: "memory");
        } else {
            XB_SPIN(xb_ld(&bar[XB_XGEN(b.x)]) == gen, bar);
            __builtin_amdgcn_fence(__ATOMIC_ACQUIRE, "agent");
            asm volatile("s_waitcnt vmcnt(0)" ::: "memory");
        }
    }
    __syncthreads();
}

#ifndef MK_ENABLE
#define MK_ENABLE 0x1ff
#endif
#define EN(x) (((MK_ENABLE) >> (x)) & 1)
#ifndef MK_DUP
#define MK_DUP 0
#endif
#define DUP(x) (1 + (((MK_DUP) >> (x)) & 1))
__global__ __launch_bounds__(512, 2) void fwd_megakernel(const Params p, const int ph_lo, const int ph_hi, const int use_sync) {
    extern __shared__ __attribute__((aligned(16))) unsigned char shm[];
    cg::grid_group grid = cg::this_grid();
    LAS unsigned char* lds = (LAS unsigned char*)shm;
    const int tid = my_tid(), wave = __builtin_amdgcn_readfirstlane(tid >> 6);
    if (use_sync == 2) grid.sync();
    volatile LAS unsigned* xst = (volatile LAS unsigned*)(lds + 131072);
    if (threadIdx.x < 4) xst[threadIdx.x] = 0u;
    __syncthreads();
    const XcdBarrier xb = xcd_barrier_post((unsigned*)(p.ws + OFF_BAR), xst);
    int ph = 0;
#define PHASE_BEGIN if (ph >= ph_lo && ph < ph_hi) { Params q = p; asm volatile("" : "+s"(q.ws), "+s"(q.out));
#define PHASE_END } ++ph; if (use_sync && ph > ph_lo && ph < ph_hi) xcd_barrier(xb);
#define PHASE_END_LAST } ++ph;
    PHASE_BEGIN for (int rep = 0; rep < DUP(3); ++rep) { if (EN(4)) phase0(q, shm); __syncthreads(); } if (MK_DUP & 1) { for (int i = 0; i < 20; ++i) xcd_barrier(xb); } PHASE_END
    PHASE_BEGIN if (EN(8)) phase_rows(q, -1, lds); PHASE_END
#pragma unroll 1
    for (int l = 0; l < 4; ++l) {
        const int lj = l >> 1;
        PHASE_BEGIN
_Pragma("unroll 1") for (int rep = 0; rep < DUP(4); ++rep) {
            pg8::Gemm g; g.A = (const bf16_t*)(q.ws + OFF_H); g.Bt = (const bf16_t*)(q.ws + OFF_WTIN) + (size_t)l * 5120 * 2048; g.M = MROWS; g.N = INW; g.K = DM;
            pg8::StaticOrder S; S.init(g.M, g.N, (int)gridDim.x, (int)blockIdx.x);
            EpiProj E; E.O = (bf16_t*)(q.ws + OFF_PROJ); E.outk = q.out + (size_t)MROWS * DM; E.outv = E.outk + (size_t)32 * 2 * 256 * 512; E.even = (l & 1) == 0; E.j = lj;
            __syncthreads();
            if (EN(6)) pg8::gemm_phase<EpiProj, pg8::StaticOrder, false>(lds, g, S, E, nullptr);
            __syncthreads();
}
        PHASE_END
        if ((l & 1) == 0) {
            PHASE_BEGIN if (EN(3)) phase_even_prep(q, lj, lds); PHASE_END
            PHASE_BEGIN
_Pragma("unroll 1") for (int rep = 0; rep < DUP(1); ++rep) {                if (blockIdx.x < 32) {
                    pg8::Gemm g; g.A = (const bf16_t*)(q.ws + OFF_TW2K); g.Bt = (const bf16_t*)(q.ws + OFF_YTS) + (size_t)lj * 1024 * 2048; g.M = 2048; g.N = 1024; g.K = 2048;
                    asm volatile("" : "+s"(g.A), "+s"(g.Bt), "+s"(g.M), "+s"(g.N), "+s"(g.K));
                    pg8::StaticOrder S; S.init(g.M, g.N, 32, (int)blockIdx.x);
                    EpiFnet E; E.proj = (const bf16_t*)(q.ws + OFF_PROJ); E.O = (bf16_t*)(q.ws + OFF_O); E.rowbase0 = NPROMPT; E.T = 2048; E.yh = (const float*)(q.ws + OFF_YH) + lj * 1024;
                    __syncthreads();
                    _Pragma("unroll 1") for (int rep2 = 0; rep2 < DUP(7); ++rep2) { if (EN(5)) pg8::gemm_phase<EpiFnet, pg8::StaticOrder, false>(lds, g, S, E, nullptr);
                    __syncthreads(); }
                } else {
                    const int nb = (int)gridDim.x - 32;
                    int fc, fG;
                    if (gridDim.x == 256) {
                        const int xq = (int)blockIdx.x & 7, kq_ = ((int)blockIdx.x >> 3) - 4;
                        if (kq_ < 24) {
#pragma unroll 1
                            for (int u = 0; u < 3; ++u) {
                                int item;
                                if (u == 0) item = (xq >> 2) * 96 + ((xq & 3) * 3 + (kq_ >> 3)) * 8 + (kq_ & 7);
                                else { const int pk = 2 * kq_ + (u - 1), gp_ = xq + 8 * (pk / 3); item = 192 + (gp_ >> 2) * 12 + (gp_ & 3) * 3 + pk % 3; }
                                if (EN(0)) attn_item(q, item, lj, lds);
                            }
                            fc = -1;
                        } else fc = xq * 4 + (kq_ - 24);
                        fG = 32;
                    } else {
                        for (int item = (int)blockIdx.x - 32; item < 576; item += nb) { if (EN(0)) attn_item(q, item, lj, lds); }
                        fc = (int)blockIdx.x - ((int)gridDim.x - 64); fG = 64;
                    }
                    __syncthreads();
                    pg8::Gemm g; g.A = (const bf16_t*)(q.ws + OFF_TW256); g.Bt = (const bf16_t*)(q.ws + OFF_YTP); g.M = 256; g.N = 16384; g.K = 512;
                    asm volatile("" : "+s"(g.A), "+s"(g.Bt), "+s"(g.M), "+s"(g.N), "+s"(g.K));
                    pg8::StaticOrder S; S.init(g.M, g.N, fG, fc);
                    EpiFnet E; E.proj = (const bf16_t*)(q.ws + OFF_PROJ); E.O = (bf16_t*)(q.ws + OFF_O); E.rowbase0 = 0; E.T = 256; E.yh = nullptr;
                    if (EN(5) && fc >= 0) pg8::gemm_phase<EpiFnet, pg8::StaticOrder, false>(lds, g, S, E, nullptr);
                    __syncthreads();
                }
}
            PHASE_END
        } else {
            PHASE_BEGIN
_Pragma("unroll 1") for (int rep = 0; rep < DUP(2); ++rep) {                for (int item = blockIdx.x; item < 384; item += gridDim.x) { if (EN(2)) sgu_item(q, item, lj, lds); }
                {
                    const int bx = (int)blockIdx.x, np = bx < 128 ? 2 : 4, first = bx < 128 ? 2 * bx : 256 + 4 * (bx - 128);
                    if (gridDim.x == 256) { for (int k = 0; k < np; ++k) { if (EN(1)) pool_item(q, first + k, lj, lds); } }
                    else { for (int k = bx; k < 768; k += (int)gridDim.x) { if (EN(1)) pool_item(q, k, lj, lds); } }
                }
                __syncthreads();
}
            PHASE_END
        }
        PHASE_BEGIN
_Pragma("unroll 1") for (int rep = 0; rep < DUP(5); ++rep) {
            pg8::Gemm g; g.A = (const bf16_t*)(q.ws + OFF_O); g.Bt = (const bf16_t*)(q.ws + OFF_WTOUT) + (size_t)l * 2048 * 2048; g.M = MROWS; g.N = DM; g.K = DM;
            pg8::StaticOrder S; S.init(g.M, g.N, (int)gridDim.x, (int)blockIdx.x);
            EpiY E; E.C = (bf16_t*)(q.ws + OFF_Y);
            __syncthreads();
            if (EN(7)) pg8::gemm_phase<EpiY, pg8::StaticOrder, false>(lds, g, S, E, nullptr);
            __syncthreads();
            if (EN(4) && gridDim.x == 256 && blockIdx.x >= 128 && l < 3) transpose_tiles(q, shm, l + 1);
}
        PHASE_END
        if (l < 3) { PHASE_BEGIN if (EN(8)) phase_rows(q, l, lds); PHASE_END } else { PHASE_BEGIN if (EN(8)) phase_rows(q, l, lds); PHASE_END_LAST }
    }
}

extern "C" void kernel_launch(void* const* d_in, const int* in_sizes, int n_in, void* d_out, int out_size, void* d_ws, size_t ws_size, hipStream_t stream) {
    constexpr size_t kDynLds = 131072 + 16;
    static int grid_blocks = 0;
    if (!grid_blocks) {
        int dev = 0, cus = 0, per_cu = 0;
        (void)hipGetDevice(&dev);
        (void)hipDeviceGetAttribute(&cus, hipDeviceAttributeMultiprocessorCount, dev);
        (void)hipFuncSetAttribute((const void*)fwd_megakernel, hipFuncAttributeMaxDynamicSharedMemorySize, (int)kDynLds);
        (void)hipOccupancyMaxActiveBlocksPerMultiprocessor(&per_cu, fwd_megakernel, 512, kDynLds);
        if (per_cu < 1) { fprintf(stderr, "occupancy query returned %d\n", per_cu); per_cu = 1; }
        if (per_cu > 1) per_cu = 1;
        grid_blocks = cus * per_cu;
        if (grid_blocks > 256) grid_blocks = 256;
    }
    if (ws_size < WS_NEED) { fprintf(stderr, "workspace too small: %zu < %zu\n", ws_size, WS_NEED); return; }
    Params p{};
    for (int i = 0; i < 18; ++i) p.in[i] = (const float*)d_in[i];
    p.out = (float*)d_out; p.ws = (unsigned char*)d_ws;
#if MK_SPLIT
    for (int ph = 0; ph < 22; ++ph) {
        int lo = ph, hi = ph + 1, us = 0;
        void* args[] = {(void*)&p, (void*)&lo, (void*)&hi, (void*)&us};
        hipLaunchCooperativeKernel((const void*)fwd_megakernel, dim3(grid_blocks), dim3(512), args, kDynLds, stream);
    }
#else
    (void)hipMemsetAsync((unsigned char*)d_ws + OFF_BAR, 0, 16384, stream);
    (void)hipMemsetAsync((unsigned char*)d_ws + OFF_MOD, 0, (size_t)4 * 3 * 6144 * 4, stream);
    int lo = 0, hi = 1000, us = 1;
    void* args[] = {(void*)&p, (void*)&lo, (void*)&hi, (void*)&us};
    hipError_t e = hipLaunchCooperativeKernel((const void*)fwd_megakernel, dim3(grid_blocks), dim3(512), args, kDynLds, stream);
    if (e != hipSuccess) fprintf(stderr, "cooperative launch failed: %s (grid %d)\n", hipGetErrorString(e), grid_blocks);
#endif
}
```

```cpp
#include <hip/hip_runtime.h>
#include <hip/hip_cooperative_groups.h>
#include <cstdio>
namespace cg = cooperative_groups;
namespace pg8 {
#define PG8_LAS __attribute__((address_space(3)))
typedef unsigned short bf16_t;
typedef short bf16x8 __attribute__((ext_vector_type(8)));
typedef float f32x4 __attribute__((ext_vector_type(4)));
typedef unsigned u32x4 __attribute__((ext_vector_type(4)));
constexpr int BM = 256, BK = 64, HALF = 128, HTB = HALF * BK * 2  , STAGE_BYTES = 8 * HTB, NXCD = 8, WGM = 8;

__host__ __device__ __forceinline__ int lds_byte(int r, int c) { const int st = (r >> 4) * 2 + (c >> 5), rr = r & 15, cc = c & 31, ob = rr * 64 + cc * 2; return st * 1024 + (ob ^ (((ob >> 9) & 1) << 5)); }
__host__ __device__ __forceinline__ void stage_rc(int b, int& R, int& C) { const int st = b / 1024, sb = b % 1024, swz = sb ^ (((sb >> 9) & 1) << 5); R = (st >> 1) * 16 + swz / 64; C = (st & 1) * 32 + (swz % 64) / 2; }
__host__ __device__ __forceinline__ int perm32(int rho) { const int n = rho >> 4, i = rho & 15; return 8 * (i >> 2) + 4 * n + (i & 3); }

struct Unit { int pm, pn; };
struct Gemm { const bf16_t* A; const bf16_t* Bt; int M, N, K; };

struct StaticOrder {
    int nM, nN, nwg, G, c;
    __host__ __device__ void init(int M, int N, int G_, int c_) { nM = M / BM; nN = N / BM; nwg = nM * nN; G = G_; c = c_; }
    __host__ __device__ bool next(int i, Unit& u) const {
        const long L = (long)i * G + c; if (L >= nwg) return false;
        int wgid = (int)L; { const int q = nwg / NXCD, r = nwg % NXCD, xcd = wgid % NXCD, off = wgid / NXCD; wgid = (xcd < r ? xcd * (q + 1) : r * (q + 1) + (xcd - r) * q) + off; }
        const int nig = WGM * nN, gid = wgid / nig, fm = gid * WGM, gsz = (nM - fm) < WGM ? (nM - fm) : WGM;
        u.pm = fm + ((wgid % nig) % gsz); u.pn = (wgid % nig) / gsz; return true;
    }
    __device__ __forceinline__ void a_ready(const Unit&) const {}
    __device__ __forceinline__ void done(const Unit&) const {}
};
typedef __bf16 bf16x2_t __attribute__((ext_vector_type(2)));
typedef float f32x2_t __attribute__((ext_vector_type(2)));
__device__ __forceinline__ unsigned cvt_pk_bf16(float lo, float hi) { const f32x2_t v = {lo, hi}; const bf16x2_t r = __builtin_convertvector(v, bf16x2_t); return __builtin_bit_cast(unsigned, r); }
template <class Epi, class Sched, bool STAMP = false>
__device__ __forceinline__ void gemm_phase(PG8_LAS unsigned char* lds, const Gemm g, const Sched& S, const Epi& E, unsigned long long* stamps) {
    int tid_ = threadIdx.x; asm volatile("" : "+v"(tid_));
    const int tid = tid_, wid = __builtin_amdgcn_readfirstlane(tid >> 6), lane = tid & 63, wr = wid >> 2, wc = wid & 3, fr = lane & 15, fq = lane >> 4;
    const int K = g.K, nt = K / BK;
    int ts_lo = 0, ts_hi = 0, nts = 0; const unsigned long long rt_entry = STAMP ? (unsigned long long)wall_clock64() : 0ull;
#define PG8_STAMP() do { if (STAMP && wid == 0 && nts < 64) { const unsigned long long _c = (unsigned long long)clock64(); \
        ts_lo = (lane == nts) ? (int)(unsigned)_c : ts_lo; ts_hi = (lane == nts) ? (int)(unsigned)(_c >> 32) : ts_hi; ++nts; } } while (0)
    PG8_STAMP();
    unsigned voffA[2], voffB[2];
#pragma unroll
    for (int i = 0; i < 2; ++i) { int R, C; stage_rc(tid * 16 + i * 8192, R, C); const int Rb = Epi::PERM ? ((R & ~31) + perm32(R & 31)) : R;
        voffA[i] = (unsigned)(R * K + C) * 2u; voffB[i] = (unsigned)(Rb * K + C) * 2u; }
    const size_t kstep = (size_t)(BK * 2);
    const size_t hstep = (size_t)HALF * K * 2;
    const size_t tstep = 2 * hstep;
    const unsigned ldsw = (unsigned)wid * 1024u;
    const int aoff = lds_byte(wr * 64 + fr, fq * 8), boff = lds_byte(wc * 32 + fr, fq * 8);
#define PG8_SA(b, h) (((b) * 2 + (h)) * HTB)
#define PG8_SB(b, h) ((4 + (b) * 2 + (h)) * HTB)
#define PG8_STAGE(bufoff, gbase, voff) do { _Pragma("unroll") for (int _i = 0; _i < 2; ++_i) \
        __builtin_amdgcn_global_load_lds((const unsigned*)((const char*)(gbase) + (voff)[_i]), (PG8_LAS unsigned*)(lds + (bufoff) + ldsw + _i * 8192), 16, 0, 0); } while (0)
#define PG8_LDA(dst, b, h) do { _Pragma("unroll") for (int m = 0; m < 4; ++m) _Pragma("unroll") for (int k = 0; k < 2; ++k) dst[m][k] = *(const PG8_LAS bf16x8*)(lds + PG8_SA(b, h) + aoff + m * 2048 + k * 1024); } while (0)
#define PG8_LDB(dst, b, h) do { _Pragma("unroll") for (int n = 0; n < 2; ++n) _Pragma("unroll") for (int k = 0; k < 2; ++k) dst[n][k] = *(const PG8_LAS bf16x8*)(lds + PG8_SB(b, h) + boff + n * 2048 + k * 1024); } while (0)
#define PG8_MMA(ai, bj, At, Bt) do { __builtin_amdgcn_s_setprio(1); _Pragma("unroll") for (int m = 0; m < 4; ++m) _Pragma("unroll") for (int n = 0; n < 2; ++n) _Pragma("unroll") for (int k = 0; k < 2; ++k) \
        acc[ai][bj][m][n] = __builtin_amdgcn_mfma_f32_16x16x32_bf16(Bt[n][k], At[m][k], acc[ai][bj][m][n], 0, 0, 0); __builtin_amdgcn_s_setprio(0); } while (0)
#define PG8_WAIT_V(n) asm volatile("s_waitcnt vmcnt(" #n ")" ::: "memory")
#define PG8_WAIT_L(n) asm volatile("s_waitcnt lgkmcnt(" #n ")" ::: "memory")
#define PG8_BAR __builtin_amdgcn_s_barrier()
#define PG8_SCHED __builtin_amdgcn_sched_barrier(0)
    Unit cur, nxt; int ui = 0;
    if (!S.next(0, cur)) return;
    f32x4 acc[2][2][4][2];
#pragma unroll
    for (int a = 0; a < 2; ++a)
#pragma unroll
        for (int b = 0; b < 2; ++b)
#pragma unroll
            for (int m = 0; m < 4; ++m)
#pragma unroll
                for (int n = 0; n < 2; ++n) acc[a][b][m][n] = (f32x4){0.f, 0.f, 0.f, 0.f};
    bf16x8 At[4][2], B0[2][2], B1[2][2];
    const char* cA = (const char*)g.A + (size_t)cur.pm * tstep; const char* cB = (const char*)g.Bt + (size_t)cur.pn * tstep;
    S.a_ready(cur);
    PG8_STAGE(PG8_SB(0, 0), cB, voffB); PG8_STAGE(PG8_SA(0, 0), cA, voffA); PG8_STAGE(PG8_SB(0, 1), cB + hstep, voffB); PG8_STAGE(PG8_SA(0, 1), cA + hstep, voffA);
    if (wr == 1) PG8_BAR;
    PG8_WAIT_V(4); PG8_BAR;
    PG8_STAGE(PG8_SB(1, 0), cB + kstep, voffB); PG8_STAGE(PG8_SA(1, 0), cA + kstep, voffA); PG8_STAGE(PG8_SB(1, 1), cB + hstep + kstep, voffB);
    PG8_WAIT_V(6); PG8_BAR;
    PG8_STAMP();
    for (;;) {
        const bool has_next = S.next(ui + 1, nxt);
        const char* nA = has_next ? (const char*)g.A + (size_t)nxt.pm * tstep : cA; const char* nB = has_next ? (const char*)g.Bt + (size_t)nxt.pn * tstep : cB;
        for (int t = 0; t < nt; t += 2) {
            const bool last = (t == nt - 2);
            const char* a1 = cA + (size_t)(t + 1) * kstep;
            const char* a2 = last ? nA : cA + (size_t)(t + 2) * kstep; const char* b2 = last ? nB : cB + (size_t)(t + 2) * kstep;
            const char* a3 = a2 + kstep; const char* b3 = b2 + kstep;
            if (last && has_next) S.a_ready(nxt);
            PG8_LDB(B0, 0, 0); PG8_SCHED; PG8_LDA(At, 0, 0); PG8_STAGE(PG8_SA(1, 1), a1 + hstep, voffA);
            PG8_WAIT_L(8); PG8_BAR; PG8_WAIT_L(0); PG8_MMA(0, 0, At, B0); PG8_BAR; PG8_SCHED;
            PG8_LDB(B1, 0, 1); PG8_STAGE(PG8_SB(0, 0), b2, voffB);
            PG8_BAR; PG8_WAIT_L(0); PG8_MMA(0, 1, At, B1); PG8_BAR;
            PG8_LDA(At, 0, 1); PG8_STAGE(PG8_SA(0, 0), a2, voffA);
            PG8_BAR; PG8_WAIT_L(0); PG8_MMA(1, 0, At, B0); PG8_BAR; PG8_SCHED;
            PG8_STAGE(PG8_SB(0, 1), b2 + hstep, voffB);
            PG8_WAIT_V(6); PG8_BAR; PG8_MMA(1, 1, At, B1); PG8_BAR;
            PG8_LDB(B0, 1, 0); PG8_SCHED; PG8_LDA(At, 1, 0); PG8_STAGE(PG8_SA(0, 1), a2 + hstep, voffA);
            PG8_WAIT_L(8); PG8_BAR; PG8_WAIT_L(0); PG8_MMA(0, 0, At, B0); PG8_BAR; PG8_SCHED;
            PG8_LDB(B1, 1, 1); PG8_STAGE(PG8_SB(1, 0), b3, voffB);
            PG8_BAR; PG8_WAIT_L(0); PG8_MMA(0, 1, At, B1); PG8_BAR;
            PG8_LDA(At, 1, 1); PG8_STAGE(PG8_SA(1, 0), a3, voffA);
            PG8_BAR; PG8_WAIT_L(0); PG8_MMA(1, 0, At, B0); PG8_BAR; PG8_SCHED;
            PG8_STAGE(PG8_SB(1, 1), b3 + hstep, voffB);
            PG8_WAIT_V(6); PG8_BAR; PG8_MMA(1, 1, At, B1); PG8_BAR;
        }
        PG8_STAMP();
        if constexpr (!Epi::AFTER_DRAIN) { E(acc, cur, wr, wc, fr, fq); S.done(cur); }
        PG8_STAMP();
        if (!has_next) break;
#pragma unroll
        for (int a = 0; a < 2; ++a)
#pragma unroll
            for (int b = 0; b < 2; ++b)
#pragma unroll
                for (int m = 0; m < 4; ++m)
#pragma unroll
                    for (int n = 0; n < 2; ++n) acc[a][b][m][n] = (f32x4){0.f, 0.f, 0.f, 0.f};
        cur = nxt; cA = nA; cB = nB; ++ui;
    }
    PG8_WAIT_V(0);
    if (wr == 0) PG8_BAR;
    PG8_BAR;
    if constexpr (Epi::AFTER_DRAIN) { E.fused(acc, cur, wr, wc, fr, fq, lds, wid, lane); S.done(cur); }
    PG8_STAMP();
    if (STAMP && wid == 0) { stamps[lane] = lane < nts ? (((unsigned long long)(unsigned)ts_hi << 32) | (unsigned)ts_lo) : 0ull;
        if (lane == 62) stamps[62] = rt_entry; if (lane == 63) stamps[63] = (unsigned long long)wall_clock64(); }
#undef PG8_STAMP
#undef PG8_SA
#undef PG8_SB
#undef PG8_STAGE
#undef PG8_LDA
#undef PG8_LDB
#undef PG8_MMA
#undef PG8_WAIT_V
#undef PG8_WAIT_L
#undef PG8_BAR
#undef PG8_SCHED
}
}


using pg8::bf16_t; using pg8::bf16x8; using pg8::f32x4; using pg8::u32x4; using pg8::cvt_pk_bf16;
typedef float f32x16 __attribute__((ext_vector_type(16)));
typedef short bf16x4 __attribute__((ext_vector_type(4)));
typedef unsigned u32x2 __attribute__((ext_vector_type(2)));
#define LAS __attribute__((address_space(3)))

constexpr int DM = 2048, MROWS = 12288, NPROMPT = 8192, INW = 5120;
constexpr float LOG2E = 1.4426950408889634f;

constexpr size_t OFF_WTIN  = 0;
constexpr size_t OFF_WTOUT = OFF_WTIN  + (size_t)4 * 5120 * 2048 * 2;
constexpr size_t OFF_MOD   = OFF_WTOUT + (size_t)4 * 2048 * 2048 * 2;
constexpr size_t OFF_H     = OFF_MOD   + (size_t)4 * 3 * 6144 * 4;
constexpr size_t OFF_PROJ  = OFF_H     + (size_t)MROWS * 2048 * 2;
constexpr size_t OFF_O     = OFF_PROJ  + (size_t)MROWS * 5120 * 2;
constexpr size_t OFF_Y     = OFF_O     + (size_t)MROWS * 2048 * 2;
constexpr size_t OFF_VT    = OFF_Y     + (size_t)MROWS * 2048 * 4;
constexpr size_t OFF_CTXK  = OFF_VT    + (size_t)MROWS * 512 * 2;
constexpr size_t OFF_CTXVT = OFF_CTXK  + (size_t)2 * 2 * 256 * 512 * 2;
constexpr size_t OFF_YTP   = OFF_CTXVT + (size_t)2 * 2 * 256 * 512 * 2;
constexpr size_t OFF_YTS   = OFF_YTP   + (size_t)32 * 512 * 512 * 2;
constexpr size_t OFF_TW256 = OFF_YTS   + (size_t)2 * 512 * 4096 * 2;
constexpr size_t OFF_TW2K  = OFF_TW256 + (size_t)256 * 512 * 2;
constexpr size_t OFF_CCS   = OFF_TW2K  + (size_t)2048 * 4096 * 2;
constexpr size_t OFF_POOLW = OFF_CCS   + (size_t)256 * 128 * 2;
constexpr size_t OFF_SGUW  = OFF_POOLW + (size_t)2 * 4 * 256 * 256 * 2;
constexpr size_t OFF_BAR   = OFF_SGUW  + (size_t)2 * 4 * 128 * 128 * 2;
constexpr size_t OFF_YH    = OFF_BAR + 16384;
constexpr size_t OFF_XB    = OFF_YH + 8192;
constexpr size_t WS_NEED   = OFF_XB + (size_t)MROWS * 2048 * 2;

struct Params { const float* in[18]; float* out; unsigned char* ws; };
enum { I_XP = 0, I_XS, I_CK, I_CV, I_C, I_CCTX, I_WADA, I_BADA, I_NPRE, I_NPOST, I_WIN, I_WOUT, I_SINK, I_POOLW, I_POOLS, I_SGUN, I_SGUW, I_SGUB };

__device__ __forceinline__ int my_tid() { int t = threadIdx.x; asm volatile("" : "+v"(t)); return t; }
__device__ __forceinline__ float bflo(unsigned w) { return __uint_as_float(w << 16); }
__device__ __forceinline__ float bfhi(unsigned w) { return __uint_as_float(w & 0xffff0000u); }
__device__ __forceinline__ float bf1(bf16_t b) { return __uint_as_float(((unsigned)b) << 16); }
__device__ __forceinline__ float silu(float x) { return x * __builtin_amdgcn_rcpf(1.f + __builtin_amdgcn_exp2f(-1.4426950408889634f * x)); }
__device__ __forceinline__ bf16_t f2bf(float f) { return (bf16_t)(cvt_pk_bf16(f, 0.f) & 0xffffu); }
__device__ __forceinline__ float wave_sum(float v) {
#pragma unroll
    for (int o = 32; o >= 1; o >>= 1) v += __shfl_xor(v, o);
    return v;
}
__device__ __forceinline__ bf16x8 ld16(const bf16_t* p) { return *(const bf16x8*)p; }
__device__ __forceinline__ bf16x8 ld8x2(const bf16_t* p0, const bf16_t* p1) {
    const bf16x4 a = *(const bf16x4*)p0, b = *(const bf16x4*)p1;
    return __builtin_shufflevector(a, b, 0, 1, 2, 3, 4, 5, 6, 7);
}
#define GAS __attribute__((address_space(1)))
__device__ __forceinline__ bf16x8 ldg16(const bf16_t* p) { return *(const GAS bf16x8*)p; }
__device__ __forceinline__ bf16x8 ldg8x2(const bf16_t* p0, const bf16_t* p1) {
    const bf16x4 a = *(const GAS bf16x4*)p0, b = *(const GAS bf16x4*)p1;
    return __builtin_shufflevector(a, b, 0, 1, 2, 3, 4, 5, 6, 7);
}
__device__ __forceinline__ f32x16 mfma32(bf16x8 a, bf16x8 b, f32x16 c) { return __builtin_amdgcn_mfma_f32_32x32x16_bf16(a, b, c, 0, 0, 0); }

__device__ __forceinline__ void transpose_tiles(const Params& p, unsigned char* smem, const int l) {
    float* tile = (float*)smem + 3 * 2048 + 8 * 3 * 256;
    volatile int* slot = (volatile int*)(tile + 128 * 129);
    const int tid = my_tid();
    unsigned* qcnt = (unsigned*)(p.ws + OFF_BAR) + 3500 + l;
    const float* win = p.in[I_WIN] + (size_t)l * 2048 * 5120; const float* wout = p.in[I_WOUT] + (size_t)l * 2048 * 2048;
    bf16_t* wtin = (bf16_t*)(p.ws + OFF_WTIN) + (size_t)l * 5120 * 2048; bf16_t* wtout = (bf16_t*)(p.ws + OFF_WTOUT) + (size_t)l * 2048 * 2048;
    __syncthreads();
    if (tid == 0) *slot = (int)atomicAdd(qcnt, 1u);
    __syncthreads();
    int cur = *slot;
    const int rr = tid >> 5, c4 = (tid & 31) * 4, nn = tid >> 2, kq0 = tid & 3;
    while (cur < 896) {
        int nxt = 0;
        if (tid == 0) nxt = (int)atomicAdd(qcnt, 1u);
        const float* src; bf16_t* dst; int N, kt, nt;
        if (cur < 640) { kt = cur / 40; nt = cur % 40; N = 5120; src = win; dst = wtin; }
        else { const int r = cur - 640; kt = r >> 4; nt = r & 15; N = 2048; src = wout; dst = wtout; }
        const int k0 = kt * 128, n0 = nt * 128;
        f32x4 v[8];
#pragma unroll
        for (int i = 0; i < 8; ++i) v[i] = __builtin_nontemporal_load((const GAS f32x4*)(src + (size_t)(k0 + rr + 16 * i) * N + n0 + c4));
#pragma unroll
        for (int i = 0; i < 8; ++i) { float* tp = tile + (rr + 16 * i) * 129 + c4; tp[0] = v[i][0]; tp[1] = v[i][1]; tp[2] = v[i][2]; tp[3] = v[i][3]; }
        __syncthreads();
#pragma unroll
        for (int jj = 0; jj < 4; ++jj) {
            const int kq = kq0 + 4 * jj;
            float t[8];
#pragma unroll
            for (int e = 0; e < 8; ++e) t[e] = tile[(kq * 8 + e) * 129 + nn];
            u32x4 w; w.x = cvt_pk_bf16(t[0], t[1]); w.y = cvt_pk_bf16(t[2], t[3]); w.z = cvt_pk_bf16(t[4], t[5]); w.w = cvt_pk_bf16(t[6], t[7]);
            *(GAS u32x4*)(dst + (size_t)(n0 + nn) * 2048 + k0 + kq * 8) = w;
        }
        if (tid == 0) *slot = nxt;
        __syncthreads();
        cur = *slot;
    }
}

__device__ __forceinline__ void phase0(const Params& p, unsigned char* smem) {
    float* sc = (float*)smem;
    float* red = sc + 3 * 2048;
    const int tid = my_tid(), wave = tid >> 6, lane = tid & 63;
    for (int i = tid; i < 3 * 2048; i += 512) {
        const int ci = i >> 11, k = i & 2047;
        const float v = ci == 0 ? p.in[I_CCTX][k] : p.in[I_C][(ci - 1) * 2048 + k];
        sc[i] = silu(v);
    }
    __syncthreads();
    float* mod = (float*)(p.ws + OFF_MOD);
    for (int item = blockIdx.x; item < 192; item += gridDim.x) {
        const int l = item / 48, rem = item % 48, n0 = (rem >> 1) * 256, kh = rem & 1;
        const float* wp = p.in[I_WADA] + ((size_t)l * 2048 + kh * 1024 + wave * 128) * 6144 + n0 + lane * 4;
        const float* s0 = sc + kh * 1024 + wave * 128;
        f32x4 a0 = {0.f, 0.f, 0.f, 0.f}, a1 = a0, a2 = a0;
#pragma unroll 8
        for (int kk = 0; kk < 128; ++kk) {
            const f32x4 wv = __builtin_nontemporal_load((const GAS f32x4*)(wp + (size_t)kk * 6144));
            a0 += wv * s0[kk]; a1 += wv * s0[2048 + kk]; a2 += wv * s0[4096 + kk];
        }
        *(f32x4*)(red + (wave * 3 + 0) * 256 + lane * 4) = a0; *(f32x4*)(red + (wave * 3 + 1) * 256 + lane * 4) = a1; *(f32x4*)(red + (wave * 3 + 2) * 256 + lane * 4) = a2;
        __syncthreads();
        for (int o = tid; o < 768; o += 512) {
            const int ci = o >> 8, col = o & 255;
            float s_ = kh == 0 ? p.in[I_BADA][l * 6144 + n0 + col] : 0.f;
#pragma unroll
            for (int w = 0; w < 8; ++w) s_ += red[(w * 3 + ci) * 256 + col];
            atomicAdd(mod + (l * 3 + ci) * 6144 + n0 + col, s_);
        }
        __syncthreads();
    }
    const int lcv = gridDim.x == 256 ? 1 : 4;
#pragma unroll 1
    for (int l = 0; l < lcv; ++l) transpose_tiles(p, smem, l);
    const int gt = blockIdx.x * 512 + tid, NT = gridDim.x * 512;
    {
        bf16_t* o = (bf16_t*)(p.ws + OFF_POOLW);
        for (int idx = gt; idx < 2 * 4 * 256 * 256; idx += NT) {
            const int lg = idx >> 16, mt = (idx >> 13) & 7, s_ = (idx >> 9) & 15, ln = (idx >> 3) & 63, jj = idx & 7;
            const int d = mt * 32 + (ln & 31), c = s_ * 16 + (ln >> 5) * 8 + jj;
            o[idx] = f2bf(p.in[I_POOLW][(lg * 256 + c) * 256 + d]);
        }
    }
    {
        bf16_t* o = (bf16_t*)(p.ws + OFF_SGUW);
        for (int idx = gt; idx < 2 * 4 * 128 * 128; idx += NT) {
            const int lh = idx >> 14, nt = (idx >> 12) & 3, s_ = (idx >> 9) & 7, ln = (idx >> 3) & 63, jj = idx & 7;
            const int pp = nt * 32 + (ln & 31), qq = s_ * 16 + (ln >> 5) * 8 + jj;
            o[idx] = f2bf(p.in[I_SGUW][(lh * 128 + pp) * 128 + qq]);
        }
    }
    {
        bf16_t* o = (bf16_t*)(p.ws + OFF_CCS);
        for (int idx = gt; idx < 256 * 128; idx += NT) {
            const int nt_ = idx >> 12, s_ = (idx >> 9) & 7, ln = (idx >> 3) & 63, jj = idx & 7;
            const int R = nt_ * 32 + (ln & 31), c = s_ * 16 + (ln >> 5) * 8 + jj, cs = R >> 7, cp = R & 127; const float x = (float)((c * cp) & 127) * (1.f / 128.f);
            const float v = cs ? __builtin_amdgcn_sinf(x) : __builtin_amdgcn_cosf(x);
            o[idx] = f2bf(v * 0.08838834764831845f);
        }
    }
    {
        bf16_t* o = (bf16_t*)(p.ws + OFF_TW256);
        for (int idx = gt; idx < 256 * 512; idx += NT) {
            const int tp = idx >> 9, k = idx & 511, t = k & 255, isS = k >> 8; const float x = (float)((t * tp) & 255) * (1.f / 256.f);
            const float v = isS ? -__builtin_amdgcn_sinf(x) : __builtin_amdgcn_cosf(x);
            o[idx] = f2bf(v * 0.0625f);
        }
    }
    {
        unsigned* o = (unsigned*)(p.ws + OFF_TW2K);
        for (int idx = gt; idx < 2048 * 1024; idx += NT) {
            const int tp = idx >> 10, k = (idx & 1023) * 2, t = k & 1023, isS = k >> 10;
            const float x0 = (float)((t * tp) & 2047) * (1.f / 2048.f), x1 = (float)(((t + 1) * tp) & 2047) * (1.f / 2048.f);
            float v0 = isS ? -__builtin_amdgcn_sinf(x0) : __builtin_amdgcn_cosf(x0);
            const float v1 = isS ? -__builtin_amdgcn_sinf(x1) : __builtin_amdgcn_cosf(x1);
            if (k == 1024) v0 = (tp & 1) ? -1.f : 1.f;
            o[idx] = cvt_pk_bf16(v0 * 0.022097086912079608f, v1 * 0.022097086912079608f);
        }
    }
    {
        bf16_t* ok = (bf16_t*)(p.ws + OFF_CTXK); bf16_t* ov = (bf16_t*)(p.ws + OFF_CTXVT);
        for (int idx = gt; idx < 2 * 2 * 256 * 512; idx += NT) {
            ok[idx] = f2bf(p.in[I_CK][idx]);
            const int t = idx & 255, dim = (idx >> 8) & 127, kvh = (idx >> 15) & 3, bj = idx >> 17;
            ov[idx] = f2bf(p.in[I_CV][((bj * 256 + t) * 4 + kvh) * 128 + dim]);
        }
    }
}

__device__ __forceinline__ void phase_rows(const Params& p, const int l, LAS unsigned char* lds) {
    const int tid = my_tid(), wave = tid >> 6, lane = tid & 63;
    const float* mod = (const float*)(p.ws + OFF_MOD);
    const bf16_t* ybuf = (const bf16_t*)(p.ws + OFF_Y);
    bf16_t* hbuf = (bf16_t*)(p.ws + OFF_H);
    LAS float* vl = (LAS float*)lds;
    {
        const int l1 = l + 1;
        f32x4 tv[11];
        const int c4 = tid * 4;
#pragma unroll
        for (int vsel = 0; vsel < 11; ++vsel) {
            const float* src = nullptr;
            if (vsel < 3) { if (l >= 0) src = mod + (l * 3 + vsel) * 6144 + 4096; }
            else if (vsel == 3) { if (l >= 0) src = p.in[I_NPOST] + l * 2048; }
            else if (vsel < 7) { if (l < 3) src = mod + (l1 * 3 + (vsel - 4)) * 6144; }
            else if (vsel < 10) { if (l < 3) src = mod + (l1 * 3 + (vsel - 7)) * 6144 + 2048; }
            else { if (l < 3) src = p.in[I_NPRE] + l1 * 2048; }
            tv[vsel] = (f32x4){0.f, 0.f, 0.f, 0.f};
            if (src) tv[vsel] = *(const GAS f32x4*)(src + c4);
        }
#pragma unroll
        for (int vsel = 0; vsel < 11; ++vsel) *(LAS f32x4*)(vl + vsel * 2048 + c4) = tv[vsel];
        __syncthreads();
    }
    for (int row = blockIdx.x * 8 + wave; row < MROWS; row += gridDim.x * 8) {
        const int ci = row < NPROMPT ? 0 : 1 + ((row - NPROMPT) >> 11);
        bf16_t* xb = (bf16_t*)(p.ws + OFF_XB) + (size_t)row * DM;
        f32x4 x[8];
        if (l <= 0) {
            const float* xs = row < NPROMPT ? p.in[I_XP] + (size_t)row * DM : p.in[I_XS] + (size_t)(row - NPROMPT) * DM;
#pragma unroll
            for (int i = 0; i < 8; ++i) x[i] = __builtin_nontemporal_load((const GAS f32x4*)(xs + i * 256 + lane * 4));
        } else {
#pragma unroll
            for (int i = 0; i < 8; ++i) { const u32x2 xw = __builtin_nontemporal_load((const GAS u32x2*)(xb + i * 256 + lane * 4)); x[i][0] = bflo(xw.x); x[i][1] = bfhi(xw.x); x[i][2] = bflo(xw.y); x[i][3] = bfhi(xw.y); }
        }
        if (l >= 0) {
            f32x4 y[8]; float ss = 0.f;
#pragma unroll
            for (int i = 0; i < 8; ++i) { const u32x2 yw = __builtin_nontemporal_load((const GAS u32x2*)(ybuf + (size_t)row * DM + i * 256 + lane * 4)); y[i][0] = bflo(yw.x); y[i][1] = bfhi(yw.x); y[i][2] = bflo(yw.y); y[i][3] = bfhi(yw.y); ss += y[i][0] * y[i][0] + y[i][1] * y[i][1] + y[i][2] * y[i][2] + y[i][3] * y[i][3]; }
            ss = wave_sum(ss);
            const float r = rsqrtf(ss * (1.f / 2048.f) + 1e-6f);
            const LAS float* gate = vl + ci * 2048; const LAS float* np = vl + 3 * 2048;
#pragma unroll
            for (int i = 0; i < 8; ++i) {
                const f32x4 g = *(const LAS f32x4*)(gate + i * 256 + lane * 4), w = *(const LAS f32x4*)(np + i * 256 + lane * 4);
#pragma unroll
                for (int e = 0; e < 4; ++e) x[i][e] += g[e] * (y[i][e] * r * w[e]);
                if (l == 3) *(GAS f32x4*)(p.out + (size_t)row * DM + i * 256 + lane * 4) = x[i];
                else { u32x2 xo; xo.x = cvt_pk_bf16(x[i][0], x[i][1]); xo.y = cvt_pk_bf16(x[i][2], x[i][3]); *(GAS u32x2*)(xb + i * 256 + lane * 4) = xo; }
            }
        }
        if (l < 3) {
            const int l1 = l + 1;
            float ss = 0.f;
#pragma unroll
            for (int i = 0; i < 8; ++i) ss += x[i][0] * x[i][0] + x[i][1] * x[i][1] + x[i][2] * x[i][2] + x[i][3] * x[i][3];
            ss = wave_sum(ss);
            const float r = rsqrtf(ss * (1.f / 2048.f) + 1e-6f);
            const LAS float* shift = vl + (4 + ci) * 2048; const LAS float* scale = vl + (7 + ci) * 2048; const LAS float* np = vl + 10 * 2048;
#pragma unroll
            for (int i = 0; i < 8; ++i) {
                const f32x4 sh = *(const LAS f32x4*)(shift + i * 256 + lane * 4), sl = *(const LAS f32x4*)(scale + i * 256 + lane * 4), w = *(const LAS f32x4*)(np + i * 256 + lane * 4);
                float hv[4];
#pragma unroll
                for (int e = 0; e < 4; ++e) hv[e] = (x[i][e] * r * w[e]) * (1.f + sl[e]) + sh[e];
                u32x2 o; o.x = cvt_pk_bf16(hv[0], hv[1]); o.y = cvt_pk_bf16(hv[2], hv[3]);
                *(u32x2*)(hbuf + (size_t)row * DM + i * 256 + lane * 4) = o;
            }
        }
    }
}

struct EpiProj {
    static constexpr bool PERM = true, AFTER_DRAIN = false;
    bf16_t* O; float* outk; float* outv; int even, j;
    __device__ __forceinline__ void operator()(const f32x4 (&acc)[2][2][4][2], const pg8::Unit& u, int wr, int wc, int fr, int fq) const {
        asm volatile("" : "+v"(fr), "+v"(fq));
        const int rloc0 = wr * 64 + fr, col0 = u.pn * 256 + wc * 32 + 8 * fq;
        const bool kv = even && u.pm < 32 && u.pn >= 6 && u.pn < 10;
        float* cbase = nullptr;
        if (kv) cbase = (u.pn < 8 ? outk : outv) + ((size_t)(u.pm * 2 + j) * 256) * 512 + ((u.pn & 1) * 256 + wc * 32 + 8 * fq);
#pragma unroll
        for (int ai = 0; ai < 2; ++ai)
#pragma unroll
            for (int m = 0; m < 4; ++m) {
                const int rloc = rloc0 + ai * 128 + m * 16;
                bf16_t* rowp = O + (size_t)(u.pm * 256 + rloc) * INW + col0;
#pragma unroll
                for (int bj = 0; bj < 2; ++bj) {
                    const f32x4 v0 = acc[ai][bj][m][0], v1 = acc[ai][bj][m][1];
                    u32x4 w; w.x = cvt_pk_bf16(v0[0], v0[1]); w.y = cvt_pk_bf16(v0[2], v0[3]); w.z = cvt_pk_bf16(v1[0], v1[1]); w.w = cvt_pk_bf16(v1[2], v1[3]);
                    *(u32x4*)(rowp + bj * 128) = w;
                    if (kv) { float* cp = cbase + (size_t)rloc * 512 + bj * 128; *(f32x4*)cp = v0; *(f32x4*)(cp + 4) = v1; }
                    __builtin_amdgcn_sched_barrier(0);
                }
            }
    }
};
struct EpiY {
    static constexpr bool PERM = true, AFTER_DRAIN = false;
    bf16_t* C;
    __device__ __forceinline__ void operator()(const f32x4 (&acc)[2][2][4][2], const pg8::Unit& u, int wr, int wc, int fr, int fq) const {
        asm volatile("" : "+v"(fr), "+v"(fq));
        const int row0 = u.pm * 256 + wr * 64 + fr, col0 = u.pn * 256 + wc * 32 + 8 * fq;
#pragma unroll
        for (int ai = 0; ai < 2; ++ai)
#pragma unroll
            for (int m = 0; m < 4; ++m) {
                bf16_t* rowp = C + (size_t)(row0 + ai * 128 + m * 16) * DM + col0;
#pragma unroll
                for (int bj = 0; bj < 2; ++bj) {
                    const f32x4 v0 = acc[ai][bj][m][0], v1 = acc[ai][bj][m][1];
                    u32x4 w; w.x = cvt_pk_bf16(v0[0], v0[1]); w.y = cvt_pk_bf16(v0[2], v0[3]); w.z = cvt_pk_bf16(v1[0], v1[1]); w.w = cvt_pk_bf16(v1[2], v1[3]);
                    *(u32x4*)(rowp + bj * 128) = w;
                }
            }
    }
};
struct EpiFnet {
    static constexpr bool PERM = true, AFTER_DRAIN = false;
    const bf16_t* proj; bf16_t* O; int rowbase0, T; const float* yh;
    __device__ __forceinline__ void operator()(const f32x4 (&acc)[2][2][4][2], const pg8::Unit& u, int wr, int wc, int fr, int fq) const {
        asm volatile("" : "+v"(fr), "+v"(fq));
        const int row0 = rowbase0 + (u.pn >> 1) * T + u.pm * 256 + wr * 64 + fr, col0 = (u.pn & 1) * 256 + wc * 32 + 8 * fq;
#pragma unroll
        for (int ai = 0; ai < 2; ++ai)
#pragma unroll
            for (int m = 0; m < 4; ++m) {
                const size_t row = (size_t)(row0 + ai * 128 + m * 16);
#pragma unroll
                for (int bj = 0; bj < 2; ++bj) {
                    const u32x4 g = *(const u32x4*)(proj + row * INW + 4608 + col0 + bj * 128);
                    f32x4 v0 = acc[ai][bj][m][0], v1 = acc[ai][bj][m][1];
                    if (yh) { const float sg = (fr & 1) ? -0.022097086912079608f : 0.022097086912079608f; const float* yp = yh + (u.pn >> 1) * 512 + col0 + bj * 128;
                        const f32x4 y0 = *(const GAS f32x4*)yp, y1 = *(const GAS f32x4*)(yp + 4); v0 += y0 * sg; v1 += y1 * sg; }
                    u32x4 w;
                    w.x = cvt_pk_bf16(v0[0] * silu(bflo(g.x)), v0[1] * silu(bfhi(g.x))); w.y = cvt_pk_bf16(v0[2] * silu(bflo(g.y)), v0[3] * silu(bfhi(g.y)));
                    w.z = cvt_pk_bf16(v1[0] * silu(bflo(g.z)), v1[1] * silu(bfhi(g.z))); w.w = cvt_pk_bf16(v1[2] * silu(bflo(g.w)), v1[3] * silu(bfhi(g.w)));
                    *(u32x4*)(O + row * DM + 1536 + col0 + bj * 128) = w;
                    __builtin_amdgcn_sched_barrier(0);
                }
            }
    }
};

__device__ __forceinline__ void phase_even_prep(const Params& p, const int lj, LAS unsigned char* lds) {
    const int tid = my_tid(), wave = tid >> 6, lane = tid & 63, l32 = lane & 31, h = lane >> 5;
    bf16_t* proj = (bf16_t*)(p.ws + OFF_PROJ);
    const bf16_t* ccs = (const bf16_t*)(p.ws + OFF_CCS);
    if ((int)blockIdx.x * 8 < 1024 || (int)(gridDim.x * 8 - 1) - ((int)blockIdx.x * 8 + 7) < 256) {
#pragma unroll
        for (int i = 0; i < 8; ++i) { const int idx = tid + 512 * i; *(LAS u32x4*)(lds + idx * 16) = *(const GAS u32x4*)(ccs + idx * 8); }
        __syncthreads();
    }
    for (int task = blockIdx.x * 8 + wave; task < 256 * 4; task += gridDim.x * 8) {
        const int rb = task >> 2, g = task & 3, row0 = rb * 32;
        bf16x8 af[8];
        const bf16_t* ap = proj + (size_t)(row0 + l32) * INW + 4096 + g * 128 + 8 * h;
#pragma unroll
        for (int s = 0; s < 8; ++s) af[s] = ld16(ap + 16 * s);
        bf16_t* yt; int T, tl0;
        if (row0 < NPROMPT) { T = 256; tl0 = row0 & 255; yt = (bf16_t*)(p.ws + OFF_YTP) + (size_t)(row0 >> 8) * 512 * 512; }
        else { T = 2048; tl0 = (row0 - NPROMPT) & 2047; yt = (bf16_t*)(p.ws + OFF_YTS) + (size_t)((row0 - NPROMPT) >> 11) * 512 * 4096; }
#pragma unroll 1
        for (int nt = 0; nt < 8; ++nt) {
            const int R = nt * 32 + l32;
            const LAS unsigned char* bp = lds + nt * 8192 + lane * 16;
            f32x16 acc;
#pragma unroll
            for (int r = 0; r < 16; ++r) acc[r] = 0.f;
#pragma unroll
            for (int s = 0; s < 8; ++s) acc = mfma32(af[s], *(const LAS bf16x8*)(bp + 1024 * s), acc);
            const int cs = R >> 7, cp = R & 127;
            bf16_t* dst = yt + (size_t)(g * 128 + cp) * (2 * T) + cs * T + tl0 + 4 * h;
#pragma unroll
            for (int q = 0; q < 4; ++q) {
                u32x2 w; w.x = cvt_pk_bf16(acc[4 * q], acc[4 * q + 1]); w.y = cvt_pk_bf16(acc[4 * q + 2], acc[4 * q + 3]);
                *(u32x2*)(dst + 8 * q) = w;
            }
        }
    }
    for (int task = (gridDim.x * 8 - 1) - (blockIdx.x * 8 + wave); task < 256; task += gridDim.x * 8) {
        const int g = task & 3, kb = (task >> 2) & 31, b = task >> 7;
        const int t = kb * 32 + l32, tp = (t == 0) ? 0 : 2048 - t;
        const bf16_t* xa = proj + (size_t)(NPROMPT + b * 2048 + t) * INW + 4096 + g * 128 + 8 * h;
        const bf16_t* ya = proj + (size_t)(NPROMPT + b * 2048 + tp) * INW + 4096 + g * 128 + 8 * h;
        bf16x8 ae[8], ao[8];
#pragma unroll
        for (int s = 0; s < 8; ++s) {
            const u32x4 x = *(const GAS u32x4*)(xa + 16 * s), y = *(const GAS u32x4*)(ya + 16 * s);
            u32x4 e, o;
#pragma unroll
            for (int q = 0; q < 4; ++q) {
                const unsigned xw = q == 0 ? x.x : q == 1 ? x.y : q == 2 ? x.z : x.w, yw = q == 0 ? y.x : q == 1 ? y.y : q == 2 ? y.z : y.w;
                const float x0 = bflo(xw), x1 = bfhi(xw), y0 = bflo(yw), y1 = bfhi(yw);
                const unsigned ew = (t == 0) ? xw : cvt_pk_bf16(x0 + y0, x1 + y1), ow = (t == 0) ? 0u : cvt_pk_bf16(x0 - y0, x1 - y1);
                if (q == 0) { e.x = ew; o.x = ow; } else if (q == 1) { e.y = ew; o.y = ow; } else if (q == 2) { e.z = ew; o.z = ow; } else { e.w = ew; o.w = ow; }
            }
            ae[s] = __builtin_bit_cast(bf16x8, e); ao[s] = __builtin_bit_cast(bf16x8, o);
        }
        bf16_t* yt = (bf16_t*)(p.ws + OFF_YTS) + (size_t)(lj * 2 + b) * 512 * 2048;
#pragma unroll 1
        for (int nt = 0; nt < 4; ++nt) {
            const LAS unsigned char* bp = lds + nt * 8192 + lane * 16;
            f32x16 acc;
#pragma unroll
            for (int r = 0; r < 16; ++r) acc[r] = 0.f;
#pragma unroll
            for (int s = 0; s < 8; ++s) acc = mfma32(ae[s], *(const LAS bf16x8*)(bp + 1024 * s), acc);
            bf16_t* dst = yt + (size_t)(g * 128 + nt * 32 + l32) * 2048 + kb * 32 + 4 * h;
#pragma unroll
            for (int q = 0; q < 4; ++q) { u32x2 w; w.x = cvt_pk_bf16(acc[4 * q], acc[4 * q + 1]); w.y = cvt_pk_bf16(acc[4 * q + 2], acc[4 * q + 3]); *(GAS u32x2*)(dst + 8 * q) = w; }
        }
#pragma unroll 1
        for (int nt = 0; nt < 4; ++nt) {
            const LAS unsigned char* bp = lds + (nt + 4) * 8192 + lane * 16;
            f32x16 acc;
#pragma unroll
            for (int r = 0; r < 16; ++r) acc[r] = 0.f;
#pragma unroll
            for (int s = 0; s < 8; ++s) acc = mfma32(ao[s], *(const LAS bf16x8*)(bp + 1024 * s), acc);
            bf16_t* dst = yt + (size_t)(g * 128 + nt * 32 + l32) * 2048 + 1024 + kb * 32 + 4 * h;
#pragma unroll
            for (int q = 0; q < 4; ++q) { u32x2 w; w.x = cvt_pk_bf16(acc[4 * q], acc[4 * q + 1]); w.y = cvt_pk_bf16(acc[4 * q + 2], acc[4 * q + 3]); *(GAS u32x2*)(dst + 8 * q) = w; }
        }
    }
    const int gt = blockIdx.x * 512 + tid, NT = gridDim.x * 512;
    for (int idx = gt; idx < 1024; idx += NT) {
        const int b = idx >> 9, n = idx & 511, g = n >> 7, cp = n & 127;
        const bf16_t* up = proj + (size_t)(NPROMPT + b * 2048 + 1024) * INW + 4096 + g * 128;
        float a = 0.f;
        u32x4 uv[16];
#pragma unroll
        for (int i = 0; i < 16; ++i) uv[i] = *(const GAS u32x4*)(up + 8 * i);
#pragma unroll
        for (int i = 0; i < 16; ++i)
#pragma unroll
            for (int e = 0; e < 4; ++e) {
                const unsigned w = e == 0 ? uv[i].x : e == 1 ? uv[i].y : e == 2 ? uv[i].z : uv[i].w; const int c = i * 8 + e * 2;
                a += bflo(w) * __builtin_amdgcn_cosf((float)((c * cp) & 127) * (1.f / 128.f)) + bfhi(w) * __builtin_amdgcn_cosf((float)(((c + 1) * cp) & 127) * (1.f / 128.f));
            }
        ((float*)(p.ws + OFF_YH))[lj * 1024 + idx] = a * 0.08838834764831845f;
    }
    for (int idx = gt; idx < 4096 * 16 * 2 * 4; idx += NT) {
        const int ib = idx & 3, a = (idx >> 2) & 1, head = (idx >> 3) & 15, rs = idx >> 7;
        const int t = rs & 2047; const float pos = (float)(a == 0 ? (t >> 6) : (t & 63));
        bf16_t* x1p = proj + (size_t)(NPROMPT + rs) * INW + head * 128 + a * 64 + ib * 8;
        const u32x4 x1 = *(const u32x4*)x1p, x2 = *(const u32x4*)(x1p + 32);
        u32x4 o1, o2;
#pragma unroll
        for (int e = 0; e < 4; ++e) {
            const unsigned w1 = e == 0 ? x1.x : e == 1 ? x1.y : e == 2 ? x1.z : x1.w, w2 = e == 0 ? x2.x : e == 1 ? x2.y : e == 2 ? x2.z : x2.w;
            float r1[2], r2[2];
#pragma unroll
            for (int q = 0; q < 2; ++q) {
                const int i = ib * 8 + e * 2 + q;
                const float inv = __builtin_amdgcn_exp2f(-(float)i * (13.287712379549449f / 32.f));
                const float rev = pos * inv * 0.15915494309189535f;
                const float cc = __builtin_amdgcn_cosf(rev), sn = __builtin_amdgcn_sinf(rev);
                const float a1 = q ? bfhi(w1) : bflo(w1), a2 = q ? bfhi(w2) : bflo(w2);
                r1[q] = a1 * cc - a2 * sn; r2[q] = a2 * cc + a1 * sn;
            }
            const unsigned p1 = cvt_pk_bf16(r1[0], r1[1]), p2 = cvt_pk_bf16(r2[0], r2[1]);
            if (e == 0) { o1.x = p1; o2.x = p2; } else if (e == 1) { o1.y = p1; o2.y = p2; } else if (e == 2) { o1.z = p1; o2.z = p2; } else { o1.w = p1; o2.w = p2; }
        }
        *(u32x4*)x1p = o1; *(u32x4*)(x1p + 32) = o2;
    }
    bf16_t* vt = (bf16_t*)(p.ws + OFF_VT);
    for (int idx = gt; idx < 1536 * 512; idx += NT) {
        const int cd = idx & 511, r8 = idx >> 9, row0 = r8 * 8;
        int rowbase, T;
        if (row0 < NPROMPT) { rowbase = row0 & ~255; T = 256; } else { rowbase = NPROMPT + ((row0 - NPROMPT) & ~2047); T = 2048; }
        const bf16_t* src = proj + (size_t)row0 * INW + 2048 + cd;
        unsigned short v[8];
#pragma unroll
        for (int j = 0; j < 8; ++j) v[j] = src[(size_t)j * INW];
        u32x4 w; w.x = v[0] | ((unsigned)v[1] << 16); w.y = v[2] | ((unsigned)v[3] << 16); w.z = v[4] | ((unsigned)v[5] << 16); w.w = v[6] | ((unsigned)v[7] << 16);
        *(u32x4*)(vt + (size_t)rowbase * 512 + (size_t)cd * T + (row0 - rowbase)) = w;
    }
}

constexpr int AT_KROW = 272, AT_VROW = 136, AT_KBYTES = 64 * AT_KROW, AT_BUF = AT_KBYTES + 128 * AT_VROW;
__device__ __forceinline__ void attn_item(const Params& p, const int item, const int j, LAS unsigned char* lds) {
    const int tid = my_tid(), wave = __builtin_amdgcn_readfirstlane(tid >> 6), lane = tid & 63, l32 = lane & 31, h = lane >> 5;
    int rowbase, T, qh, bs = -1, q0c = 0;
    if (item < 192) { bs = item / 96; const int rem = item % 96; qh = rem >> 3; q0c = (rem & 7) * 256; rowbase = NPROMPT + bs * 2048; T = 2048; }
    else { const int pi = item - 192; rowbase = (pi / 12) * 256; qh = pi % 12; T = 256; }
    const int kvh = qh / 3, q0 = q0c + wave * 32;
    const bf16_t* proj = (const bf16_t*)(p.ws + OFF_PROJ);
    bf16x8 qf[8];
    {
        const bf16_t* qp = proj + (size_t)(rowbase + q0 + l32) * INW + qh * 128 + 8 * h;
#pragma unroll
        for (int s = 0; s < 8; ++s) qf[s] = ldg16(qp + 16 * s);
    }
    float m = p.in[I_SINK][j * 12 + qh] * LOG2E, lsum = (h == 0) ? 1.f : 0.f;
    f32x16 oacc[4];
#pragma unroll
    for (int dt = 0; dt < 4; ++dt)
#pragma unroll
        for (int r = 0; r < 16; ++r) oacc[dt][r] = 0.f;
    int kl0 = 0, kl1 = 256, nctx = 0;
    if (bs >= 0) { kl0 = max(0, q0c - 128); kl1 = min(T, q0c + 384); nctx = 4; }
    const int nlc = (kl1 - kl0) >> 6, nch = nlc + nctx;
    const bf16_t* kg = proj + (size_t)rowbase * INW + 1536 + kvh * 128;
    const bf16_t* vg = (const bf16_t*)(p.ws + OFF_VT) + (size_t)rowbase * 512 + (size_t)(kvh * 128) * T;
    const bf16_t* ckg = (const bf16_t*)(p.ws + OFF_CTXK) + (size_t)((max(bs, 0) * 2 + j) * 256) * 512 + kvh * 128;
    const bf16_t* cvg = (const bf16_t*)(p.ws + OFF_CTXVT) + (size_t)(((max(bs, 0) * 2 + j) * 4 + kvh) * 128) * 256;
    const int krow = tid >> 4, kc16 = tid & 15, vrow = tid >> 3, vc16 = tid & 7;
    u32x4 skA[2], svA[2], skB[2], svB[2];
    auto stage_load = [&](const int ci, u32x4 (&sk)[2], u32x4 (&sv)[2]) {
        const bf16_t* kb; const bf16_t* vb; size_t kst, vst;
        if (ci < nlc) { const int ks = kl0 + 64 * ci; kb = kg + (size_t)ks * INW; kst = INW; vb = vg + ks; vst = (size_t)T; }
        else { const int ks = 64 * (ci - nlc); kb = ckg + (size_t)ks * 512; kst = 512; vb = cvg + ks; vst = 256; }
#pragma unroll
        for (int i = 0; i < 2; ++i) {
            sk[i] = *(const GAS u32x4*)(kb + (size_t)(krow + 32 * i) * kst + kc16 * 8);
            sv[i] = *(const GAS u32x4*)(vb + (size_t)(vrow + 64 * i) * vst + vc16 * 8);
        }
    };
    auto stage_store = [&](const int b, const u32x4 (&sk)[2], const u32x4 (&sv)[2]) {
        LAS unsigned char* base = lds + b * AT_BUF;
#pragma unroll
        for (int i = 0; i < 2; ++i) {
            *(LAS u32x4*)(base + (krow + 32 * i) * AT_KROW + kc16 * 16) = sk[i];
            LAS unsigned char* vd = base + AT_KBYTES + (vrow + 64 * i) * AT_VROW + vc16 * 16;
            u32x2 lo, hi; lo.x = sv[i].x; lo.y = sv[i].y; hi.x = sv[i].z; hi.y = sv[i].w;
            *(LAS u32x2*)vd = lo; *(LAS u32x2*)(vd + 8) = hi;
        }
    };
    constexpr float sc = 0.08838834764831845f * LOG2E;
    __syncthreads();
    stage_load(0, skA, svA); stage_store(0, skA, svA);
    if (nch > 1) stage_load(1, skA, svA);
    __syncthreads();
    auto chunk_step = [&](const int ci, u32x4 (&skc)[2], u32x4 (&svc)[2], u32x4 (&skn)[2], u32x4 (&svn)[2]) {
        if (ci + 2 < nch) stage_load(ci + 2, skn, svn);
        const LAS unsigned char* kbuf = lds + (ci & 1) * AT_BUF;
        const LAS unsigned char* vbuf = kbuf + AT_KBYTES;
        const bool local = ci < nlc;
        const int kc0 = kl0 + 64 * ci;
#pragma unroll 1
        for (int tt = 0; tt < 2; ++tt) {
            const int kt = kc0 + 32 * tt;
            bool masked = false;
            if (local && bs >= 0) { const int d = kt - (q0 - 128); if (d < 0 || d > 256) continue; masked = (d == 0 || d == 256); }
            bf16x8 kf[8];
            const LAS unsigned char* kp = kbuf + (tt * 32 + l32) * AT_KROW + 16 * h;
#pragma unroll
            for (int ks = 0; ks < 8; ++ks) kf[ks] = *(const LAS bf16x8*)(kp + 32 * ks);
            f32x16 s;
#pragma unroll
            for (int r = 0; r < 16; ++r) s[r] = 0.f;
#pragma unroll
            for (int ks = 0; ks < 8; ++ks) s = mfma32(kf[ks], qf[ks], s);
            bf16x8 vf[8];
            const LAS unsigned char* vp = vbuf + l32 * AT_VROW + (tt * 32 + 4 * h) * 2;
#pragma unroll
            for (int dt = 0; dt < 4; ++dt)
#pragma unroll
                for (int c = 0; c < 2; ++c) {
                    const bf16x4 a = *(const LAS bf16x4*)(vp + dt * 32 * AT_VROW + c * 32), b = *(const LAS bf16x4*)(vp + dt * 32 * AT_VROW + c * 32 + 16);
                    vf[dt * 2 + c] = __builtin_shufflevector(a, b, 0, 1, 2, 3, 4, 5, 6, 7);
                }
            float tmax = -3.0e38f;
            if (masked) {
                const int dqk = (q0 + l32) - kt - 4 * h;
#pragma unroll
                for (int r = 0; r < 16; ++r) { const int d = dqk - (8 * (r >> 2) + (r & 3)); if (d > 128 || d < -128) s[r] = -1.0e30f; tmax = fmaxf(tmax, s[r]); }
            } else {
#pragma unroll
                for (int r = 0; r < 16; ++r) tmax = fmaxf(tmax, s[r]);
            }
            { const auto rr = __builtin_amdgcn_permlane32_swap(__float_as_uint(tmax), __float_as_uint(tmax), false, false);
              tmax = fmaxf(__uint_as_float(rr[0]), __uint_as_float(rr[1])) * sc; }
            if (!__all(tmax - m <= 8.0f)) {
                const float mn = fmaxf(m, tmax), alpha = __builtin_amdgcn_exp2f(m - mn);
                m = mn; lsum *= alpha;
#pragma unroll
                for (int dt = 0; dt < 4; ++dt)
#pragma unroll
                    for (int r = 0; r < 16; ++r) oacc[dt][r] *= alpha;
            }
            float ps = 0.f;
#pragma unroll
            for (int r = 0; r < 16; ++r) { s[r] = __builtin_amdgcn_exp2f(__builtin_fmaf(s[r], sc, -m)); ps += s[r]; }
            lsum += ps;
            bf16x8 pb[2];
#pragma unroll
            for (int c = 0; c < 2; ++c) {
                u32x4 w; w.x = cvt_pk_bf16(s[8 * c + 0], s[8 * c + 1]); w.y = cvt_pk_bf16(s[8 * c + 2], s[8 * c + 3]); w.z = cvt_pk_bf16(s[8 * c + 4], s[8 * c + 5]); w.w = cvt_pk_bf16(s[8 * c + 6], s[8 * c + 7]);
                pb[c] = __builtin_bit_cast(bf16x8, w);
            }
#pragma unroll
            for (int dt = 0; dt < 4; ++dt)
#pragma unroll
                for (int c = 0; c < 2; ++c) oacc[dt] = mfma32(vf[dt * 2 + c], pb[c], oacc[dt]);
        }
        if (ci + 1 < nch) stage_store((ci + 1) & 1, skc, svc);
        __syncthreads();
    };
#pragma unroll 1
    for (int ci = 0; ci < nch; ci += 2) {
        chunk_step(ci, skA, svA, skB, svB);
        if (ci + 1 < nch) chunk_step(ci + 1, skB, svB, skA, svA);
    }
    const float lt = lsum + __shfl_xor(lsum, 32), inv = 1.f / lt;
    const size_t row = (size_t)(rowbase + q0 + l32);
    const bf16_t* gp = proj + row * INW + 2560 + qh * 128 + 4 * h;
    bf16_t* op = (bf16_t*)(p.ws + OFF_O) + row * DM + qh * 128 + 4 * h;
#pragma unroll
    for (int dt = 0; dt < 4; ++dt)
#pragma unroll
        for (int g4 = 0; g4 < 4; ++g4) {
            const u32x2 g = *(const GAS u32x2*)(gp + 32 * dt + 8 * g4);
            u32x2 w;
            w.x = cvt_pk_bf16(oacc[dt][4 * g4 + 0] * inv * silu(bflo(g.x)), oacc[dt][4 * g4 + 1] * inv * silu(bfhi(g.x)));
            w.y = cvt_pk_bf16(oacc[dt][4 * g4 + 2] * inv * silu(bflo(g.y)), oacc[dt][4 * g4 + 3] * inv * silu(bfhi(g.y)));
            *(GAS u32x2*)(op + 32 * dt + 8 * g4) = w;
        }
}

constexpr int PL_PITCH = 528;
constexpr int PL_POOLED = 80 * 528;
template <int HW>
__device__ __forceinline__ void pool_body(const Params& p, const int lj, const int g, const int row0, const int rowbase, const int T, LAS unsigned char* lds,
                                          const int tid, const int wave, const int lane, const int l32, const int h) {
    const bf16_t* proj = (const bf16_t*)(p.ws + OFF_PROJ);
    const int tl0 = row0 - rowbase;
    constexpr int NR = 64 + 2 * HW;
    bf16x8 afr[2][16];
    {
        const bf16_t* wt_ = (const bf16_t*)(p.ws + OFF_POOLW) + (size_t)((lj * 4 + g) * 8 + 2 * (wave >> 1)) * 8192 + lane * 8;
#pragma unroll
        for (int s = 0; s < 16; ++s) { afr[0][s] = ldg16(wt_ + 512 * s); afr[1][s] = ldg16(wt_ + 8192 + 512 * s); }
    }
    if (tid < 64) *(LAS f32x4*)(lds + 77824 + tid * 16) = *(const GAS f32x4*)(p.in[I_POOLS] + lj * 1024 + g * 256 + tid * 4);
    for (int idx = tid; idx < NR * 32; idx += 512) {
        const int r = idx >> 5, c16 = idx & 31, tt = tl0 - HW + r;
        u32x4 v; v.x = 0u; v.y = 0u; v.z = 0u; v.w = 0u;
        if (tt >= 0 && tt < T) v = *(const GAS u32x4*)(proj + (size_t)(rowbase + tt) * INW + g * 256 + c16 * 8);
        *(LAS u32x4*)(lds + r * PL_PITCH + c16 * 16) = v;
    }
    __syncthreads();
    const int ts = wave & 1, mp = wave >> 1;
    {
        const int tl = tl0 + ts * 32 + l32;
        const float rc = 1.f / (float)(min(tl + HW, T) - max(tl - HW, 0));
        const LAS unsigned char* sp = lds + (ts * 32 + l32) * PL_PITCH + 16 * h;
        LAS unsigned char* pp = lds + PL_POOLED + (ts * 32 + l32) * PL_PITCH + 16 * h;
#pragma unroll 1
        for (int s4 = 0; s4 < 4; ++s4) {
            const int s = mp * 4 + s4;
            float sum[8];
#pragma unroll
            for (int e = 0; e < 8; ++e) sum[e] = 0.f;
#pragma unroll
            for (int d = 0; d < 2 * HW; ++d) {
                const u32x4 v = *(const LAS u32x4*)(sp + d * PL_PITCH + 32 * s);
                sum[0] += bflo(v.x); sum[1] += bfhi(v.x); sum[2] += bflo(v.y); sum[3] += bfhi(v.y);
                sum[4] += bflo(v.z); sum[5] += bfhi(v.z); sum[6] += bflo(v.w); sum[7] += bfhi(v.w);
            }
            const u32x4 sv = *(const LAS u32x4*)(sp + HW * PL_PITCH + 32 * s);
            u32x4 w;
            w.x = cvt_pk_bf16(sum[0] * rc - bflo(sv.x), sum[1] * rc - bfhi(sv.x)); w.y = cvt_pk_bf16(sum[2] * rc - bflo(sv.y), sum[3] * rc - bfhi(sv.y));
            w.z = cvt_pk_bf16(sum[4] * rc - bflo(sv.z), sum[5] * rc - bfhi(sv.z)); w.w = cvt_pk_bf16(sum[6] * rc - bflo(sv.w), sum[7] * rc - bfhi(sv.w));
            *(LAS u32x4*)(pp + 32 * s) = w;
        }
    }
    __syncthreads();
    const LAS unsigned char* bp_ = lds + PL_POOLED + (ts * 32 + l32) * PL_PITCH + 16 * h;
    f32x16 acc[2];
#pragma unroll
    for (int m2 = 0; m2 < 2; ++m2)
#pragma unroll
        for (int r = 0; r < 16; ++r) acc[m2][r] = 0.f;
#pragma unroll
    for (int s = 0; s < 16; ++s) {
        const bf16x8 bfr = *(const LAS bf16x8*)(bp_ + 32 * s);
        acc[0] = mfma32(afr[0][s], bfr, acc[0]); acc[1] = mfma32(afr[1][s], bfr, acc[1]);
    }
    const int row = row0 + ts * 32 + l32;
    const LAS float* psc = (const LAS float*)(lds + 77824) + 4 * h;
    const bf16_t* gp = proj + (size_t)row * INW + 1024 + g * 256 + 4 * h;
    bf16_t* op = (bf16_t*)(p.ws + OFF_O) + (size_t)row * DM + g * 256 + 4 * h;
#pragma unroll
    for (int m2 = 0; m2 < 2; ++m2)
#pragma unroll
        for (int g4 = 0; g4 < 4; ++g4) {
            const int c0 = (2 * mp + m2) * 32 + 8 * g4;
            const u32x2 gg = *(const GAS u32x2*)(gp + c0);
            const f32x4 ps = *(const LAS f32x4*)(psc + c0);
            u32x2 w;
            w.x = cvt_pk_bf16(acc[m2][4 * g4 + 0] * ps[0] * silu(bflo(gg.x)), acc[m2][4 * g4 + 1] * ps[1] * silu(bfhi(gg.x)));
            w.y = cvt_pk_bf16(acc[m2][4 * g4 + 2] * ps[2] * silu(bflo(gg.y)), acc[m2][4 * g4 + 3] * ps[3] * silu(bfhi(gg.y)));
            *(GAS u32x2*)(op + c0) = w;
        }
}
__device__ __forceinline__ void pool_item(const Params& p, const int item, const int lj, LAS unsigned char* lds) {
    const int tid = my_tid(), wave = __builtin_amdgcn_readfirstlane(tid >> 6), lane = tid & 63, l32 = lane & 31, h = lane >> 5;
    const int tb = item >> 2, gs = item & 3, g = gs == 0 ? 0 : gs == 1 ? 3 : gs == 2 ? 1 : 2;
    const int row0 = tb * 64;
    int rowbase, T;
    if (row0 < NPROMPT) { rowbase = row0 & ~255; T = 256; } else { rowbase = NPROMPT + ((row0 - NPROMPT) & ~2047); T = 2048; }
    __syncthreads();
    if (g == 0) pool_body<1>(p, lj, g, row0, rowbase, T, lds, tid, wave, lane, l32, h);
    else if (g == 1) pool_body<2>(p, lj, g, row0, rowbase, T, lds, tid, wave, lane, l32, h);
    else if (g == 2) pool_body<4>(p, lj, g, row0, rowbase, T, lds, tid, wave, lane, l32, h);
    else pool_body<8>(p, lj, g, row0, rowbase, T, lds, tid, wave, lane, l32, h);
}

constexpr int SGU_PITCH = 260;
__device__ __forceinline__ void sgu_item(const Params& p, const int item, const int lj, LAS unsigned char* lds) {
    const int tid = my_tid(), wave = tid >> 6, lane = tid & 63, l32 = lane & 31, h = lane >> 5;
    const int ch = item >> 2, hd = item & 3, R0 = ch * 128;
    const bf16_t* proj = (const bf16_t*)(p.ws + OFF_PROJ);
    LAS bf16_t* vn = (LAS bf16_t*)lds;
    __syncthreads();
    if (tid < 64) *(LAS f32x4*)(lds + 69632 + tid * 16) = *(const GAS f32x4*)(p.in[I_SGUN] + lj * 1024 + hd * 256 + tid * 4);
    bf16x8 wfr[4][8];
    {
        const bf16_t* wb_ = (const bf16_t*)(p.ws + OFF_SGUW) + (size_t)(lj * 4 + hd) * 16384 + lane * 8;
#pragma unroll
        for (int nt = 0; nt < 2; ++nt)
#pragma unroll
            for (int s = 0; s < 8; ++s) wfr[nt][s] = ldg16(wb_ + (size_t)nt * 4096 + 512 * s);
    }
    {
        const int q = tid >> 2, qt = tid & 3;
        const bf16_t* vp = proj + (size_t)(R0 + q) * INW + 3072 + hd * 256 + qt * 64;
        u32x4 v[8];
#pragma unroll
        for (int i = 0; i < 8; ++i) v[i] = *(const GAS u32x4*)(vp + 8 * i);
        float sm = 0.f;
#pragma unroll
        for (int i = 0; i < 8; ++i) sm += (bflo(v[i].x) + bfhi(v[i].x)) + (bflo(v[i].y) + bfhi(v[i].y)) + (bflo(v[i].z) + bfhi(v[i].z)) + (bflo(v[i].w) + bfhi(v[i].w));
        sm += __shfl_xor(sm, 1); sm += __shfl_xor(sm, 2);
        const float mu = sm * (1.f / 256.f);
        float sq = 0.f;
#pragma unroll
        for (int i = 0; i < 8; ++i) {
            float d;
            d = bflo(v[i].x) - mu; sq += d * d; d = bfhi(v[i].x) - mu; sq += d * d; d = bflo(v[i].y) - mu; sq += d * d; d = bfhi(v[i].y) - mu; sq += d * d;
            d = bflo(v[i].z) - mu; sq += d * d; d = bfhi(v[i].z) - mu; sq += d * d; d = bflo(v[i].w) - mu; sq += d * d; d = bfhi(v[i].w) - mu; sq += d * d;
        }
        sq += __shfl_xor(sq, 1); sq += __shfl_xor(sq, 2);
        const float rs = rsqrtf(sq * (1.f / 256.f) + 1e-6f);
        __syncthreads();
        const LAS float* gnp = (const LAS float*)(lds + 69632) + qt * 64;
        LAS bf16_t* dst = vn + q * SGU_PITCH + qt * 64;
#pragma unroll
        for (int i = 0; i < 8; ++i) {
            const f32x4 g0 = *(const LAS f32x4*)(gnp + 8 * i), g1 = *(const LAS f32x4*)(gnp + 8 * i + 4);
            u32x2 w0, w1;
            w0.x = cvt_pk_bf16((bflo(v[i].x) - mu) * rs * g0[0], (bfhi(v[i].x) - mu) * rs * g0[1]); w0.y = cvt_pk_bf16((bflo(v[i].y) - mu) * rs * g0[2], (bfhi(v[i].y) - mu) * rs * g0[3]);
            w1.x = cvt_pk_bf16((bflo(v[i].z) - mu) * rs * g1[0], (bfhi(v[i].z) - mu) * rs * g1[1]); w1.y = cvt_pk_bf16((bflo(v[i].w) - mu) * rs * g1[2], (bfhi(v[i].w) - mu) * rs * g1[3]);
            *(LAS u32x2*)(dst + 8 * i) = w0; *(LAS u32x2*)(dst + 8 * i + 4) = w1;
        }
    }
    __syncthreads();
    {
        const bf16_t* wb_ = (const bf16_t*)(p.ws + OFF_SGUW) + (size_t)(lj * 4 + hd) * 16384 + lane * 8;
#pragma unroll
        for (int nt = 2; nt < 4; ++nt)
#pragma unroll
            for (int s = 0; s < 8; ++s) wfr[nt][s] = ldg16(wb_ + (size_t)nt * 4096 + 512 * s);
    }
    bf16x8 af[8];
    {
        const int c = wave * 32 + l32;
#pragma unroll
        for (int s = 0; s < 8; ++s) {
            unsigned short e[8];
#pragma unroll
            for (int jj = 0; jj < 8; ++jj) e[jj] = vn[(16 * s + 8 * h + jj) * SGU_PITCH + c];
            u32x4 w; w.x = e[0] | ((unsigned)e[1] << 16); w.y = e[2] | ((unsigned)e[3] << 16); w.z = e[4] | ((unsigned)e[5] << 16); w.w = e[6] | ((unsigned)e[7] << 16);
            af[s] = __builtin_bit_cast(bf16x8, w);
        }
    }
    __syncthreads();
#pragma unroll
    for (int nt = 0; nt < 4; ++nt) {
        const int pp = nt * 32 + l32;
        f32x16 acc;
#pragma unroll
        for (int r = 0; r < 16; ++r) acc[r] = 0.f;
#pragma unroll
        for (int s = 0; s < 8; ++s) acc = mfma32(af[s], wfr[nt][s], acc);
        const float bias = p.in[I_SGUB][(lj * 4 + hd) * 128 + pp];
        LAS unsigned char* mp_ = lds + pp * PL_PITCH + (wave * 32 + 4 * h) * 2;
#pragma unroll
        for (int g4 = 0; g4 < 4; ++g4) {
            u32x2 w; w.x = cvt_pk_bf16(acc[4 * g4 + 0] + bias, acc[4 * g4 + 1] + bias); w.y = cvt_pk_bf16(acc[4 * g4 + 2] + bias, acc[4 * g4 + 3] + bias);
            *(LAS u32x2*)(mp_ + 16 * g4) = w;
        }
    }
    __syncthreads();
#pragma unroll 2
    for (int idx = tid; idx < 128 * 32; idx += 512) {
        const int pp = idx >> 5, c16 = idx & 31;
        const size_t row = (size_t)(R0 + pp);
        const int cb = hd * 256 + c16 * 8;
        const u32x4 mx = *(const LAS u32x4*)(lds + pp * PL_PITCH + c16 * 16);
        const u32x4 uu = *(const GAS u32x4*)(proj + row * INW + 2048 + cb), gg = *(const GAS u32x4*)(proj + row * INW + 4096 + cb);
        u32x4 w;
        w.x = cvt_pk_bf16(bflo(uu.x) * bflo(mx.x) * silu(bflo(gg.x)), bfhi(uu.x) * bfhi(mx.x) * silu(bfhi(gg.x)));
        w.y = cvt_pk_bf16(bflo(uu.y) * bflo(mx.y) * silu(bflo(gg.y)), bfhi(uu.y) * bfhi(mx.y) * silu(bfhi(gg.y)));
        w.z = cvt_pk_bf16(bflo(uu.z) * bflo(mx.z) * silu(bflo(gg.z)), bfhi(uu.z) * bfhi(mx.z) * silu(bfhi(gg.z)));
        w.w = cvt_pk_bf16(bflo(uu.w) * bflo(mx.w) * silu(bflo(gg.w)), bfhi(uu.w) * bfhi(mx.w) * silu(bfhi(gg.w)));
        *(GAS u32x4*)((bf16_t*)(p.ws + OFF_O) + row * DM + 1024 + cb) = w;
    }
}

#ifndef MK_SPLIT
#define MK_SPLIT 0
#endif

#define XB_TMO      128
#define XB_XCNT(j)  (256  + 64 * (j))
#define XB_XSUB(j)  (1280 + 64 * (j))
#define XB_XGEN(j)  (2304 + 64 * (j))
#define XB_TOP      3328
#define XB_TOPGEN   3392
#define XCD_BAR_WORDS 3456
#define XB_SPIN_CAP (1u << 18)

__device__ __forceinline__ unsigned xb_ld(unsigned* p)              { return __hip_atomic_load(p, __ATOMIC_RELAXED, __HIP_MEMORY_SCOPE_AGENT); }
__device__ __forceinline__ unsigned xb_add(unsigned* p, unsigned v) { return __hip_atomic_fetch_add(p, v, __ATOMIC_RELAXED, __HIP_MEMORY_SCOPE_AGENT); }
__device__ __forceinline__ unsigned xb_xcc_id() { return (unsigned)__builtin_amdgcn_s_getreg((3 << 11) | 20) & 0xFu; }
#define XB_SPIN(cond, bar) do { unsigned _sp = 0; while (cond) { __builtin_amdgcn_s_sleep(1); \
    if ((++_sp & 255u) == 0u) { if (xb_ld(&(bar)[XB_TMO])) break; if (_sp > XB_SPIN_CAP) { atomicAdd(&(bar)[XB_TMO], 1u); break; } } } } while (0)

struct XcdBarrier {
    unsigned* bar; unsigned x;
    volatile LAS unsigned* st;
};

__device__ __forceinline__ XcdBarrier xcd_barrier_post(unsigned* bar, volatile LAS unsigned* st) {
    XcdBarrier b; b.bar = bar; b.x = xb_xcc_id(); b.st = st;
    if (threadIdx.x == 0) (void)xb_add(&bar[XB_XCNT(b.x)], 1u);
    return b;
}
__device__ __forceinline__ void xcd_barrier_complete(unsigned* bar, unsigned x, unsigned& nloc, unsigned& nx) {
    const unsigned G = gridDim.x * gridDim.y * gridDim.z;
    unsigned sum, cnt, mine, sp = 0u;
    for (;;) {
        sum = 0u; cnt = 0u; mine = 0u;
#pragma unroll
        for (unsigned j = 0; j < 16; ++j) { const unsigned c = xb_ld(&bar[XB_XCNT(j)]); sum += c; cnt += (c > 0u) ? 1u : 0u; mine = (j == x) ? c : mine; }
        if (sum == G) break;
        __builtin_amdgcn_s_sleep(1);
        if ((++sp & 255u) == 0u) { if (xb_ld(&bar[XB_TMO])) break; if (sp > XB_SPIN_CAP) { atomicAdd(&bar[XB_TMO], 1u); break; } }
    }
    nloc = mine > 0u ? mine : 1u; nx = cnt > 0u ? cnt : 1u;
}

__device__ __forceinline__ void xcd_barrier(const XcdBarrier& b) {
    asm volatile("s_waitcnt vmcnt(0)" ::: "memory");
    __syncthreads();
    if (threadIdx.x == 0) {
        unsigned* bar = b.bar;
        __builtin_amdgcn_s_waitcnt(0);
        unsigned nloc = b.st[0], nx = b.st[1];
        if (nloc == 0u) { xcd_barrier_complete(bar, b.x, nloc, nx); b.st[0] = nloc; b.st[1] = nx; }
        const unsigned old = xb_add(&bar[XB_XSUB(b.x)], 1u);
        const unsigned gen = old / nloc;
        if (old + 1u == (gen + 1u) * nloc) {
            __builtin_amdgcn_fence(__ATOMIC_RELEASE, "agent");
            asm volatile("s_waitcnt vmcnt(0)" ::: "memory");
            const unsigned og = xb_add(&bar[XB_TOP], 1u);
            const unsigned tg = og / nx;
            if (og + 1u == (tg + 1u) * nx) xb_add(&bar[XB_TOPGEN], 1u);
            else XB_SPIN(xb_ld(&bar[XB_TOPGEN]) == tg, bar);
            __builtin_amdgcn_fence(__ATOMIC_ACQUIRE, "agent");
            xb_add(&bar[XB_XGEN(b.x)], 1u);
            asm volatile("s_waitcnt vmcnt(0)" ::: "memory");
        } else {
            XB_SPIN(xb_ld(&bar[XB_XGEN(b.x)]) == gen, bar);
            __builtin_amdgcn_fence(__ATOMIC_ACQUIRE, "agent");
            asm volatile("s_waitcnt vmcnt(0)" ::: "memory");
        }
    }
    __syncthreads();
}

#ifndef MK_ENABLE
#define MK_ENABLE 0x1ff
#endif
#define EN(x) (((MK_ENABLE) >> (x)) & 1)
#ifndef MK_DUP
#define MK_DUP 0
#endif
#define DUP(x) (1 + (((MK_DUP) >> (x)) & 1))
__global__ __launch_bounds__(512, 2) void fwd_megakernel(const Params p, const int ph_lo, const int ph_hi, const int use_sync) {
    extern __shared__ __attribute__((aligned(16))) unsigned char shm[];
    cg::grid_group grid = cg::this_grid();
    LAS unsigned char* lds = (LAS unsigned char*)shm;
    const int tid = my_tid(), wave = __builtin_amdgcn_readfirstlane(tid >> 6);
    if (use_sync == 2) grid.sync();
    volatile LAS unsigned* xst = (volatile LAS unsigned*)(lds + 131072);
    if (threadIdx.x < 4) xst[threadIdx.x] = 0u;
    __syncthreads();
    const XcdBarrier xb = xcd_barrier_post((unsigned*)(p.ws + OFF_BAR), xst);
    int ph = 0;
#define PHASE_BEGIN if (ph >= ph_lo && ph < ph_hi) { Params q = p; asm volatile("" : "+s"(q.ws), "+s"(q.out));
#define PHASE_END } ++ph; if (use_sync && ph > ph_lo && ph < ph_hi) xcd_barrier(xb);
#define PHASE_END_LAST } ++ph;
    PHASE_BEGIN for (int rep = 0; rep < DUP(3); ++rep) { if (EN(4)) phase0(q, shm); __syncthreads(); } if (MK_DUP & 1) { for (int i = 0; i < 20; ++i) xcd_barrier(xb); } PHASE_END
    PHASE_BEGIN if (EN(8)) phase_rows(q, -1, lds); PHASE_END
#pragma unroll 1
    for (int l = 0; l < 4; ++l) {
        const int lj = l >> 1;
        PHASE_BEGIN
_Pragma("unroll 1") for (int rep = 0; rep < DUP(4); ++rep) {
            pg8::Gemm g; g.A = (const bf16_t*)(q.ws + OFF_H); g.Bt = (const bf16_t*)(q.ws + OFF_WTIN) + (size_t)l * 5120 * 2048; g.M = MROWS; g.N = INW; g.K = DM;
            pg8::StaticOrder S; S.init(g.M, g.N, (int)gridDim.x, (int)blockIdx.x);
            EpiProj E; E.O = (bf16_t*)(q.ws + OFF_PROJ); E.outk = q.out + (size_t)MROWS * DM; E.outv = E.outk + (size_t)32 * 2 * 256 * 512; E.even = (l & 1) == 0; E.j = lj;
            __syncthreads();
            if (EN(6)) pg8::gemm_phase<EpiProj, pg8::StaticOrder, false>(lds, g, S, E, nullptr);
            __syncthreads();
}
        PHASE_END
        if ((l & 1) == 0) {
            PHASE_BEGIN if (EN(3)) phase_even_prep(q, lj, lds); PHASE_END
            PHASE_BEGIN
_Pragma("unroll 1") for (int rep = 0; rep < DUP(1); ++rep) {                if (blockIdx.x < 32) {
                    pg8::Gemm g; g.A = (const bf16_t*)(q.ws + OFF_TW2K); g.Bt = (const bf16_t*)(q.ws + OFF_YTS) + (size_t)lj * 1024 * 2048; g.M = 2048; g.N = 1024; g.K = 2048;
                    asm volatile("" : "+s"(g.A), "+s"(g.Bt), "+s"(g.M), "+s"(g.N), "+s"(g.K));
                    pg8::StaticOrder S; S.init(g.M, g.N, 32, (int)blockIdx.x);
                    EpiFnet E; E.proj = (const bf16_t*)(q.ws + OFF_PROJ); E.O = (bf16_t*)(q.ws + OFF_O); E.rowbase0 = NPROMPT; E.T = 2048; E.yh = (const float*)(q.ws + OFF_YH) + lj * 1024;
                    __syncthreads();
                    _Pragma("unroll 1") for (int rep2 = 0; rep2 < DUP(7); ++rep2) { if (EN(5)) pg8::gemm_phase<EpiFnet, pg8::StaticOrder, false>(lds, g, S, E, nullptr);
                    __syncthreads(); }
                } else {
                    const int nb = (int)gridDim.x - 32;
                    int fc, fG;
                    if (gridDim.x == 256) {
                        const int xq = (int)blockIdx.x & 7, kq_ = ((int)blockIdx.x >> 3) - 4;
                        if (kq_ < 24) {
#pragma unroll 1
                            for (int u = 0; u < 3; ++u) {
                                int item;
                                if (u == 0) item = (xq >> 2) * 96 + ((xq & 3) * 3 + (kq_ >> 3)) * 8 + (kq_ & 7);
                                else { const int pk = 2 * kq_ + (u - 1), gp_ = xq + 8 * (pk / 3); item = 192 + (gp_ >> 2) * 12 + (gp_ & 3) * 3 + pk % 3; }
                                if (EN(0)) attn_item(q, item, lj, lds);
                            }
                            fc = -1;
                        } else fc = xq * 4 + (kq_ - 24);
                        fG = 32;
                    } else {
                        for (int item = (int)blockIdx.x - 32; item < 576; item += nb) { if (EN(0)) attn_item(q, item, lj, lds); }
                        fc = (int)blockIdx.x - ((int)gridDim.x - 64); fG = 64;
                    }
                    __syncthreads();
                    pg8::Gemm g; g.A = (const bf16_t*)(q.ws + OFF_TW256); g.Bt = (const bf16_t*)(q.ws + OFF_YTP); g.M = 256; g.N = 16384; g.K = 512;
                    asm volatile("" : "+s"(g.A), "+s"(g.Bt), "+s"(g.M), "+s"(g.N), "+s"(g.K));
                    pg8::StaticOrder S; S.init(g.M, g.N, fG, fc);
                    EpiFnet E; E.proj = (const bf16_t*)(q.ws + OFF_PROJ); E.O = (bf16_t*)(q.ws + OFF_O); E.rowbase0 = 0; E.T = 256; E.yh = nullptr;
                    if (EN(5) && fc >= 0) pg8::gemm_phase<EpiFnet, pg8::StaticOrder, false>(lds, g, S, E, nullptr);
                    __syncthreads();
                }
}
            PHASE_END
        } else {
            PHASE_BEGIN
_Pragma("unroll 1") for (int rep = 0; rep < DUP(2); ++rep) {                for (int item = blockIdx.x; item < 384; item += gridDim.x) { if (EN(2)) sgu_item(q, item, lj, lds); }
                {
                    const int bx = (int)blockIdx.x, np = bx < 128 ? 2 : 4, first = bx < 128 ? 2 * bx : 256 + 4 * (bx - 128);
                    if (gridDim.x == 256) { for (int k = 0; k < np; ++k) { if (EN(1)) pool_item(q, first + k, lj, lds); } }
                    else { for (int k = bx; k < 768; k += (int)gridDim.x) { if (EN(1)) pool_item(q, k, lj, lds); } }
                }
                __syncthreads();
}
            PHASE_END
        }
        PHASE_BEGIN
_Pragma("unroll 1") for (int rep = 0; rep < DUP(5); ++rep) {
            pg8::Gemm g; g.A = (const bf16_t*)(q.ws + OFF_O); g.Bt = (const bf16_t*)(q.ws + OFF_WTOUT) + (size_t)l * 2048 * 2048; g.M = MROWS; g.N = DM; g.K = DM;
            pg8::StaticOrder S; S.init(g.M, g.N, (int)gridDim.x, (int)blockIdx.x);
            EpiY E; E.C = (bf16_t*)(q.ws + OFF_Y);
            __syncthreads();
            if (EN(7)) pg8::gemm_phase<EpiY, pg8::StaticOrder, false>(lds, g, S, E, nullptr);
            __syncthreads();
            if (EN(4) && gridDim.x == 256 && blockIdx.x >= 128 && l < 3) transpose_tiles(q, shm, l + 1);
}
        PHASE_END
        if (l < 3) { PHASE_BEGIN if (EN(8)) phase_rows(q, l, lds); PHASE_END } else { PHASE_BEGIN if (EN(8)) phase_rows(q, l, lds); PHASE_END_LAST }
    }
}

extern "C" void kernel_launch(void* const* d_in, const int* in_sizes, int n_in, void* d_out, int out_size, void* d_ws, size_t ws_size, hipStream_t stream) {
    constexpr size_t kDynLds = 131072 + 16;
    static int grid_blocks = 0;
    if (!grid_blocks) {
        int dev = 0, cus = 0, per_cu = 0;
        (void)hipGetDevice(&dev);
        (void)hipDeviceGetAttribute(&cus, hipDeviceAttributeMultiprocessorCount, dev);
        (void)hipFuncSetAttribute((const void*)fwd_megakernel, hipFuncAttributeMaxDynamicSharedMemorySize, (int)kDynLds);
        (void)hipOccupancyMaxActiveBlocksPerMultiprocessor(&per_cu, fwd_megakernel, 512, kDynLds);
        if (per_cu < 1) { fprintf(stderr, "occupancy query returned %d\n", per_cu); per_cu = 1; }
        if (per_cu > 1) per_cu = 1;
        grid_blocks = cus * per_cu;
        if (grid_blocks > 256) grid_blocks = 256;
    }
    if (ws_size < WS_NEED) { fprintf(stderr, "workspace too small: %zu < %zu\n", ws_size, WS_NEED); return; }
    Params p{};
    for (int i = 0; i < 18; ++i) p.in[i] = (const float*)d_in[i];
    p.out = (float*)d_out; p.ws = (unsigned char*)d_ws;
#if MK_SPLIT
    for (int ph = 0; ph < 22; ++ph) {
        int lo = ph, hi = ph + 1, us = 0;
        void* args[] = {(void*)&p, (void*)&lo, (void*)&hi, (void*)&us};
        hipLaunchCooperativeKernel((const void*)fwd_megakernel, dim3(grid_blocks), dim3(512), args, kDynLds, stream);
    }
#else
    (void)hipMemsetAsync((unsigned char*)d_ws + OFF_BAR, 0, 16384, stream);
    (void)hipMemsetAsync((unsigned char*)d_ws + OFF_MOD, 0, (size_t)4 * 3 * 6144 * 4, stream);
    int lo = 0, hi = 1000, us = 1;
    void* args[] = {(void*)&p, (void*)&lo, (void*)&hi, (void*)&us};
    hipError_t e = hipLaunchCooperativeKernel((const void*)fwd_megakernel, dim3(grid_blocks), dim3(512), args, kDynLds, stream);
    if (e != hipSuccess) fprintf(stderr, "cooperative launch failed: %s (grid %d)\n", hipGetErrorString(e), grid_blocks);
#endif
}
```
